# Optimizing an MI355X kernel written in HIP

```python
import jax, jax.numpy as jnp
from jax import lax
import numpy as np

D_MODEL = 2048
BATCH = 2
SEQ = 8192
DEPTH = 1

CHUNK = 64
Q_BLOCK = 128
HEAD_DIM = 128
N_FOX_HEADS = D_MODEL // (2 * HEAD_DIM)
N_RET_HEADS = D_MODEL // (2 * HEAD_DIM)
D_FOX = N_FOX_HEADS * HEAD_DIM
D_RET = N_RET_HEADS * HEAD_DIM
D_MIX = D_FOX + D_RET
D_IN = 3 * D_FOX + N_FOX_HEADS + 4 * D_RET
N_GROUPS = 4
EXPERTS_PER_GROUP = 8
N_EXPERTS = N_GROUPS * EXPERTS_PER_GROUP
TOP_K = 2
D_EXPERT = D_MODEL // 4
MOE_BLOCK = 128
ROPE_BASE = 10000.0
EPS = 1e-6
FORGET_BIAS_INIT = 3.0

kernel_name = "hybrid_fox_retention_hmoe_adaln"


def rms_norm(x, w):
    xf = x.astype(jnp.float32)
    y = xf * lax.rsqrt(jnp.mean(xf * xf, axis=-1, keepdims=True) + EPS)
    return (y * w.astype(jnp.float32)).astype(x.dtype)


def rotate(x, pos):
    half = HEAD_DIM // 2
    theta = ROPE_BASE ** (-jnp.arange(half, dtype=jnp.float32) / half)
    ang = pos[:, None] * theta[None, :]
    cos = jnp.cos(ang)[None, :, None, :]
    sin = jnp.sin(ang)[None, :, None, :]
    x1, x2 = x[..., :half], x[..., half:]
    return jnp.concatenate([x1 * cos - x2 * sin, x1 * sin + x2 * cos], axis=-1).astype(x.dtype)


def forgetting_attention(q, k, v, log_f):
    B, H, S, d = q.shape
    nb = S // Q_BLOCK
    cum = jnp.cumsum(log_f, axis=-1)
    key_pos = jnp.arange(S)
    scale = HEAD_DIM ** -0.5
    qb = q.reshape(B, H, nb, Q_BLOCK, d).transpose(2, 0, 1, 3, 4)
    cb = cum.reshape(B, H, nb, Q_BLOCK).transpose(2, 0, 1, 3)

    def block(args):
        i, q_i, c_i = args
        s = jnp.einsum('bhqd,bhkd->bhqk', q_i, k).astype(jnp.float32) * scale
        s = s + c_i[..., :, None] - cum[..., None, :]
        q_pos = i * Q_BLOCK + jnp.arange(Q_BLOCK)
        s = jnp.where(key_pos[None, :] <= q_pos[:, None], s, -jnp.inf)
        p = jax.nn.softmax(s, axis=-1).astype(v.dtype)
        return jnp.einsum('bhqk,bhkd->bhqd', p, v)

    out = lax.map(block, (jnp.arange(nb), qb, cb))
    return out.transpose(1, 2, 0, 3, 4).reshape(B, H, S, d)


def retention(q, k, v):
    B, H, S, d = q.shape
    nc = S // CHUNK
    log_g = jnp.log(1.0 - 2.0 ** (-5.0 - jnp.arange(H, dtype=jnp.float32)))
    idx = jnp.arange(CHUNK, dtype=jnp.float32)
    diff = idx[:, None] - idx[None, :]
    decay = jnp.where(diff >= 0, jnp.exp(log_g[:, None, None] * jnp.maximum(diff, 0.0)), 0.0)
    q_decay = jnp.exp(log_g[:, None] * (idx + 1.0))
    k_decay = jnp.exp(log_g[:, None] * (CHUNK - 1.0 - idx))
    chunk_decay = jnp.exp(log_g * CHUNK)
    qc = q.reshape(B, H, nc, CHUNK, d)
    kc = k.reshape(B, H, nc, CHUNK, d) * (HEAD_DIM ** -0.5)
    vc = v.reshape(B, H, nc, CHUNK, d)
    scores = jnp.einsum('bhnid,bhnjd->bhnij', qc, kc) * decay[None, :, None]
    intra = jnp.einsum('bhnij,bhnje->bhnie', scores, vc)
    kv = jnp.einsum('bhnjd,bhnje->bhnde', kc * k_decay[None, :, None, :, None], vc)

    def step(state, kv_i):
        return state * chunk_decay[None, :, None, None] + kv_i, state

    _, prev = lax.scan(step, jnp.zeros((B, H, d, d), kv.dtype), kv.transpose(2, 0, 1, 3, 4))
    prev = prev.transpose(1, 2, 0, 3, 4)
    inter = jnp.einsum('bhnid,bhnde->bhnie', qc * q_decay[None, :, None, :, None], prev)
    return (intra + inter).reshape(B, H, S, d).astype(v.dtype)


def hierarchical_moe(h, w_coarse, b_coarse, w_fine, b_fine, w1, w3, w2):
    N, D = h.shape
    hf = h.astype(jnp.float32)
    p_group = jax.nn.softmax(hf @ w_coarse.astype(jnp.float32) + b_coarse.astype(jnp.float32), axis=-1)
    g_sel = jnp.argmax(p_group, axis=-1)
    p_g = jnp.take_along_axis(p_group, g_sel[:, None], axis=-1)
    fine_all = jnp.einsum('nd,gde->nge', hf, w_fine.astype(jnp.float32)) + b_fine.astype(jnp.float32)
    fine = jnp.take_along_axis(fine_all, g_sel[:, None, None], axis=1)[:, 0]
    top_p, top_e = lax.top_k(jax.nn.softmax(fine, axis=-1), TOP_K)
    gate = p_g * top_p / jnp.sum(top_p, axis=-1, keepdims=True)
    eid = g_sel[:, None] * EXPERTS_PER_GROUP + top_e
    NK = N * TOP_K
    flat_e = eid.reshape(NK).astype(jnp.int32)
    flat_w = gate.reshape(NK)
    flat_tok = jnp.repeat(jnp.arange(N, dtype=jnp.int32), TOP_K)
    order = jnp.argsort(flat_e)
    e_s, tok_s, w_s = flat_e[order], flat_tok[order], flat_w[order]
    counts = jnp.zeros((N_EXPERTS,), jnp.int32).at[flat_e].add(1)
    padded = (counts + MOE_BLOCK - 1) // MOE_BLOCK * MOE_BLOCK
    start = jnp.cumsum(counts) - counts
    pstart = jnp.cumsum(padded) - padded
    pend = pstart + padded
    dest = pstart[e_s] + (jnp.arange(NK, dtype=jnp.int32) - start[e_s])
    nb = NK // MOE_BLOCK + N_EXPERTS
    slot_tok = jnp.full((nb * MOE_BLOCK,), N, jnp.int32).at[dest].set(tok_s)
    slot_w = jnp.zeros((nb * MOE_BLOCK,), h.dtype).at[dest].set(w_s.astype(h.dtype))
    block_start = jnp.arange(nb, dtype=jnp.int32) * MOE_BLOCK
    block_e = jnp.minimum(jnp.searchsorted(pend, block_start, side='right'), N_EXPERTS - 1)
    xpad = jnp.concatenate([h, jnp.zeros((1, D), h.dtype)], axis=0)
    xb = xpad[slot_tok].reshape(nb, MOE_BLOCK, D)

    def expert_block(args):
        x_i, e = args
        return (jax.nn.silu(x_i @ w1[e]) * (x_i @ w3[e])) @ w2[e]

    yb = lax.map(expert_block, (xb, block_e))
    y = jnp.zeros((N + 1, D), yb.dtype).at[slot_tok].add(yb.reshape(-1, D) * slot_w[:, None])
    return y[:N]


def setup_inputs(seed: int = 0) -> dict:
    key = jax.random.key(seed)
    ks = jax.random.split(key, 20)
    L, D = DEPTH, D_MODEL
    nrm = jax.random.normal
    return {
        "x": nrm(ks[0], (BATCH, SEQ, D), jnp.float32),
        "c": nrm(ks[1], (BATCH, D), jnp.float32),
        "w_ada": nrm(ks[2], (L, D, 6 * D), jnp.float32) * D ** -0.5,
        "b_ada": 0.02 * nrm(ks[3], (L, 6 * D), jnp.float32),
        "norm1_w": 1.0 + 0.01 * nrm(ks[4], (L, D), jnp.float32),
        "w_in": nrm(ks[5], (L, D, D_IN), jnp.float32) * D ** -0.5,
        "forget_bias": FORGET_BIAS_INIT + 0.1 * nrm(ks[6], (L, N_FOX_HEADS), jnp.float32),
        "q_norm_w": 1.0 + 0.01 * nrm(ks[7], (L, HEAD_DIM), jnp.float32),
        "k_norm_w": 1.0 + 0.01 * nrm(ks[8], (L, HEAD_DIM), jnp.float32),
        "ret_norm_w": 1.0 + 0.01 * nrm(ks[9], (L, D_RET), jnp.float32),
        "w_out": nrm(ks[10], (L, D_MIX, D), jnp.float32) * D_MIX ** -0.5,
        "norm2_w": 1.0 + 0.01 * nrm(ks[11], (L, D), jnp.float32),
        "w_coarse": nrm(ks[12], (L, D, N_GROUPS), jnp.float32) * D ** -0.5,
        "b_coarse": 0.01 * nrm(ks[13], (L, N_GROUPS), jnp.float32),
        "w_fine": nrm(ks[14], (L, N_GROUPS, D, EXPERTS_PER_GROUP), jnp.float32) * D ** -0.5,
        "b_fine": 0.01 * nrm(ks[15], (L, N_GROUPS, EXPERTS_PER_GROUP), jnp.float32),
        "w1": nrm(ks[16], (L, N_EXPERTS, D, D_EXPERT), jnp.float32) * D ** -0.5,
        "w3": nrm(ks[17], (L, N_EXPERTS, D, D_EXPERT), jnp.float32) * D ** -0.5,
        "w2": nrm(ks[18], (L, N_EXPERTS, D_EXPERT, D), jnp.float32) * D_EXPERT ** -0.5,
    }


def reference(x, c, w_ada, b_ada, norm1_w, w_in, forget_bias, q_norm_w, k_norm_w, ret_norm_w,
              w_out, norm2_w, w_coarse, b_coarse, w_fine, b_fine, w1, w3, w2):
    B, S, D = x.shape
    H, d = N_FOX_HEADS, HEAD_DIM
    Hr = N_RET_HEADS
    splits = [D_FOX, 2 * D_FOX, 3 * D_FOX, 3 * D_FOX + H,
              3 * D_FOX + H + D_RET, 3 * D_FOX + H + 2 * D_RET, 3 * D_FOX + H + 3 * D_RET]
    pos = jnp.arange(S, dtype=jnp.float32)
    c_act = jax.nn.silu(c)
    for l in range(DEPTH):
        mod = c_act @ w_ada[l] + b_ada[l]
        sh1, sc1, g1, sh2, sc2, g2 = jnp.split(mod[:, None, :], 6, axis=-1)
        h = rms_norm(x, norm1_w[l]) * (1.0 + sc1) + sh1
        z = h @ w_in[l]
        qa, ka, va, fa, qb, kb, vb, gb = jnp.split(z, splits, axis=-1)
        qa = rms_norm(qa.reshape(B, S, H, d), q_norm_w[l]).transpose(0, 2, 1, 3)
        ka = rms_norm(ka.reshape(B, S, H, d), k_norm_w[l]).transpose(0, 2, 1, 3)
        va = va.reshape(B, S, H, d).transpose(0, 2, 1, 3)
        log_f = jax.nn.log_sigmoid(fa.astype(jnp.float32) + forget_bias[l].astype(jnp.float32))
        o_a = forgetting_attention(qa, ka, va, log_f.transpose(0, 2, 1))
        o_a = o_a.transpose(0, 2, 1, 3).reshape(B, S, D_FOX)
        qb = rotate(qb.reshape(B, S, Hr, d), pos).transpose(0, 2, 1, 3)
        kb = rotate(kb.reshape(B, S, Hr, d), pos).transpose(0, 2, 1, 3)
        vb = vb.reshape(B, S, Hr, d).transpose(0, 2, 1, 3)
        o_b = retention(qb, kb, vb).transpose(0, 2, 1, 3)
        o_b = rms_norm(o_b, ret_norm_w[l].reshape(Hr, d)).reshape(B, S, D_RET)
        o_b = o_b * jax.nn.silu(gb)
        mix = jnp.concatenate([o_a, o_b], axis=-1) @ w_out[l]
        x = x + g1 * mix
        h2 = rms_norm(x, norm2_w[l]) * (1.0 + sc2) + sh2
        y = hierarchical_moe(h2.reshape(B * S, D), w_coarse[l], b_coarse[l], w_fine[l], b_fine[l],
                             w1[l], w3[l], w2[l])
        x = x + g2 * y.reshape(B, S, D).astype(x.dtype)
    return x
```

```cpp
#include <hip/hip_runtime.h>
#include <cstdio>
#include <cstdint>
typedef unsigned short bf16_t;
__device__ __forceinline__ float bf2f(bf16_t v) { return __uint_as_float(((unsigned)v) << 16); }
__device__ __forceinline__ unsigned f2bf(float f) { const unsigned u = __float_as_uint(f); return (u + 0x7fffu + ((u >> 16) & 1u)) >> 16; }

constexpr size_t MiB = 1u << 20;
constexpr int M_TOK = 16384, SEQ = 8192, DM = 2048;
constexpr size_t QKV_ELEMS = (size_t)16 * 8192 * 128;
namespace nv {

__global__ void __launch_bounds__(256) k_modp(const float* __restrict__ c, const float* __restrict__ w_ada, float* __restrict__ modp) {
    const int j = blockIdx.x * 256 + threadIdx.x, ks = blockIdx.y;
    float a0 = 0.f, a1 = 0.f;
    for (int k = ks * 128; k < ks * 128 + 128; ++k) {
        const float w = w_ada[(size_t)k * 12288 + j];
        float c0 = c[k], c1 = c[2048 + k];
        c0 = c0 / (1.f + expf(-c0)); c1 = c1 / (1.f + expf(-c1));
        a0 += c0 * w; a1 += c1 * w;
    }
    modp[(ks * 2 + 0) * 12288 + j] = a0; modp[(ks * 2 + 1) * 12288 + j] = a1;
}
__global__ void __launch_bounds__(256) k_mod(const float* __restrict__ modp, const float* __restrict__ b_ada, float* __restrict__ mod) {
    const int i = blockIdx.x * 256 + threadIdx.x;
    const int j = i % 12288, b = i / 12288; float a = b_ada[j];
    for (int s = 0; s < 16; ++s) a += modp[(s * 2 + b) * 12288 + j];
    mod[i] = a;
}
__global__ void __launch_bounds__(256) k_rope(float2* __restrict__ rope) {
    const int i = blockIdx.x * 256 + threadIdx.x; const int s = i >> 6, j = i & 63;
    const float theta = powf(10000.f, -(float)j / 64.f);
    const float ang = (float)s * theta;
    const double a = (double)ang, TWO_PI = 6.283185307179586; const double k = rint(a / TWO_PI); const float r = (float)(a - k * TWO_PI);
    rope[i] = make_float2(cosf(r), sinf(r));
}
__device__ __forceinline__ float block_sum256(float v, float* red) {
#pragma unroll
    for (int o = 32; o > 0; o >>= 1) v += __shfl_xor(v, o);
    __syncthreads();
    if ((threadIdx.x & 63) == 0) red[threadIdx.x >> 6] = v;
    __syncthreads();
    return (red[0] + red[1]) + (red[2] + red[3]);
}
__device__ __forceinline__ float log_sigmoid(float x) { return x >= 0.f ? -log1pf(expf(-x)) : x - log1pf(expf(x)); }

__global__ void __launch_bounds__(256) k_xn(const float* __restrict__ x, const float* __restrict__ norm1_w, const float* __restrict__ mod, const float* __restrict__ w_in,
                                           const float* __restrict__ fbias, bf16_t* __restrict__ xn, float* __restrict__ logf_) {
    __shared__ float red[4];
    const int m = blockIdx.x, b = m >> 13, s = m & 8191, tid = threadIdx.x;
    const float* xr = x + (size_t)m * 2048; const float* sh = mod + b * 12288; const float* sc = sh + 2048;
    float v[8]; int col[2] = {tid * 4, 1024 + tid * 4};
#pragma unroll
    for (int i = 0; i < 2; ++i) { const float4 t = *(const float4*)(xr + col[i]); v[4 * i] = t.x; v[4 * i + 1] = t.y; v[4 * i + 2] = t.z; v[4 * i + 3] = t.w; }
    float ss = 0.f;
#pragma unroll
    for (int i = 0; i < 8; ++i) ss += v[i] * v[i];
    ss = block_sum256(ss, red);
    const float rstd = rsqrtf(ss * (1.f / 2048.f) + 1e-6f);
    float fa[8] = {0.f, 0.f, 0.f, 0.f, 0.f, 0.f, 0.f, 0.f};
#pragma unroll
    for (int i = 0; i < 2; ++i) {
        unsigned short o[4];
#pragma unroll
        for (int e = 0; e < 4; ++e) { const int cc = col[i] + e; const float h = v[4 * i + e] * rstd * norm1_w[cc] * (1.f + sc[cc]) + sh[cc]; o[e] = f2bf(h);
            const float4 w0 = *(const float4*)(w_in + (size_t)cc * 7176 + 3072), w1 = *(const float4*)(w_in + (size_t)cc * 7176 + 3076);
            fa[0] += h * w0.x; fa[1] += h * w0.y; fa[2] += h * w0.z; fa[3] += h * w0.w; fa[4] += h * w1.x; fa[5] += h * w1.y; fa[6] += h * w1.z; fa[7] += h * w1.w; }
        uint2 pk; pk.x = o[0] | ((unsigned)o[1] << 16); pk.y = o[2] | ((unsigned)o[3] << 16);
        *(uint2*)(xn + (size_t)m * 2048 + col[i]) = pk;
    }
#pragma unroll
    for (int hh = 0; hh < 8; ++hh) { const float t = block_sum256(fa[hh], red); if (tid == 0) logf_[(size_t)(b * 8 + hh) * 8192 + s] = log_sigmoid(t + fbias[hh]); }
}
__global__ void __launch_bounds__(1024) k_cum(const float* __restrict__ logf_, float* __restrict__ cum) {
    __shared__ double sc[2][1024];
    const int bh = blockIdx.x, tid = threadIdx.x; const float* p = logf_ + (size_t)bh * 8192 + tid * 8;
    double loc[8]; double run = 0.0;
#pragma unroll
    for (int i = 0; i < 8; ++i) { run += (double)p[i]; loc[i] = run; }
    sc[0][tid] = run; __syncthreads();
    int cur = 0;
    for (int o = 1; o < 1024; o <<= 1) { const double t = sc[cur][tid] + (tid >= o ? sc[cur][tid - o] : 0.0); sc[cur ^ 1][tid] = t; cur ^= 1; __syncthreads(); }
    const double off = sc[cur][tid] - run;
#pragma unroll
    for (int i = 0; i < 8; ++i) cum[(size_t)bh * 8192 + tid * 8 + i] = (float)(off + loc[i]);
}

template <class F> __global__ void __launch_bounds__(256) k_gemm(F f, int K) {
    __shared__ __attribute__((aligned(16))) float As[16][68]; __shared__ __attribute__((aligned(16))) float Bs[16][68];
    const int tid = threadIdx.x, tx = tid & 15, ty = tid >> 4, m0 = blockIdx.y * 64, n0 = blockIdx.x * 64;
    typename F::Ctx ctx; if (!f.tile(m0, n0, ctx)) return;
    float acc[4][4];
#pragma unroll
    for (int i = 0; i < 4; ++i)
#pragma unroll
        for (int j = 0; j < 4; ++j) acc[i][j] = 0.f;
    for (int k0 = 0; k0 < K; k0 += 16) {
        { const int r = tid >> 2, kq = (tid & 3) * 4; float a[4]; f.loadA(ctx, m0 + r, k0 + kq, a);
#pragma unroll
          for (int i = 0; i < 4; ++i) As[kq + i][r] = a[i]; }
        { const int kk = tid >> 4, nq = (tid & 15) * 4; float bv[4]; f.loadB(ctx, k0 + kk, n0 + nq, bv);
          *(float4*)&Bs[kk][nq] = make_float4(bv[0], bv[1], bv[2], bv[3]); }
        __syncthreads();
#pragma unroll
        for (int kk = 0; kk < 16; ++kk) { const float4 a = *(const float4*)&As[kk][ty * 4]; const float4 b = *(const float4*)&Bs[kk][tx * 4];
            const float av[4] = {a.x, a.y, a.z, a.w}, bw[4] = {b.x, b.y, b.z, b.w};
#pragma unroll
            for (int i = 0; i < 4; ++i)
#pragma unroll
                for (int j = 0; j < 4; ++j) acc[i][j] += av[i] * bw[j]; }
        __syncthreads();
    }
    f.store(ctx, m0 + ty * 4, n0 + tx * 4, acc);
}
__device__ __forceinline__ void ld4bf(const bf16_t* p, float* a) { const uint2 t = *(const uint2*)p; a[0] = __uint_as_float(t.x << 16); a[1] = __uint_as_float(t.x & 0xffff0000u); a[2] = __uint_as_float(t.y << 16); a[3] = __uint_as_float(t.y & 0xffff0000u); }
__device__ __forceinline__ void st4bf(bf16_t* p, float a, float b, float c, float d) { uint2 t; t.x = f2bf(a) | ((unsigned)f2bf(b) << 16); t.y = f2bf(c) | ((unsigned)f2bf(d) << 16); *(uint2*)p = t; }

struct FZ {
    struct Ctx {}; const bf16_t* xn; const float* w_in; bf16_t* z;
    __device__ __forceinline__ bool tile(int, int, Ctx&) const { return true; }
    __device__ __forceinline__ void loadA(const Ctx&, int r, int k, float* a) const { ld4bf(xn + (size_t)r * 2048 + k, a); }
    __device__ __forceinline__ void loadB(const Ctx&, int k, int n, float* b) const { const int nc = n < 3072 ? n : n + 8; const float4 t = *(const float4*)(w_in + (size_t)k * 7176 + nc); b[0] = t.x; b[1] = t.y; b[2] = t.z; b[3] = t.w; }
    __device__ __forceinline__ void store(const Ctx&, int r, int n, float (&acc)[4][4]) const {
#pragma unroll
        for (int i = 0; i < 4; ++i) st4bf(z + (size_t)(r + i) * 7168 + n, acc[i][0], acc[i][1], acc[i][2], acc[i][3]); }
};
struct FO {
    struct Ctx {}; const bf16_t* mix; const float* w_out; const float* x; const float* mod; float* x1;
    __device__ __forceinline__ bool tile(int, int, Ctx&) const { return true; }
    __device__ __forceinline__ void loadA(const Ctx&, int r, int k, float* a) const { ld4bf(mix + (size_t)r * 2048 + k, a); }
    __device__ __forceinline__ void loadB(const Ctx&, int k, int n, float* b) const { const float4 t = *(const float4*)(w_out + (size_t)k * 2048 + n); b[0] = t.x; b[1] = t.y; b[2] = t.z; b[3] = t.w; }
    __device__ __forceinline__ void store(const Ctx&, int r, int n, float (&acc)[4][4]) const {
#pragma unroll
        for (int i = 0; i < 4; ++i) { const int row = r + i, b = row >> 13; const float4 g = *(const float4*)(mod + b * 12288 + 4096 + n); const float4 xv = *(const float4*)(x + (size_t)row * 2048 + n);
            *(float4*)(x1 + (size_t)row * 2048 + n) = make_float4(xv.x + g.x * acc[i][0], xv.y + g.y * acc[i][1], xv.z + g.z * acc[i][2], xv.w + g.w * acc[i][3]); } }
};
struct FUp {
    struct Ctx { int e; }; const bf16_t* xs; const float* w1; const float* w3; const int* tile_e; const int* ntile; bf16_t* up;
    __device__ __forceinline__ bool tile(int m0, int, Ctx& c) const { const int t = m0 >> 8; if (t >= *ntile) return false; c.e = tile_e[t]; return true; }
    __device__ __forceinline__ void loadA(const Ctx&, int r, int k, float* a) const { ld4bf(xs + (size_t)r * 2048 + k, a); }
    __device__ __forceinline__ void loadB(const Ctx& c, int k, int n, float* b) const { const float* w = n < 512 ? w1 + ((size_t)c.e * 2048 + k) * 512 + n : w3 + ((size_t)c.e * 2048 + k) * 512 + (n - 512); const float4 t = *(const float4*)w; b[0] = t.x; b[1] = t.y; b[2] = t.z; b[3] = t.w; }
    __device__ __forceinline__ void store(const Ctx&, int r, int n, float (&acc)[4][4]) const {
#pragma unroll
        for (int i = 0; i < 4; ++i) st4bf(up + (size_t)(r + i) * 1024 + n, acc[i][0], acc[i][1], acc[i][2], acc[i][3]); }
};
struct FDn {
    struct Ctx { int e; }; const bf16_t* act; const float* w2; const int* tile_e; const int* ntile; bf16_t* y;
    __device__ __forceinline__ bool tile(int m0, int, Ctx& c) const { const int t = m0 >> 8; if (t >= *ntile) return false; c.e = tile_e[t]; return true; }
    __device__ __forceinline__ void loadA(const Ctx&, int r, int k, float* a) const { ld4bf(act + (size_t)r * 512 + k, a); }
    __device__ __forceinline__ void loadB(const Ctx& c, int k, int n, float* b) const { const float4 t = *(const float4*)(w2 + ((size_t)c.e * 512 + k) * 2048 + n); b[0] = t.x; b[1] = t.y; b[2] = t.z; b[3] = t.w; }
    __device__ __forceinline__ void store(const Ctx&, int r, int n, float (&acc)[4][4]) const {
#pragma unroll
        for (int i = 0; i < 4; ++i) st4bf(y + (size_t)(r + i) * 2048 + n, acc[i][0], acc[i][1], acc[i][2], acc[i][3]); }
};

__global__ void __launch_bounds__(256) k_post(const bf16_t* __restrict__ z, const float* __restrict__ q_norm_w, const float* __restrict__ k_norm_w, const float2* __restrict__ rope, bf16_t* __restrict__ qkv) {
    __shared__ float zf[7168]; __shared__ float rs[16];
    const int m = blockIdx.x, b = m >> 13, s = m & 8191, tid = threadIdx.x, lane = tid & 63, wv = tid >> 6;
    for (int i = tid; i < 7168 / 4; i += 256) { float a[4]; ld4bf(z + (size_t)m * 7168 + i * 4, a); zf[4 * i] = a[0]; zf[4 * i + 1] = a[1]; zf[4 * i + 2] = a[2]; zf[4 * i + 3] = a[3]; }
    __syncthreads();
    for (int g = wv * 4; g < wv * 4 + 4; ++g) { const float a = zf[g * 128 + lane], c = zf[g * 128 + 64 + lane]; float ss = a * a + c * c;
#pragma unroll
        for (int o = 32; o > 0; o >>= 1) ss += __shfl_xor(ss, o);
        if (lane == 0) rs[g] = rsqrtf(ss * (1.f / 128.f) + 1e-6f); }
    __syncthreads();
    for (int idx = tid; idx < 7168; idx += 256) {
        const int t = idx >> 10, h = (idx >> 7) & 7, d = idx & 127; float o;
        if (t == 0) o = zf[idx] * rs[h] * q_norm_w[d];
        else if (t == 1) o = zf[idx] * rs[8 + h] * k_norm_w[d];
        else if (t == 3 || t == 4) { const int j = d >> 1; const float x1 = zf[t * 1024 + h * 128 + j], x2 = zf[t * 1024 + h * 128 + 64 + j]; const float2 cs = rope[s * 64 + j];
            o = (d & 1) ? x1 * cs.y + x2 * cs.x : x1 * cs.x - x2 * cs.y;
            if (t == 4) { const float l2g = log2f(1.f - exp2f(-5.f - (float)h)); o *= 0.08838834764831845f * exp2f(-(float)(s & 63) * l2g); } }
        else if (t == 6) { const float g = zf[idx]; o = g / (1.f + expf(-g)); }
        else o = zf[idx];
        qkv[(size_t)t * (16u * 8192u * 128u) + ((size_t)(b * 8 + h) * 8192 + s) * 128 + d] = f2bf(o);
    }
}
__global__ void __launch_bounds__(256) k_attn(const bf16_t* __restrict__ fq, const bf16_t* __restrict__ fk, const bf16_t* __restrict__ fv, const float* __restrict__ cum, bf16_t* __restrict__ mix) {
    const int bh = blockIdx.y, t = blockIdx.x * 4 + (threadIdx.x >> 6), lane = threadIdx.x & 63;
    const size_t base = (size_t)bh * 8192 * 128;
    const unsigned qu = *(const unsigned*)(fq + base + (size_t)t * 128 + lane * 2);
    const float qx = __uint_as_float(qu << 16) * 0.08838834764831845f, qy = __uint_as_float(qu & 0xffff0000u) * 0.08838834764831845f;
    const float* cm = cum + (size_t)bh * 8192; const float ct = cm[t];
    float mx = -1e30f, l = 0.f, ox = 0.f, oy = 0.f;
    for (int j = 0; j <= t; ++j) {
        const unsigned ku = *(const unsigned*)(fk + base + (size_t)j * 128 + lane * 2);
        float dot = qx * __uint_as_float(ku << 16) + qy * __uint_as_float(ku & 0xffff0000u);
#pragma unroll
        for (int o = 32; o > 0; o >>= 1) dot += __shfl_xor(dot, o);
        const float sc = dot + (ct - cm[j]); const float mn = fmaxf(mx, sc); const float a = __expf(mx - mn), p = __expf(sc - mn);
        const unsigned vu = *(const unsigned*)(fv + base + (size_t)j * 128 + lane * 2);
        l = l * a + p; ox = ox * a + p * __uint_as_float(vu << 16); oy = oy * a + p * __uint_as_float(vu & 0xffff0000u); mx = mn;
    }
    const float inv = 1.f / l; const int b = bh >> 3, h = bh & 7;
    *(unsigned*)(mix + ((size_t)(b * 8192 + t)) * 2048 + h * 128 + lane * 2) = f2bf(ox * inv) | ((unsigned)f2bf(oy * inv) << 16);
}
__global__ void __launch_bounds__(256) k_ret(const bf16_t* __restrict__ rq, const bf16_t* __restrict__ rk, const bf16_t* __restrict__ rv, float* __restrict__ ro) {
    __shared__ float red[2][4][8];
    const int bh = blockIdx.x >> 3, sl = blockIdx.x & 7, tid = threadIdx.x, d = tid & 127, eh = tid >> 7, e0 = sl * 16 + eh * 8, wv = tid >> 6, lane = tid & 63, h = bh & 7;
    const float g = 1.f - exp2f(-5.f - (float)h), l2g = log2f(g);
    const size_t base = (size_t)bh * 8192 * 128;
    float S[8] = {0.f, 0.f, 0.f, 0.f, 0.f, 0.f, 0.f, 0.f};
    for (int s = 0; s < 8192; ++s) {
        const float qd = bf2f(rq[base + (size_t)s * 128 + d]); const float kd = bf2f(rk[base + (size_t)s * 128 + d]) * exp2f((float)(s & 63) * l2g);
        const uint4 vu = *(const uint4*)(rv + base + (size_t)s * 128 + e0);
        const float v[8] = {__uint_as_float(vu.x << 16), __uint_as_float(vu.x & 0xffff0000u), __uint_as_float(vu.y << 16), __uint_as_float(vu.y & 0xffff0000u),
                            __uint_as_float(vu.z << 16), __uint_as_float(vu.z & 0xffff0000u), __uint_as_float(vu.w << 16), __uint_as_float(vu.w & 0xffff0000u)};
        float part[8];
#pragma unroll
        for (int i = 0; i < 8; ++i) { S[i] = g * S[i] + kd * v[i]; part[i] = qd * S[i]; }
#pragma unroll
        for (int i = 0; i < 8; ++i) {
#pragma unroll
            for (int o = 32; o > 0; o >>= 1) part[i] += __shfl_xor(part[i], o); }
        const int pb = s & 1;
        if (lane == 0) {
#pragma unroll
            for (int i = 0; i < 8; ++i) red[pb][wv][i] = part[i]; }
        __syncthreads();
        if (tid < 16) { const int e2 = tid >> 3, i = tid & 7; ro[base + (size_t)s * 128 + sl * 16 + tid] = red[pb][2 * e2][i] + red[pb][2 * e2 + 1][i]; }
    }
}
__global__ void __launch_bounds__(256) k_retnorm(const float* __restrict__ ro, const float* __restrict__ ret_norm_w, const bf16_t* __restrict__ rg, bf16_t* __restrict__ mix) {
    const int m = blockIdx.x, b = m >> 13, s = m & 8191, tid = threadIdx.x, h = tid >> 5, e = (tid & 31) * 4;
    const size_t off = ((size_t)(b * 8 + h) * 8192 + s) * 128 + e;
    const float4 o = *(const float4*)(ro + off); float ss = o.x * o.x + o.y * o.y + o.z * o.z + o.w * o.w;
#pragma unroll
    for (int k = 16; k > 0; k >>= 1) ss += __shfl_xor(ss, k);
    const float rstd = rsqrtf(ss * (1.f / 128.f) + 1e-6f); float g[4]; ld4bf(rg + off, g); const float4 w = *(const float4*)(ret_norm_w + h * 128 + e);
    st4bf(mix + (size_t)m * 2048 + 1024 + h * 128 + e, o.x * rstd * w.x * g[0], o.y * rstd * w.y * g[1], o.z * rstd * w.z * g[2], o.w * rstd * w.w * g[3]);
}
__global__ void __launch_bounds__(256) k_h2route(const float* __restrict__ x1, const float* __restrict__ norm2_w, const float* __restrict__ mod, const float* __restrict__ w_coarse, const float* __restrict__ b_coarse,
                                                const float* __restrict__ w_fine, const float* __restrict__ b_fine, bf16_t* __restrict__ h2, int* __restrict__ r_eid, float* __restrict__ r_gate, int* __restrict__ r_idx, int* __restrict__ cnt) {
    __shared__ float red[4]; __shared__ float part[36][4];
    const int m = blockIdx.x, b = m >> 13, tid = threadIdx.x, lane = tid & 63, wv = tid >> 6;
    const float* xr = x1 + (size_t)m * 2048; const float* sh = mod + b * 12288 + 6144; const float* sc = sh + 2048;
    float v[8]; int col[2] = {tid * 4, 1024 + tid * 4};
#pragma unroll
    for (int i = 0; i < 2; ++i) { const float4 t = *(const float4*)(xr + col[i]); v[4 * i] = t.x; v[4 * i + 1] = t.y; v[4 * i + 2] = t.z; v[4 * i + 3] = t.w; }
    float ss = 0.f;
#pragma unroll
    for (int i = 0; i < 8; ++i) ss += v[i] * v[i];
    ss = block_sum256(ss, red);
    const float rstd = rsqrtf(ss * (1.f / 2048.f) + 1e-6f);
    float lg[36];
#pragma unroll
    for (int i = 0; i < 36; ++i) lg[i] = 0.f;
#pragma unroll
    for (int i = 0; i < 2; ++i) {
        float hv[4];
#pragma unroll
        for (int e = 0; e < 4; ++e) { const int cc = col[i] + e; hv[e] = v[4 * i + e] * rstd * norm2_w[cc] * (1.f + sc[cc]) + sh[cc];
            const float4 wc = *(const float4*)(w_coarse + (size_t)cc * 4); lg[0] += hv[e] * wc.x; lg[1] += hv[e] * wc.y; lg[2] += hv[e] * wc.z; lg[3] += hv[e] * wc.w;
#pragma unroll
            for (int g = 0; g < 4; ++g) { const float4 f0 = *(const float4*)(w_fine + ((size_t)g * 2048 + cc) * 8), f1 = *(const float4*)(w_fine + ((size_t)g * 2048 + cc) * 8 + 4);
                lg[4 + g * 8 + 0] += hv[e] * f0.x; lg[4 + g * 8 + 1] += hv[e] * f0.y; lg[4 + g * 8 + 2] += hv[e] * f0.z; lg[4 + g * 8 + 3] += hv[e] * f0.w;
                lg[4 + g * 8 + 4] += hv[e] * f1.x; lg[4 + g * 8 + 5] += hv[e] * f1.y; lg[4 + g * 8 + 6] += hv[e] * f1.z; lg[4 + g * 8 + 7] += hv[e] * f1.w; } }
        st4bf(h2 + (size_t)m * 2048 + col[i], hv[0], hv[1], hv[2], hv[3]);
    }
#pragma unroll
    for (int i = 0; i < 36; ++i) { float t = lg[i];
#pragma unroll
        for (int o = 32; o > 0; o >>= 1) t += __shfl_xor(t, o);
        if (lane == 0) part[i][wv] = t; }
    __syncthreads();
    if (tid == 0) {
        float cl[4]; int gs = 0;
        for (int g = 0; g < 4; ++g) { cl[g] = (part[g][0] + part[g][1]) + (part[g][2] + part[g][3]) + b_coarse[g]; if (cl[g] > cl[gs]) gs = g; }
        float den = 0.f; for (int g = 0; g < 4; ++g) den += expf(cl[g] - cl[gs]);
        const float pg = 1.f / den;
        float fl[8]; int e0 = 0;
        for (int e = 0; e < 8; ++e) { fl[e] = (part[4 + gs * 8 + e][0] + part[4 + gs * 8 + e][1]) + (part[4 + gs * 8 + e][2] + part[4 + gs * 8 + e][3]) + b_fine[gs * 8 + e]; if (fl[e] > fl[e0]) e0 = e; }
        int e1 = e0 == 0 ? 1 : 0; for (int e = 0; e < 8; ++e) if (e != e0 && fl[e] > fl[e1]) e1 = e;
        const float t1 = expf(fl[e1] - fl[e0]); const float g0 = pg / (1.f + t1), g1 = pg * t1 / (1.f + t1);
        const int E0 = gs * 8 + e0, E1 = gs * 8 + e1;
        r_eid[2 * m] = E0; r_eid[2 * m + 1] = E1; r_gate[2 * m] = g0; r_gate[2 * m + 1] = g1;
        r_idx[2 * m] = atomicAdd(cnt + E0, 1); r_idx[2 * m + 1] = atomicAdd(cnt + E1, 1);
    }
}
__global__ void k_offsets(const int* __restrict__ cnt, int* __restrict__ pstart, int* __restrict__ tile_e, int* __restrict__ ntile) {
    if (threadIdx.x == 0 && blockIdx.x == 0) { int p = 0, t = 0;
        for (int e = 0; e < 32; ++e) { pstart[e] = p; const int n = (cnt[e] + 255) >> 8; for (int i = 0; i < n; ++i) tile_e[t++] = e; p += n * 256; }
        pstart[32] = p; *ntile = t; }
}
__global__ void __launch_bounds__(256) k_gather(const bf16_t* __restrict__ h2, const int* __restrict__ r_eid, const int* __restrict__ r_idx, const int* __restrict__ pstart, int* __restrict__ r_slot, bf16_t* __restrict__ xs) {
    const int mk = blockIdx.x, m = mk >> 1, tid = threadIdx.x;
    const int slot = pstart[r_eid[mk]] + r_idx[mk]; if (tid == 0) r_slot[mk] = slot;
    *(uint4*)(xs + (size_t)slot * 2048 + tid * 8) = *(const uint4*)(h2 + (size_t)m * 2048 + tid * 8);
}
__global__ void __launch_bounds__(256) k_act(const bf16_t* __restrict__ up, const int* __restrict__ ntile, bf16_t* __restrict__ act) {
    const int slot = blockIdx.x; if (slot >= *ntile * 256) return; const int tid = threadIdx.x;
    const unsigned a = *(const unsigned*)(up + (size_t)slot * 1024 + tid * 2), c = *(const unsigned*)(up + (size_t)slot * 1024 + 512 + tid * 2);
    const float a0 = __uint_as_float(a << 16), a1 = __uint_as_float(a & 0xffff0000u), c0 = __uint_as_float(c << 16), c1 = __uint_as_float(c & 0xffff0000u);
    *(unsigned*)(act + (size_t)slot * 512 + tid * 2) = f2bf(a0 / (1.f + expf(-a0)) * c0) | ((unsigned)f2bf(a1 / (1.f + expf(-a1)) * c1) << 16);
}
__global__ void __launch_bounds__(256) k_combine(const float* x1, const bf16_t* __restrict__ y, const int* __restrict__ r_slot, const float* __restrict__ r_gate, const float* __restrict__ mod, float* out) {
    const int m = blockIdx.x, b = m >> 13, tid = threadIdx.x; const int s0 = r_slot[2 * m], s1 = r_slot[2 * m + 1]; const float g0 = r_gate[2 * m], g1 = r_gate[2 * m + 1];
    const float* g2 = mod + b * 12288 + 10240;
#pragma unroll
    for (int i = 0; i < 2; ++i) { const int c = i * 1024 + tid * 4; float a[4], d[4]; ld4bf(y + (size_t)s0 * 2048 + c, a); ld4bf(y + (size_t)s1 * 2048 + c, d);
        const float4 xv = *(const float4*)(x1 + (size_t)m * 2048 + c); const float4 gg = *(const float4*)(g2 + c);
        *(float4*)(out + (size_t)m * 2048 + c) = make_float4(xv.x + gg.x * (g0 * a[0] + g1 * d[0]), xv.y + gg.y * (g0 * a[1] + g1 * d[1]), xv.z + gg.z * (g0 * a[2] + g1 * d[2]), xv.w + gg.w * (g0 * a[3] + g1 * d[3])); }
}
}
namespace nvws {
constexpr size_t CTL = 0, MOD = 1 * MiB, MODP = 2 * MiB, ROPE = 4 * MiB, LOGF = 8 * MiB, CUM = 9 * MiB, ROUTE = 10 * MiB, TILE = 11 * MiB,
                 XN = 16 * MiB, MIX = 80 * MiB, Z = 144 * MiB, QKV = 368 * MiB, RO = 592 * MiB, END = 656 * MiB;
constexpr size_t H2 = XN, XS = Z, ACT = Z + 160 * MiB, UP = QKV, Y = QKV + 80 * MiB;
}
extern "C" void kernel_launch(void* const* d_in, const int* in_sizes, int n_in, void* d_out, int out_size, void* d_ws, size_t ws_size, hipStream_t stream) {
    using namespace nvws;
    if (ws_size < END) { fprintf(stderr, "kernel_launch: workspace too small (%zu < %zu)\n", ws_size, (size_t)END); return; }
    const float* x = (const float*)d_in[0]; const float* c = (const float*)d_in[1]; const float* w_ada = (const float*)d_in[2]; const float* b_ada = (const float*)d_in[3];
    const float* norm1_w = (const float*)d_in[4]; const float* w_in = (const float*)d_in[5]; const float* fbias = (const float*)d_in[6]; const float* q_norm_w = (const float*)d_in[7];
    const float* k_norm_w = (const float*)d_in[8]; const float* ret_norm_w = (const float*)d_in[9]; const float* w_out = (const float*)d_in[10]; const float* norm2_w = (const float*)d_in[11];
    const float* w_coarse = (const float*)d_in[12]; const float* b_coarse = (const float*)d_in[13]; const float* w_fine = (const float*)d_in[14]; const float* b_fine = (const float*)d_in[15];
    const float* w1 = (const float*)d_in[16]; const float* w3 = (const float*)d_in[17]; const float* w2 = (const float*)d_in[18];
    unsigned char* ws = (unsigned char*)d_ws; float* out = (float*)d_out;
    int* cnt = (int*)(ws + CTL); float* mod = (float*)(ws + MOD); float* modp = (float*)(ws + MODP); float2* rope = (float2*)(ws + ROPE); float* logf_ = (float*)(ws + LOGF); float* cum = (float*)(ws + CUM);
    int* r_eid = (int*)(ws + ROUTE); float* r_gate = (float*)(ws + ROUTE + 128 * 1024); int* r_idx = (int*)(ws + ROUTE + 256 * 1024); int* r_slot = (int*)(ws + ROUTE + 384 * 1024);
    int* pstart = (int*)(ws + TILE); int* tile_e = pstart + 64; int* ntile = pstart + 512;
    bf16_t* xn = (bf16_t*)(ws + XN); bf16_t* mix = (bf16_t*)(ws + MIX); bf16_t* z = (bf16_t*)(ws + Z); bf16_t* qkv = (bf16_t*)(ws + QKV); float* ro = (float*)(ws + RO);
    bf16_t* h2 = (bf16_t*)(ws + H2); bf16_t* xs = (bf16_t*)(ws + XS); bf16_t* act = (bf16_t*)(ws + ACT); bf16_t* up = (bf16_t*)(ws + UP); bf16_t* y = (bf16_t*)(ws + Y);
    (void)hipMemsetAsync(ws + CTL, 0, 4096, stream);
    nv::k_modp<<<dim3(48, 16), 256, 0, stream>>>(c, w_ada, modp);
    nv::k_mod<<<96, 256, 0, stream>>>(modp, b_ada, mod);
    nv::k_rope<<<2048, 256, 0, stream>>>(rope);
    nv::k_xn<<<16384, 256, 0, stream>>>(x, norm1_w, mod, w_in, fbias, xn, logf_);
    nv::k_cum<<<16, 1024, 0, stream>>>(logf_, cum);
    { nv::FZ f{}; f.xn = xn; f.w_in = w_in; f.z = z; nv::k_gemm<nv::FZ><<<dim3(112, 256), 256, 0, stream>>>(f, 2048); }
    nv::k_post<<<16384, 256, 0, stream>>>(z, q_norm_w, k_norm_w, rope, qkv);
    nv::k_attn<<<dim3(2048, 16), 256, 0, stream>>>(qkv, qkv + QKV_ELEMS, qkv + 2 * QKV_ELEMS, cum, mix);
    nv::k_ret<<<128, 256, 0, stream>>>(qkv + 3 * QKV_ELEMS, qkv + 4 * QKV_ELEMS, qkv + 5 * QKV_ELEMS, ro);
    nv::k_retnorm<<<16384, 256, 0, stream>>>(ro, ret_norm_w, qkv + 6 * QKV_ELEMS, mix);
    { nv::FO f{}; f.mix = mix; f.w_out = w_out; f.x = x; f.mod = mod; f.x1 = out; nv::k_gemm<nv::FO><<<dim3(32, 256), 256, 0, stream>>>(f, 2048); }
    nv::k_h2route<<<16384, 256, 0, stream>>>(out, norm2_w, mod, w_coarse, b_coarse, w_fine, b_fine, h2, r_eid, r_gate, r_idx, cnt);
    nv::k_offsets<<<1, 64, 0, stream>>>(cnt, pstart, tile_e, ntile);
    nv::k_gather<<<32768, 256, 0, stream>>>(h2, r_eid, r_idx, pstart, r_slot, xs);
    { nv::FUp f{}; f.xs = xs; f.w1 = w1; f.w3 = w3; f.tile_e = tile_e; f.ntile = ntile; f.up = up; nv::k_gemm<nv::FUp><<<dim3(16, 640), 256, 0, stream>>>(f, 2048); }
    nv::k_act<<<40960, 256, 0, stream>>>(up, ntile, act);
    { nv::FDn f{}; f.act = act; f.w2 = w2; f.tile_e = tile_e; f.ntile = ntile; f.y = y; nv::k_gemm<nv::FDn><<<dim3(32, 640), 256, 0, stream>>>(f, 512); }
    nv::k_combine<<<16384, 256, 0, stream>>>(out, y, r_slot, r_gate, mod, out);
}
```

```cpp
#include <hip/hip_runtime.h>
#include <cstdio>
#include <cstdint>
typedef unsigned short bf16_t;
__device__ __forceinline__ float bf2f(bf16_t v) { return __uint_as_float(((unsigned)v) << 16); }
__device__ __forceinline__ unsigned f2bf(float f) { const unsigned u = __float_as_uint(f); return (u + 0x7fffu + ((u >> 16) & 1u)) >> 16; }

constexpr size_t MiB = 1u << 20;
constexpr int M_TOK = 16384, SEQ = 8192, DM = 2048;
constexpr size_t QKV_ELEMS = (size_t)16 * 8192 * 128;
namespace pg8 {
#define PG8_LAS __attribute__((address_space(3)))
typedef short bf16x8 __attribute__((ext_vector_type(8)));
typedef float f32x4 __attribute__((ext_vector_type(4)));
typedef unsigned u32x4 __attribute__((ext_vector_type(4)));
constexpr int BM = 256, BK = 64, HALF = 128, HTB = HALF * BK * 2  , STAGE_BYTES = 8 * HTB, NXCD = 8, WGM = 8;

__host__ __device__ __forceinline__ int lds_byte(int r, int c) { const int st = (r >> 4) * 2 + (c >> 5), rr = r & 15, cc = c & 31, ob = rr * 64 + cc * 2; return st * 1024 + (ob ^ (((ob >> 9) & 1) << 5)); }
__host__ __device__ __forceinline__ void stage_rc(int b, int& R, int& C) { const int st = b / 1024, sb = b % 1024, swz = sb ^ (((sb >> 9) & 1) << 5); R = (st >> 1) * 16 + swz / 64; C = (st & 1) * 32 + (swz % 64) / 2; }
__host__ __device__ __forceinline__ int perm32(int rho) { const int n = rho >> 4, i = rho & 15; return 8 * (i >> 2) + 4 * n + (i & 3); }

struct Unit { int pm, pn, e; };
struct Gemm { const bf16_t* A; const bf16_t* Bt; int M, N, K; size_t estride; };

struct StaticOrder {
    int nM, nN, nwg, G, c;
    __host__ __device__ void init(int M, int N, int G_, int c_) { nM = M / BM; nN = N / BM; nwg = nM * nN; G = G_; c = c_; }
    __host__ __device__ bool next(int i, Unit& u) const {
        const long L = (long)i * G + c; if (L >= nwg) return false;
        int wgid = (int)L; { const int q = nwg / NXCD, r = nwg % NXCD, xcd = wgid % NXCD, off = wgid / NXCD; wgid = (xcd < r ? xcd * (q + 1) : r * (q + 1) + (xcd - r) * q) + off; }
        const int nig = WGM * nN, gid = wgid / nig, fm = gid * WGM, gsz = (nM - fm) < WGM ? (nM - fm) : WGM;
        u.pm = fm + ((wgid % nig) % gsz); u.pn = (wgid % nig) / gsz; u.e = 0; return true;
    }
    __device__ __forceinline__ void a_ready(const Unit&) const {}
    __device__ __forceinline__ void done(const Unit&) const {}
};

__device__ __forceinline__ unsigned cvt_pk_bf16(float lo, float hi) { unsigned r; asm volatile("v_cvt_pk_bf16_f32 %0, %1, %2" : "=v"(r) : "v"(lo), "v"(hi)); return r; }
typedef float f32x2 __attribute__((ext_vector_type(2)));
__device__ __forceinline__ f32x2 gelu_pk(f32x2 v) {
    const f32x2 av = __builtin_elementwise_abs(v), d = av * 0.2316418882f + 1.0f;
    f32x2 t; t.x = __builtin_amdgcn_rcpf(d.x); t.y = __builtin_amdgcn_rcpf(d.y);
    f32x2 q = t * 0.5307027145f + (-0.7265760135f); q = q * t + 0.7107068705f; q = q * t + (-0.142248368f); q = q * t + 0.127414796f; q = q * t;
    const f32x2 s = (v * v) * (-0.72134752044f);
    f32x2 e; e.x = __builtin_amdgcn_exp2f(s.x); e.y = __builtin_amdgcn_exp2f(s.y);
    const f32x2 m = v * (q * e), r = v - m;
    f32x2 o; o.x = v.x < 0.f ? m.x : r.x; o.y = v.y < 0.f ? m.y : r.y; return o;
}

template <int ACT  > struct EpiBf16 {
    static constexpr bool PERM = true, AFTER_DRAIN = false; static_assert(ACT == 0 || ACT == 1, "EpiBf16: ACT is 0 (none) or 1 (gelu_pk)");
    bf16_t* O; int ldc; const float* bias; int split_cols; size_t split_stride; float scale0;
    __device__ __forceinline__ void operator()(const f32x4 (&acc)[2][2][4][2], const Unit& u, int wr, int wc, int fr, int fq) const {
        const int row0 = u.pm * BM + wr * 64 + fr; int colt = u.pn * BM; bf16_t* base = O;
        float sc = 1.f; if (split_cols) { const int t = colt / split_cols; base += (size_t)t * split_stride; colt -= t * split_cols; if (t == 0) sc = scale0; }
        const int col0 = colt + wc * 32 + 8 * fq, bcol0 = u.pn * BM + wc * 32 + 8 * fq;
        f32x4 bv[2][2];
#pragma unroll
        for (int bj = 0; bj < 2; ++bj)
#pragma unroll
            for (int n = 0; n < 2; ++n) bv[bj][n] = bias ? *(const f32x4*)(bias + bcol0 + bj * HALF + 4 * n) : (f32x4){0.f, 0.f, 0.f, 0.f};
#pragma unroll
        for (int ai = 0; ai < 2; ++ai)
#pragma unroll
            for (int m = 0; m < 4; ++m) { bf16_t* rowp = base + (size_t)(row0 + ai * HALF + m * 16) * ldc + col0;
#pragma unroll
                for (int bj = 0; bj < 2; ++bj) { f32x4 v0 = acc[ai][bj][m][0] + bv[bj][0], v1 = acc[ai][bj][m][1] + bv[bj][1];
                    if (ACT == 1) { f32x2 a = gelu_pk((f32x2){v0[0], v0[1]}), b = gelu_pk((f32x2){v0[2], v0[3]}), c = gelu_pk((f32x2){v1[0], v1[1]}), d = gelu_pk((f32x2){v1[2], v1[3]});
                        v0 = (f32x4){a.x, a.y, b.x, b.y}; v1 = (f32x4){c.x, c.y, d.x, d.y}; }
                    v0 = v0 * sc; v1 = v1 * sc; u32x4 w; w.x = cvt_pk_bf16(v0[0], v0[1]); w.y = cvt_pk_bf16(v0[2], v0[3]); w.z = cvt_pk_bf16(v1[0], v1[1]); w.w = cvt_pk_bf16(v1[2], v1[3]);
                    *(u32x4*)(rowp + bj * HALF) = w; } }
    }
};
template <class Epi, class Sched, bool ALIGN_EPI = false, bool SP2 = false>
__device__ __forceinline__ void gemm_phase(PG8_LAS unsigned char* lds, const Gemm g, const Sched& S, const Epi& E) {
    const int tid = threadIdx.x, wid = __builtin_amdgcn_readfirstlane(tid >> 6), lane = tid & 63, wr = wid >> 2, wc = wid & 3, fr = lane & 15, fq = lane >> 4;
    const int K = g.K, nt = K / BK;
    unsigned voffA[2], voffB[2];
#pragma unroll
    for (int i = 0; i < 2; ++i) { int R, C; stage_rc(tid * 16 + i * 8192, R, C); const int Rb = Epi::PERM ? ((R & ~31) + perm32(R & 31)) : R;
        voffA[i] = (unsigned)(R * K + C) * 2u; voffB[i] = (unsigned)(Rb * K + C) * 2u; }
    const size_t kstep = (size_t)(BK * 2);
    const size_t hstep = (size_t)HALF * K * 2;
    const size_t tstep = 2 * hstep;
    const unsigned ldsw = (unsigned)wid * 1024u;
    const int aoff = lds_byte(wr * 64 + fr, fq * 8), boff = lds_byte(wc * 32 + fr, fq * 8);
#define PG8_SA(b, h) (((b) * 2 + (h)) * HTB)
#define PG8_SB(b, h) ((4 + (b) * 2 + (h)) * HTB)
#define PG8_STAGE(bufoff, gbase, voff) do { _Pragma("unroll") for (int _i = 0; _i < 2; ++_i) \
        __builtin_amdgcn_global_load_lds((const unsigned*)((const char*)(gbase) + (voff)[_i]), (PG8_LAS unsigned*)(lds + (bufoff) + ldsw + _i * 8192), 16, 0, 0); } while (0)
#define PG8_LDA(dst, b, h) do { _Pragma("unroll") for (int m = 0; m < 4; ++m) _Pragma("unroll") for (int k = 0; k < 2; ++k) dst[m][k] = *(const PG8_LAS bf16x8*)(lds + PG8_SA(b, h) + aoff + m * 2048 + k * 1024); } while (0)
#define PG8_LDB(dst, b, h) do { _Pragma("unroll") for (int n = 0; n < 2; ++n) _Pragma("unroll") for (int k = 0; k < 2; ++k) dst[n][k] = *(const PG8_LAS bf16x8*)(lds + PG8_SB(b, h) + boff + n * 2048 + k * 1024); } while (0)
#define PG8_MMA(ai, bj, At, Bt) do { __builtin_amdgcn_s_setprio(1); _Pragma("unroll") for (int m = 0; m < 4; ++m) _Pragma("unroll") for (int n = 0; n < 2; ++n) _Pragma("unroll") for (int k = 0; k < 2; ++k) \
        acc[ai][bj][m][n] = __builtin_amdgcn_mfma_f32_16x16x32_bf16(Bt[n][k], At[m][k], acc[ai][bj][m][n], 0, 0, 0); __builtin_amdgcn_s_setprio(0); } while (0)
#define PG8_WAIT_V(n) asm volatile("s_waitcnt vmcnt(" #n ")" ::: "memory")
#define PG8_WAIT_L(n) asm volatile("s_waitcnt lgkmcnt(" #n ")" ::: "memory")
#define PG8_BAR __builtin_amdgcn_s_barrier()
#define PG8_SCHED __builtin_amdgcn_sched_barrier(0)
    Unit cur, nxt; int ui = 0;
    if (!S.next(0, cur)) return;
    f32x4 acc[2][2][4][2];
#pragma unroll
    for (int a = 0; a < 2; ++a)
#pragma unroll
        for (int b = 0; b < 2; ++b)
#pragma unroll
            for (int m = 0; m < 4; ++m)
#pragma unroll
                for (int n = 0; n < 2; ++n) acc[a][b][m][n] = (f32x4){0.f, 0.f, 0.f, 0.f};
    bf16x8 At[4][2], B0[2][2], B1[2][2];
    const char* cA = (const char*)g.A + (size_t)cur.pm * tstep; const char* cB = (const char*)g.Bt + (size_t)cur.pn * tstep + (size_t)cur.e * g.estride;
    S.a_ready(cur);
    if constexpr (SP2) {
        PG8_STAGE(PG8_SB(0, 0), cB, voffB); PG8_STAGE(PG8_SB(0, 1), cB + hstep, voffB); PG8_STAGE(PG8_SA(0, 0), cA, voffA); PG8_STAGE(PG8_SA(0, 1), cA + hstep, voffA);
        if (wr == 1) PG8_BAR;
        PG8_WAIT_V(2); PG8_BAR;
        PG8_STAGE(PG8_SB(1, 0), cB + kstep, voffB); PG8_STAGE(PG8_SA(1, 0), cA + kstep, voffA); PG8_STAGE(PG8_SB(1, 1), cB + hstep + kstep, voffB);
        PG8_WAIT_V(6); PG8_BAR;
    } else {
        PG8_STAGE(PG8_SB(0, 0), cB, voffB); PG8_STAGE(PG8_SA(0, 0), cA, voffA); PG8_STAGE(PG8_SB(0, 1), cB + hstep, voffB); PG8_STAGE(PG8_SA(0, 1), cA + hstep, voffA);
        if (wr == 1) PG8_BAR;
        PG8_WAIT_V(4); PG8_BAR;
        PG8_STAGE(PG8_SB(1, 0), cB + kstep, voffB); PG8_STAGE(PG8_SA(1, 0), cA + kstep, voffA); PG8_STAGE(PG8_SB(1, 1), cB + hstep + kstep, voffB);
        PG8_WAIT_V(6); PG8_BAR;
    }
    for (;;) {
        const bool has_next = S.next(ui + 1, nxt);
        const char* nA = has_next ? (const char*)g.A + (size_t)nxt.pm * tstep : cA; const char* nB = has_next ? (const char*)g.Bt + (size_t)nxt.pn * tstep + (size_t)nxt.e * g.estride : cB;
        for (int t = 0; t < nt; t += 2) {
            const bool last = (t == nt - 2);
            const char* a1 = cA + (size_t)(t + 1) * kstep;
            const char* a2 = last ? nA : cA + (size_t)(t + 2) * kstep; const char* b2 = last ? nB : cB + (size_t)(t + 2) * kstep;
            const char* a3 = a2 + kstep; const char* b3 = b2 + kstep;
            if (last && has_next) S.a_ready(nxt);
            if constexpr (SP2) {
            PG8_LDB(B0, 0, 0); PG8_LDB(B1, 0, 1); PG8_SCHED; PG8_LDA(At, 0, 0); PG8_STAGE(PG8_SA(1, 1), a1 + hstep, voffA);
            PG8_WAIT_V(8); PG8_WAIT_L(0); PG8_BAR; PG8_MMA(0, 0, At, B0); PG8_MMA(0, 1, At, B1); PG8_BAR; PG8_SCHED;
            PG8_LDA(At, 0, 1); PG8_STAGE(PG8_SB(0, 0), b2, voffB); PG8_STAGE(PG8_SB(0, 1), b2 + hstep, voffB); PG8_STAGE(PG8_SA(0, 0), a2, voffA);
            PG8_WAIT_V(8); PG8_WAIT_L(0); PG8_BAR; PG8_MMA(1, 0, At, B0); PG8_MMA(1, 1, At, B1); PG8_BAR; PG8_SCHED;
            PG8_LDB(B0, 1, 0); PG8_LDB(B1, 1, 1); PG8_SCHED; PG8_LDA(At, 1, 0); PG8_STAGE(PG8_SA(0, 1), a2 + hstep, voffA);
            PG8_WAIT_V(8); PG8_WAIT_L(0); PG8_BAR; PG8_MMA(0, 0, At, B0); PG8_MMA(0, 1, At, B1); PG8_BAR; PG8_SCHED;
            PG8_LDA(At, 1, 1); PG8_STAGE(PG8_SB(1, 0), b3, voffB); PG8_STAGE(PG8_SB(1, 1), b3 + hstep, voffB); PG8_STAGE(PG8_SA(1, 0), a3, voffA);
            PG8_WAIT_V(8); PG8_WAIT_L(0); PG8_BAR; PG8_MMA(1, 0, At, B0); PG8_MMA(1, 1, At, B1); PG8_BAR; PG8_SCHED;
            } else {
            PG8_LDB(B0, 0, 0); PG8_SCHED; PG8_LDA(At, 0, 0); PG8_STAGE(PG8_SA(1, 1), a1 + hstep, voffA);
            PG8_WAIT_L(8); PG8_BAR; PG8_WAIT_L(0); PG8_MMA(0, 0, At, B0); PG8_BAR; PG8_SCHED;
            PG8_LDB(B1, 0, 1); PG8_STAGE(PG8_SB(0, 0), b2, voffB);
            PG8_BAR; PG8_WAIT_L(0); PG8_MMA(0, 1, At, B1); PG8_BAR;
            PG8_LDA(At, 0, 1); PG8_STAGE(PG8_SA(0, 0), a2, voffA);
            PG8_BAR; PG8_WAIT_L(0); PG8_MMA(1, 0, At, B0); PG8_BAR; PG8_SCHED;
            PG8_STAGE(PG8_SB(0, 1), b2 + hstep, voffB);
            PG8_WAIT_V(6); PG8_BAR; PG8_MMA(1, 1, At, B1); PG8_BAR;
            PG8_LDB(B0, 1, 0); PG8_SCHED; PG8_LDA(At, 1, 0); PG8_STAGE(PG8_SA(0, 1), a2 + hstep, voffA);
            PG8_WAIT_L(8); PG8_BAR; PG8_WAIT_L(0); PG8_MMA(0, 0, At, B0); PG8_BAR; PG8_SCHED;
            PG8_LDB(B1, 1, 1); PG8_STAGE(PG8_SB(1, 0), b3, voffB);
            PG8_BAR; PG8_WAIT_L(0); PG8_MMA(0, 1, At, B1); PG8_BAR;
            PG8_LDA(At, 1, 1); PG8_STAGE(PG8_SA(1, 0), a3, voffA);
            PG8_BAR; PG8_WAIT_L(0); PG8_MMA(1, 0, At, B0); PG8_BAR; PG8_SCHED;
            PG8_STAGE(PG8_SB(1, 1), b3 + hstep, voffB);
            PG8_WAIT_V(6); PG8_BAR; PG8_MMA(1, 1, At, B1); PG8_BAR;
            }
        }
        if constexpr (ALIGN_EPI) { if (wr == 0) PG8_BAR; }
        if constexpr (!Epi::AFTER_DRAIN) { E(acc, cur, wr, wc, fr, fq); S.done(cur); }
        if (!has_next) break;
#pragma unroll
        for (int a = 0; a < 2; ++a)
#pragma unroll
            for (int b = 0; b < 2; ++b)
#pragma unroll
                for (int m = 0; m < 4; ++m)
#pragma unroll
                    for (int n = 0; n < 2; ++n) acc[a][b][m][n] = (f32x4){0.f, 0.f, 0.f, 0.f};
        cur = nxt; cA = nA; cB = nB; ++ui;
        if constexpr (ALIGN_EPI) { if (wr == 1) PG8_BAR; }
    }
    PG8_WAIT_V(0);
    if constexpr (!ALIGN_EPI) { if (wr == 0) PG8_BAR; }
    PG8_BAR;
    if constexpr (Epi::AFTER_DRAIN) { E.fused(acc, cur, wr, wc, fr, fq, lds, wid, lane); S.done(cur); }
#undef PG8_SA
#undef PG8_SB
#undef PG8_STAGE
#undef PG8_LDA
#undef PG8_LDB
#undef PG8_MMA
#undef PG8_WAIT_V
#undef PG8_WAIT_L
#undef PG8_BAR
#undef PG8_SCHED
}
}
#define GAS __attribute__((address_space(1)))
#define LAS __attribute__((address_space(3)))
typedef GAS unsigned gu32;
typedef GAS unsigned long long gu64;
#define RLX_AGENT __ATOMIC_RELAXED, __HIP_MEMORY_SCOPE_AGENT
#define LDS_WAIT() asm volatile("s_waitcnt lgkmcnt(0)" ::: "memory")
#define VM_WAIT() asm volatile("s_waitcnt vmcnt(0)" ::: "memory")
#define XB_TMO      128
#define XB_XCNT(j)  (256  + 64 * (j))
#define XB_XSUB(j)  (1280 + 64 * (j))
#define XB_XGEN(j)  (2304 + 64 * (j))
#define XB_TOP      3328
#define XB_TOPGEN   3392
#define XCD_BAR_WORDS 3456
#define XB_SPIN_CAP (1u << 18)

__device__ __forceinline__ unsigned xb_ld(unsigned* p)              { return __hip_atomic_load(p, __ATOMIC_RELAXED, __HIP_MEMORY_SCOPE_AGENT); }
__device__ __forceinline__ unsigned xb_add(unsigned* p, unsigned v) { return __hip_atomic_fetch_add(p, v, __ATOMIC_RELAXED, __HIP_MEMORY_SCOPE_AGENT); }
__device__ __forceinline__ unsigned xb_xcc_id() { return (unsigned)__builtin_amdgcn_s_getreg((3 << 11) | 20) & 0xFu; }
#define XB_SPIN(cond, bar) do { unsigned _sp = 0; while (cond) { __builtin_amdgcn_s_sleep(1); \
    if ((++_sp & 255u) == 0u) { if (xb_ld(&(bar)[XB_TMO])) break; if (_sp > XB_SPIN_CAP) { atomicAdd(&(bar)[XB_TMO], 1u); break; } } } } while (0)

struct XcdBarrier {
    unsigned* bar; unsigned x;
    volatile LAS unsigned* st;
};

__device__ __forceinline__ XcdBarrier xcd_barrier_post(unsigned* bar, volatile LAS unsigned* st) {
    XcdBarrier b; b.bar = bar; b.x = xb_xcc_id(); b.st = st;
    if (threadIdx.x == 0) (void)xb_add(&bar[XB_XCNT(b.x)], 1u);
    return b;
}
__device__ __forceinline__ void xcd_barrier_complete(unsigned* bar, unsigned x, unsigned& nloc, unsigned& nx) {
    const unsigned G = gridDim.x * gridDim.y * gridDim.z;
    unsigned sum, cnt, mine, sp = 0u;
    for (;;) {
        sum = 0u; cnt = 0u; mine = 0u;
#pragma unroll
        for (unsigned j = 0; j < 16; ++j) { const unsigned c = xb_ld(&bar[XB_XCNT(j)]); sum += c; cnt += (c > 0u) ? 1u : 0u; mine = (j == x) ? c : mine; }
        if (sum == G) break;
        __builtin_amdgcn_s_sleep(1);
        if ((++sp & 255u) == 0u) { if (xb_ld(&bar[XB_TMO])) break; if (sp > XB_SPIN_CAP) { atomicAdd(&bar[XB_TMO], 1u); break; } }
    }
    nloc = mine > 0u ? mine : 1u; nx = cnt > 0u ? cnt : 1u;
}

__device__ __forceinline__ void xcd_barrier(const XcdBarrier& b) {
    asm volatile("s_waitcnt vmcnt(0)" ::: "memory");
    __syncthreads();
    if (threadIdx.x == 0) {
        unsigned* bar = b.bar;
        __builtin_amdgcn_s_waitcnt(0);
        unsigned nloc = b.st[0], nx = b.st[1];
        if (nloc == 0u) { xcd_barrier_complete(bar, b.x, nloc, nx); b.st[0] = nloc; b.st[1] = nx; }
        const unsigned old = xb_add(&bar[XB_XSUB(b.x)], 1u);
        const unsigned gen = old / nloc;
        if (old + 1u == (gen + 1u) * nloc) {
            __builtin_amdgcn_fence(__ATOMIC_RELEASE, "agent");
            asm volatile("s_waitcnt vmcnt(0)" ::: "memory");
            const unsigned og = xb_add(&bar[XB_TOP], 1u);
            const unsigned tg = og / nx;
            if (og + 1u == (tg + 1u) * nx) xb_add(&bar[XB_TOPGEN], 1u);
            else XB_SPIN(xb_ld(&bar[XB_TOPGEN]) == tg, bar);
            __builtin_amdgcn_fence(__ATOMIC_ACQUIRE, "agent");
            xb_add(&bar[XB_XGEN(b.x)], 1u);
            asm volatile("s_waitcnt vmcnt(0)" ::: "memory");
        } else {
            XB_SPIN(xb_ld(&bar[XB_XGEN(b.x)]) == gen, bar);
            __builtin_amdgcn_fence(__ATOMIC_ACQUIRE, "agent");
            asm volatile("s_waitcnt vmcnt(0)" ::: "memory");
        }
    }
    __syncthreads();
}
namespace at {
constexpr int D = 128; constexpr float THR = 8.f; constexpr bool WSKIP = false; constexpr int WBIG = 1 << 30;
constexpr float SCALE = 0.08838834764831845f;
constexpr int NW = 8, QBLK = 32, KVBLK = 64, QB = NW * QBLK;
constexpr int SHM_V = KVBLK * D * 2, SHM_K = KVBLK * D * 2;
constexpr int LDS_BODY = 2 * SHM_V + 2 * SHM_K + NW * 64 * 4;
constexpr int LDS_BIAS = LDS_BODY, LDS_BYTES = LDS_BODY + 8192 * 4;
using bf16 = unsigned short;
typedef short bf16x8 __attribute__((ext_vector_type(8)));
typedef short s16x4 __attribute__((ext_vector_type(4)));
typedef float f32x16 __attribute__((ext_vector_type(16)));
typedef float f32x4 __attribute__((ext_vector_type(4)));
typedef unsigned u32x4 __attribute__((ext_vector_type(4)));
template <class A, class Bt> struct same_t { static constexpr bool v = false; };
template <class A> struct same_t<A, A> { static constexpr bool v = true; };

#define KSWZ(row, colB) ((row) * 256 + ((colB) ^ (((row) & 7) << 4)))
#define SBAR() __builtin_amdgcn_sched_barrier(0)
__device__ __forceinline__ int v_st(int k, int c) { const int kk = (k & ~0xC) | ((k & 4) << 1) | ((k & 8) >> 1); return ((kk >> 3) * 4 + (c >> 5)) * 512 + ((kk & 7) * 32 + (c & 31)) * 2; }
__device__ __forceinline__ int v_rd_base(int lane) { return ((lane & 3) << 3) | (((lane >> 2) & 3) << 6) | (((lane >> 4) & 1) << 5) | (((lane >> 5) & 1) << 8); }
constexpr int v_rd_off(int d0, int ks, int half) { return d0 * 512 + ks * 4096 + half * 2048; }
__device__ __forceinline__ int crow(int r, int hi) { return (r & 3) + 8 * (r >> 2) + 4 * hi; }
__device__ __forceinline__ unsigned cvtpk(float lo, float hi) {
    unsigned r; asm volatile("v_cvt_pk_bf16_f32 %0, %1, %2" : "=v"(r) : "v"(lo), "v"(hi)); return r;
}
__device__ __forceinline__ bf16x8 pack8(f32x4 a, f32x4 b) {
    u32x4 w = {cvtpk(a[0], a[1]), cvtpk(a[2], a[3]), cvtpk(b[0], b[1]), cvtpk(b[2], b[3])};
    return *reinterpret_cast<bf16x8*>(&w);
}
template <class T> __device__ __forceinline__ bf16x8 load8(const T* p) {
    if constexpr (same_t<T, float>::v) { return pack8(*(const f32x4*)p, *(const f32x4*)(p + 4)); }
    else { return *reinterpret_cast<const bf16x8*>(p); }
}
template <int MODE> __device__ __forceinline__ void mask_tile(f32x16& p0, f32x16& p1, int dq, unsigned W) {
    const float NEG = MODE ? 0.f : -__builtin_inff();
#pragma unroll
    for (int r = 0; r < 16; ++r) {
        const int c = (r & 3) + 8 * (r >> 2);
        if ((unsigned)(dq - c) >= W) p0[r] = NEG;
        if ((unsigned)(dq - c - 32) >= W) p1[r] = NEG;
    }
}
__device__ __forceinline__ void partialRet(f32x16& p0, float rowfac) { for (int r = 0; r < 16; ++r) p0[r] *= rowfac; }
__device__ __forceinline__ void partialSM(f32x16& p0, f32x16& p1, float& m_reg, float& mn, float& alpha) {
    float pmax = p0[0]; for (int r = 1; r < 16; ++r) pmax = fmaxf(pmax, p0[r]); for (int r = 0; r < 16; ++r) pmax = fmaxf(pmax, p1[r]);
    { auto rr = __builtin_amdgcn_permlane32_swap(__float_as_uint(pmax), __float_as_uint(pmax), false, false);
      pmax = fmaxf(__uint_as_float(rr[0]), __uint_as_float(rr[1])); }
    constexpr float C2 = 1.4426950408889634f * SCALE;
    if (__builtin_expect(__all((pmax - m_reg) * SCALE <= THR), 1)) { mn = m_reg; alpha = 1.f; }
    else { mn = fmaxf(m_reg, pmax); alpha = __builtin_amdgcn_exp2f((m_reg - mn) * C2); m_reg = mn; }
    const float mnL = -mn * C2;
    for (int r = 0; r < 16; ++r) p0[r] = fmaf(p0[r], C2, mnL); for (int r = 0; r < 16; ++r) p1[r] = fmaf(p1[r], C2, mnL);
    for (int r = 0; r < 16; ++r) p0[r] = __builtin_amdgcn_exp2f(p0[r]);
}
template <int MODE> __device__ __forceinline__ void finishSM(f32x16& p0, f32x16& p1, float alpha, float& l_reg, bf16x8& pa0, bf16x8& pa1, bf16x8& pa2, bf16x8& pa3) {
    if constexpr (MODE == 0) {
    for (int r = 0; r < 16; ++r) p1[r] = __builtin_amdgcn_exp2f(p1[r]);
    float ps = 0; for (int r = 0; r < 16; ++r) ps += p0[r]; for (int r = 0; r < 16; ++r) ps += p1[r];
    { auto rr = __builtin_amdgcn_permlane32_swap(__float_as_uint(ps), __float_as_uint(ps), false, false);
      ps = __uint_as_float(rr[0]) + __uint_as_float(rr[1]); }
    l_reg = l_reg * alpha + ps;
    } else { for (int r = 0; r < 16; ++r) p1[r] *= alpha; }
#define PK4(P, B_, OUT) do { unsigned a0 = cvtpk(P[B_+0], P[B_+1]), a1 = cvtpk(P[B_+2], P[B_+3]);                          \
        unsigned b0 = cvtpk(P[B_+4], P[B_+5]), b1 = cvtpk(P[B_+6], P[B_+7]);                                             \
        auto r0 = __builtin_amdgcn_permlane32_swap(a0, b0, false, false); auto r1 = __builtin_amdgcn_permlane32_swap(a1, b1, false, false); \
        u32x4 w = {r0[0], r1[0], r0[1], r1[1]}; OUT = *reinterpret_cast<bf16x8*>(&w); } while (0)
    PK4(p0, 0, pa0); PK4(p0, 8, pa1); PK4(p1, 0, pa2); PK4(p1, 8, pa3);
#undef PK4
}
template <int KB, bool SK, int MODE>
__device__ __forceinline__ void qkt(f32x16& p0, f32x16& p1, const char* K_lds, int r32, int hi, const bf16x8* qr, bool act, const float* bt) {
    if (SK && !act) { const float NEG = -__builtin_inff();
#pragma unroll
        for (int r = 0; r < 16; ++r) { p0[r] = NEG; p1[r] = NEG; } return; }
    if constexpr (MODE == 0) {
        const f32x4 b0 = *(const f32x4*)(bt), b1 = *(const f32x4*)(bt + 8), b2 = *(const f32x4*)(bt + 16), b3 = *(const f32x4*)(bt + 24);
        const f32x4 c0 = *(const f32x4*)(bt + 32), c1 = *(const f32x4*)(bt + 40), c2 = *(const f32x4*)(bt + 48), c3 = *(const f32x4*)(bt + 56);
        p0 = f32x16{b0[0], b0[1], b0[2], b0[3], b1[0], b1[1], b1[2], b1[3], b2[0], b2[1], b2[2], b2[3], b3[0], b3[1], b3[2], b3[3]};
        p1 = f32x16{c0[0], c0[1], c0[2], c0[3], c1[0], c1[1], c1[2], c1[3], c2[0], c2[1], c2[2], c2[3], c3[0], c3[1], c3[2], c3[3]};
    } else { p0 = f32x16{}; p1 = f32x16{}; }
    const char* kb[4];
#pragma unroll
    for (int dd = 0; dd < 4; ++dd) kb[dd] = K_lds + KB * SHM_K + KSWZ(r32, (dd * 16 + hi * 8) * 2);
#pragma unroll
    for (int d0 = 0; d0 < 8; ++d0) { const char* a = kb[d0 & 3] + (d0 >> 2) * 128;
        bf16x8 b0 = *reinterpret_cast<const bf16x8*>(a);
        bf16x8 b1 = *reinterpret_cast<const bf16x8*>(a + 32 * 256);
        p0 = __builtin_amdgcn_mfma_f32_32x32x16_bf16(b0, qr[d0], p0, 0, 0, 0);
        p1 = __builtin_amdgcn_mfma_f32_32x32x16_bf16(b1, qr[d0], p1, 0, 0, 0); }
}
template <int VB, bool SK>
__device__ __forceinline__ void pv_tile(f32x16* o, int vb0, bf16x8 pa0, bf16x8 pa1, bf16x8 pa2, bf16x8 pa3, bool act) {
    if (SK && !act) return;
#define TRRD(dst, off) asm volatile("ds_read_b64_tr_b16 %0, %1 offset:%2" : "=&v"(dst) : "v"(vb0), "i"(off) : "memory")
#define PV_D0(d0) do { s16x4 l0, l1, l2, l3, h0, h1, h2, h3; constexpr int b_ = VB * SHM_V + v_rd_off(d0, 0, 0);     \
        TRRD(l0, b_); TRRD(h0, b_ + 2048); TRRD(l1, b_ + 4096); TRRD(h1, b_ + 6144); TRRD(l2, b_ + 8192); TRRD(h2, b_ + 10240); TRRD(l3, b_ + 12288); TRRD(h3, b_ + 14336); \
        asm volatile("s_waitcnt lgkmcnt(0)" ::: "memory"); SBAR();                 \
        o[d0] = __builtin_amdgcn_mfma_f32_32x32x16_bf16(pa0, (bf16x8){l0[0], l0[1], l0[2], l0[3], h0[0], h0[1], h0[2], h0[3]}, o[d0], 0, 0, 0);   \
        o[d0] = __builtin_amdgcn_mfma_f32_32x32x16_bf16(pa1, (bf16x8){l1[0], l1[1], l1[2], l1[3], h1[0], h1[1], h1[2], h1[3]}, o[d0], 0, 0, 0);   \
        o[d0] = __builtin_amdgcn_mfma_f32_32x32x16_bf16(pa2, (bf16x8){l2[0], l2[1], l2[2], l2[3], h2[0], h2[1], h2[2], h2[3]}, o[d0], 0, 0, 0);   \
        o[d0] = __builtin_amdgcn_mfma_f32_32x32x16_bf16(pa3, (bf16x8){l3[0], l3[1], l3[2], l3[3], h3[0], h3[1], h3[2], h3[3]}, o[d0], 0, 0, 0); } while (0)
    PV_D0(0); PV_D0(1); PV_D0(2); PV_D0(3);
#undef PV_D0
#undef TRRD
}

template <class TIn, class TOut> struct BlockRef { const TIn* Q; const TIn* K; const TIn* V; TOut* O; int P0; int jlo; int bh; };
template <class TIn> struct NextRef { const TIn* Q; const TIn* K; const TIn* V; int jlo; };
template <class TIn> struct Extra { const float* bias; const TIn* G; const float* nw; };
constexpr int LDO = 2048;
template <class TIn> struct Seam {
    bf16x8 qr[8];
    bf16x8 st_v0, st_v1, st_k0, st_k1; f32x4 sf0, sf1, sf2, sf3;
    f32x4 tq[16];
};
#define ROW(p, k0, rr) ((p) + (unsigned)(((k0) + (rr)) * D + sc))
#define VMW() asm volatile("s_waitcnt vmcnt(0)" ::: "memory")
#define VMWN(n) asm volatile("s_waitcnt vmcnt(%0)" :: "i"(n) : "memory")
#define SLOAD_H(Kp, Vp, k0) do { S.st_v0 = load8<TIn>(ROW(Vp, k0, sr)); S.st_v1 = load8<TIn>(ROW(Vp, k0, 32 + sr));              \
                         S.st_k0 = load8<TIn>(ROW(Kp, k0, sr)); S.st_k1 = load8<TIn>(ROW(Kp, k0, 32 + sr)); } while (0)
#define SWRITE_HK(bf) do { *(bf16x8*)(K_lds + (bf) * SHM_K + kws) = S.st_k0; *(bf16x8*)(K_lds + (bf) * SHM_K + kws + 32 * 256) = S.st_k1; } while (0)
#define SWRITE_HV(bf) do { *(bf16x8*)(V_lds + (bf) * SHM_V + vst0) = S.st_v0; *(bf16x8*)(V_lds + (bf) * SHM_V + vst1) = S.st_v1; } while (0)
#define SWRITE_H(bf) do { SWRITE_HV(bf); SWRITE_HK(bf); } while (0)
#define SLOAD_F(p, k0) do { S.sf0 = *(const f32x4*)ROW(p, k0, sr); S.sf1 = *(const f32x4*)(ROW(p, k0, sr) + 4);                \
                            S.sf2 = *(const f32x4*)ROW(p, k0, 32 + sr); S.sf3 = *(const f32x4*)(ROW(p, k0, 32 + sr) + 4); } while (0)
#define SWRITE_KF(bf) do { *(bf16x8*)(K_lds + (bf) * SHM_K + kws) = pack8(S.sf0, S.sf1); *(bf16x8*)(K_lds + (bf) * SHM_K + kws + 32 * 256) = pack8(S.sf2, S.sf3); } while (0)
#define SWRITE_VF(bf) do { *(bf16x8*)(V_lds + (bf) * SHM_V + vst0) = pack8(S.sf0, S.sf1); *(bf16x8*)(V_lds + (bf) * SHM_V + vst1) = pack8(S.sf2, S.sf3); } while (0)
template <class TIn, class TOut>
__device__ __forceinline__ void causal_swa_prime(const BlockRef<TIn, TOut>& cur, int W, char* lds, Seam<TIn>& S) {
    constexpr bool F32 = same_t<TIn, float>::v;
    const int tid = threadIdx.x, wid = __builtin_amdgcn_readfirstlane(tid >> 6), lane = tid & 63, r32 = lane & 31, hi = lane >> 5;
    const int sr = tid >> 4, sc = (tid & 15) * 8, kws = KSWZ(sr, sc * 2); char* K_lds = lds + 2 * SHM_V;
    const int kb0 = cur.jlo * KVBLK;
    for (int d0 = 0; d0 < 8; ++d0) S.qr[d0] = load8<TIn>(cur.Q + (unsigned)((wid * QBLK + r32) * D + d0 * 16 + hi * 8));
    if constexpr (F32) { SLOAD_F((const float*)cur.K, kb0); VMW(); SWRITE_KF(0); SBAR(); SLOAD_F((const float*)cur.V, kb0); }
    else { SLOAD_H(cur.K, cur.V, kb0); VMW(); SWRITE_HK(0); }
    __syncthreads();
}
template <int MODE, class TIn, class TOut>
__device__ __forceinline__ void causal_swa_block(const BlockRef<TIn, TOut>& cur, const NextRef<TIn>& nxt, const Extra<TIn>& X, int skv, int W, char* lds, Seam<TIn>& S) {
    constexpr bool F32 = same_t<TIn, float>::v;
    int tid_ = threadIdx.x; asm volatile("" : "+v"(tid_));
    const int tid = tid_, wid = __builtin_amdgcn_readfirstlane(tid >> 6), lane = tid & 63, r32 = lane & 31, hi = lane >> 5;
    const int j_lo = cur.jlo;
    int j_hi = (cur.P0 + QB - 1) / KVBLK + 1; if (j_hi > skv / KVBLK) j_hi = skv / KVBLK;
    const int NT = j_hi - j_lo;
    const int kbn = nxt.jlo * KVBLK;
    const int qlo = cur.P0 + wid * QBLK, qm = qlo + r32 - 4 * hi;
    char* V_lds = lds; char* K_lds = lds + 2 * SHM_V;
    float* ws = (float*)(lds + 2 * SHM_V + 2 * SHM_K) + wid * 64; float* li_l = ws, * al_l = ws + 32;
    float m_reg = -1e30f, l_reg = 0; f32x16 o[4] = {};
    const int sr = tid >> 4, sc = (tid & 15) * 8, vst0 = v_st(sr, sc), vst1 = v_st(32 + sr, sc), kws = KSWZ(sr, sc * 2);
    const int vb0 = (int)(uintptr_t)V_lds + v_rd_base(lane);
    const TIn* Kh = cur.K; const TIn* Vh = cur.V;
    const float* bl = (const float*)(lds + LDS_BIAS) + 4 * hi;
    if constexpr (MODE == 0) { for (int i = tid; i < NT * 16; i += 64 * NW) *(f32x4*)(lds + LDS_BIAS + i * 16) = *(const f32x4*)(X.bias + (size_t)cur.bh * 8192 + j_lo * KVBLK + i * 4); __syncthreads(); }
    const float l2g = MODE ? log2f(1.f - exp2f(-5.f - (float)(cur.bh & 7))) : 0.f;
#define BT(t) (bl + (t) * KVBLK)
#define PSM(P0_, P1_, mnX, alX, t) do { if constexpr (MODE == 0) partialSM(P0_, P1_, m_reg, mnX, alX); else { alX = __builtin_amdgcn_exp2f(l2g * (float)(qlo + r32 - KBASE(t))); partialRet(P0_, alX); } } while (0)
#define RESC(a) do { if (MODE == 0 && __any((a) < 1.f)) { if (hi == 0) al_l[r32] = (a); asm volatile("s_waitcnt lgkmcnt(0)" ::: "memory");              \
                     for (int d_ = 0; d_ < 4; ++d_) for (int r = 0; r < 16; ++r) o[d_][r] *= al_l[crow(r, hi)]; } } while (0)
#define KBASE(t) ((j_lo + (t)) * KVBLK)
#define ACT(t) (KBASE(t) <= qlo + QBLK - 1 && KBASE(t) + KVBLK - 1 >= qlo - W + 1)
#define MASKT(P0_, P1_, t) do { const int kb_ = KBASE(t); if ((!SK || ACT(t)) && (kb_ + KVBLK - 1 > qlo || kb_ <= qlo + QBLK - 1 - W)) mask_tile<MODE>(P0_, P1_, qm - kb_, (unsigned)W); } while (0)
    constexpr int NQL = F32 ? 16 : 8;
    constexpr bool SK = WSKIP && !F32;
#define SEAM_K0() do { VMWN(NQL); if constexpr (F32) { SWRITE_KF(0); SBAR(); SLOAD_F((const float*)nxt.V, kbn); } else { SWRITE_HK(0); } SBAR(); } while (0)
    f32x16 pA0, pA1, pB0, pB1; float mnA, mnB, alA, alB; bf16x8 pa0, pa1, pa2, pa3;
    if constexpr (F32) { VMW(); SWRITE_VF(0); SBAR(); } else { SWRITE_HV(0); SBAR(); }
    if (NT > 1) { if constexpr (F32) SLOAD_F((const float*)Kh, KBASE(1)); else SLOAD_H(Kh, Vh, KBASE(1)); }
    SBAR(); qkt<0, SK, MODE>(pA0, pA1, K_lds, r32, hi, S.qr, ACT(0), BT(0));
    if constexpr (F32) { if (NT > 1) { VMW(); SWRITE_KF(1); SBAR(); SLOAD_F((const float*)Vh, KBASE(1)); } }
    MASKT(pA0, pA1, 0); PSM(pA0, pA1, mnA, alA, 0);
    if (NT > 1) { VMW(); if constexpr (F32) { SWRITE_VF(1); SBAR(); if (NT > 2) SLOAD_F((const float*)Kh, KBASE(2)); } else SWRITE_H(1); }
    __syncthreads();
#define HALF_STEP(PX0, PX1, mnX, alX, PY0, PY1, alY, t, KB, VB, SB) do {                                                      \
        SBAR(); qkt<KB, SK, MODE>(PX0, PX1, K_lds, r32, hi, S.qr, ACT(t), BT(t));                                \
        finishSM<MODE>(PY0, PY1, alY, l_reg, pa0, pa1, pa2, pa3); SBAR();                                                           \
        if ((t) + 1 < NT) { if constexpr (F32) { VMW(); SWRITE_KF(SB); SBAR(); SLOAD_F((const float*)Vh, KBASE((t) + 1)); }  \
                            else { SLOAD_H(Kh, Vh, KBASE((t) + 1)); } SBAR(); }                                               \
        pv_tile<VB, SK>(o, vb0, pa0, pa1, pa2, pa3, ACT((t) - 1)); MASKT(PX0, PX1, (t)); PSM(PX0, PX1, mnX, alX, (t));                                        \
        __syncthreads();                                                                                                      \
        if ((t) + 1 < NT) { VMW(); if constexpr (F32) { SWRITE_VF(SB); SBAR(); if ((t) + 2 < NT) SLOAD_F((const float*)Kh, KBASE((t) + 2)); } \
                            else { SWRITE_H(SB); } }                                                                          \
        RESC(alX); __syncthreads(); } while (0)
    for (int t = 1; t + 1 < NT; t += 2) {
        HALF_STEP(pB0, pB1, mnB, alB, pA0, pA1, alA, t, 1, 0, 0);
        HALF_STEP(pA0, pA1, mnA, alA, pB0, pB1, alB, t + 1, 0, 1, 1);
    }
    const bool even = (NT & 1) == 0;
    if (even) { SBAR(); qkt<1, SK, MODE>(pB0, pB1, K_lds, r32, hi, S.qr, ACT(NT - 1), BT(NT - 1)); SBAR(); }
#define QROW(e) (nxt.Q + (size_t)(wid * QBLK + r32) * D + ((e) >> 1) * 16 + hi * 8 + ((e) & 1) * 4)
    if constexpr (F32) { SLOAD_F((const float*)nxt.K, kbn); SBAR();
#pragma unroll
        for (int e = 0; e < 8; ++e) S.tq[e] = *(const f32x4*)QROW(e); }
    else { SLOAD_H(nxt.K, nxt.V, kbn); SBAR();
#pragma unroll
        for (int d0 = 0; d0 < 8; ++d0) S.qr[d0] = load8<TIn>(nxt.Q + (unsigned)((wid * QBLK + r32) * D + d0 * 16 + hi * 8)); }
    SBAR();
    finishSM<MODE>(pA0, pA1, alA, l_reg, pa0, pa1, pa2, pa3); SBAR();
    if constexpr (F32) {
#pragma unroll
        for (int e = 8; e < 16; ++e) S.tq[e] = *(const f32x4*)QROW(e); SBAR(); }
#undef QROW
    pv_tile<0, SK>(o, vb0, pa0, pa1, pa2, pa3, ACT(even ? NT - 2 : NT - 1));
    if (even) { MASKT(pB0, pB1, NT - 1); PSM(pB0, pB1, mnB, alB, NT - 1); __syncthreads(); RESC(alB);
        finishSM<MODE>(pB0, pB1, alB, l_reg, pa0, pa1, pa2, pa3); SBAR(); pv_tile<1, SK>(o, vb0, pa0, pa1, pa2, pa3, ACT(NT - 1)); }
    SBAR(); SEAM_K0();
    float rli[16];
    if constexpr (MODE == 0) {
        if (hi == 0) li_l[r32] = l_reg; asm volatile("s_waitcnt lgkmcnt(0)" ::: "memory");
#pragma unroll
        for (int r = 0; r < 16; ++r) rli[r] = __builtin_amdgcn_rcpf(li_l[crow(r, hi)]);
    } else {
#pragma unroll
        for (int r = 0; r < 16; ++r) { float sq = (o[0][r] * o[0][r] + o[1][r] * o[1][r]) + (o[2][r] * o[2][r] + o[3][r] * o[3][r]);
            sq += __shfl_xor(sq, 1); sq += __shfl_xor(sq, 2); sq += __shfl_xor(sq, 4); sq += __shfl_xor(sq, 8); sq += __shfl_xor(sq, 16);
            rli[r] = rsqrtf(sq * (1.f / 128.f) + 1e-6f); }
    }
    { int t2 = threadIdx.x; asm volatile("" : "+v"(t2));
      const int w2 = __builtin_amdgcn_readfirstlane(t2 >> 6), c2 = t2 & 31, h2 = (t2 >> 5) & 1;
      TOut* Ow = cur.O + (unsigned)((w2 * QBLK + 4 * h2) * LDO + c2);
      float nwv[4] = {1.f, 1.f, 1.f, 1.f}; const TIn* Gp = nullptr;
      if constexpr (MODE == 1) { Gp = X.G + ((size_t)cur.bh * 8192 + cur.P0) * D + (unsigned)((w2 * QBLK + 4 * h2) * D + c2);
#pragma unroll
          for (int d0 = 0; d0 < 4; ++d0) nwv[d0] = X.nw[(cur.bh & 7) * D + d0 * 32 + c2]; }
#pragma unroll
      for (int r = 0; r < 16; ++r) { const int ro = (r & 3) + 8 * (r >> 2);
          float v[4];
#pragma unroll
          for (int d0 = 0; d0 < 4; ++d0) { v[d0] = o[d0][r] * rli[r];
              if constexpr (MODE == 1) { const unsigned gq = Gp[ro * D + d0 * 32]; v[d0] *= nwv[d0] * __uint_as_float(gq << 16); } }
#pragma unroll
          for (int d0 = 0; d0 < 4; ++d0) { const float vn = __shfl_xor(v[d0], 1);
              if ((c2 & 1) == 0) *(unsigned*)(Ow + ro * LDO + d0 * 32) = cvtpk(v[d0], vn); }
          if ((r & 3) == 3) asm volatile("" ::: "memory"); } }
    if constexpr (F32) {
#pragma unroll
        for (int d0 = 0; d0 < 8; ++d0) S.qr[d0] = pack8(S.tq[2 * d0], S.tq[2 * d0 + 1]); }
    __syncthreads();
#undef RESC
#undef BT
#undef PSM
#undef KBASE
#undef ACT
#undef MASKT
#undef SEAM_K0
#undef HALF_STEP
}
#undef ROW
#undef VMW
#undef VMWN
#undef SLOAD_H
#undef SWRITE_HK
#undef SWRITE_HV
#undef SWRITE_H
#undef SLOAD_F
#undef SWRITE_KF
#undef SWRITE_VF

}
constexpr int NWAVES = 8;
namespace W {
constexpr size_t CTL = 0, CTL_ZERO_BYTES = 1 * MiB;
constexpr size_t MOD = 1 * MiB, MODP = 2 * MiB, ROPE = 4 * MiB, LOGF = 8 * MiB, CUM = 9 * MiB, BIAS = 9 * MiB + 512 * 1024, ROUTE = 10 * MiB, TILE = 11 * MiB, JLO = 12 * MiB, WFR = 13 * MiB;
constexpr size_t XN = 16 * MiB, MIX = 80 * MiB, WT_IN = 144 * MiB, WT_OUT = 172 * MiB, WT_13 = 180 * MiB, WT_2 = 308 * MiB, QKV = 372 * MiB, END = 596 * MiB;
constexpr size_t H2 = XN, XS = QKV, ACT = QKV + 160 * MiB, Y = 16 * MiB;
constexpr size_t NV_RO = 596 * MiB, NV_UP = 596 * MiB, NV_Z = 144 * MiB, NV_END = 676 * MiB;
}
constexpr int CW_CNT = 0;
constexpr int CW_BAR = 4096;
constexpr int RING_OFF = 0, RING_BYTES = 131072, XCH_OFF = 131072, XCH_BYTES = 8192, MISC_OFF = XCH_OFF + XCH_BYTES, LDS_BYTES = 147456;

struct Args { const float* in[19]; float* out; unsigned char* ws; int ph_lo, ph_hi, li, pad; };

__device__ __forceinline__ float wave_sum(float v) {
#pragma unroll
    for (int o = 1; o < 64; o <<= 1) v += __shfl_xor(v, o);
    return v;
}
__device__ __forceinline__ unsigned pk2(float lo, float hi) { return f2bf(lo) | (f2bf(hi) << 16); }
__device__ __forceinline__ float log_sigmoid_f(float x) { return x >= 0.f ? -log1pf(expf(-x)) : x - log1pf(expf(x)); }

__device__ __forceinline__ void tr_item(const float* colp, size_t ldw, bf16_t* WT, int K, int k0, int n0, LAS float* scr, int lane) {
#pragma unroll 8
    for (int i = 0; i < 32; ++i) { const int kk = 2 * i + (lane >> 5); scr[kk * 33 + (lane & 31)] = colp[(size_t)(k0 + kk) * ldw]; }
    LDS_WAIT(); asm volatile("" ::: "memory");
    const int c = lane & 7;
#pragma unroll
    for (int j = 0; j < 4; ++j) { const int n = (lane >> 3) + 8 * j; const LAS float* s = scr + (8 * c) * 33 + n;
        uint4 o; o.x = pk2(s[0 * 33], s[1 * 33]); o.y = pk2(s[2 * 33], s[3 * 33]); o.z = pk2(s[4 * 33], s[5 * 33]); o.w = pk2(s[6 * 33], s[7 * 33]);
        *(uint4*)(WT + (size_t)(n0 + n) * K + k0 + 8 * c) = o; }
    LDS_WAIT(); asm volatile("" ::: "memory");
}
__device__ __forceinline__ int win_src(int n) {
    const int tt = n >> 10;
    if (tt < 3) return n;
    if (tt < 5) { const int d = n & 127; return 8 + (n & ~127) + (d & 1) * 64 + (d >> 1); }
    return n + 8;
}
__device__ __forceinline__ void ph0(const Args& a, LAS unsigned char* lds, int G) {
    const int tid = threadIdx.x, lane = tid & 63, wave = __builtin_amdgcn_readfirstlane(tid >> 6);
    unsigned char* ws = a.ws;
    LAS float* cact = (LAS float*)(lds + RING_OFF + 98304);
    const float* c = a.in[1]; const float* w_ada = a.in[2];
    for (int i = tid; i < 4096; i += 512) { const float cv = c[i]; cact[i] = cv / (1.f + expf(-cv)); }
    __syncthreads();
    float* modp = (float*)(ws + W::MODP);
    for (int it = blockIdx.x; it < 384; it += G) { const int cb = it % 24, ks = it / 24, j = cb * 512 + tid; float a0 = 0.f, a1 = 0.f;
#pragma unroll 8
        for (int k = ks * 128; k < ks * 128 + 128; ++k) { const float w = w_ada[(size_t)k * 12288 + j]; a0 += cact[k] * w; a1 += cact[2048 + k] * w; }
        modp[(ks * 2 + 0) * 12288 + j] = a0; modp[(ks * 2 + 1) * 12288 + j] = a1; }
    float2* rope = (float2*)(ws + W::ROPE);
    for (int i = blockIdx.x * 512 + tid; i < 8192 * 64; i += G * 512) { const int s = i >> 6, j = i & 63;
        const float theta = powf(10000.f, -(float)j / 64.f); const float ang = (float)s * theta;
        const double ad = (double)ang, TWO_PI = 6.283185307179586; const double kq = rint(ad / TWO_PI); const float r = (float)(ad - kq * TWO_PI);
        rope[i] = make_float2(cosf(r), sinf(r)); }
    { bf16_t* wfr = (bf16_t*)(ws + W::WFR); const float* w_fine = a.in[14];
      for (int i = blockIdx.x * 512 + tid; i < 8 * 16 * 64 * 8; i += G * 512) { const int e8 = i & 7, ln = (i >> 3) & 63, ks = (i >> 9) & 15, w = i >> 13, col = ln & 31, hf = ln >> 5;
          const float wv = w_fine[((size_t)(col >> 3) * 2048 + 256 * w + 16 * ks + 8 * hf + e8) * 8 + (col & 7)]; const unsigned h = f2bf(wv), l = f2bf(wv - __uint_as_float(h << 16));
          wfr[(((size_t)(w * 16 + ks) * 2 + 0) * 64 + ln) * 8 + e8] = (bf16_t)h; wfr[(((size_t)(w * 16 + ks) * 2 + 1) * 64 + ln) * 8 + e8] = (bf16_t)l; } }
    LAS float* scr = (LAS float*)(lds + RING_OFF + wave * 12288);
    const float* w_in = a.in[5]; const float* w_out = a.in[10]; const float* w1 = a.in[16]; const float* w3 = a.in[17]; const float* w2 = a.in[18];
    bf16_t* wt_in = (bf16_t*)(ws + W::WT_IN); bf16_t* wt_out = (bf16_t*)(ws + W::WT_OUT); bf16_t* wt_13 = (bf16_t*)(ws + W::WT_13); bf16_t* wt_2 = (bf16_t*)(ws + W::WT_2);
    constexpr int I_IN = 32 * 224, I_OUT = 32 * 64, I_13 = 32 * 1024, I_2 = 32 * 512, NITEMS = I_IN + I_OUT + I_13 + I_2;
    const int gw = blockIdx.x * NWAVES + wave, NGW = G * NWAVES;
    for (int it = gw; it < NITEMS; it += NGW) {
        int r = it;
        if (r < I_IN) { const int kb = r / 224, nb = r % 224; tr_item(w_in + win_src(nb * 32 + (lane & 31)), 7176, wt_in, 2048, kb * 64, nb * 32, scr, lane); continue; } r -= I_IN;
        if (r < I_OUT) { const int kb = r / 64, nb = r % 64; tr_item(w_out + nb * 32 + (lane & 31), 2048, wt_out, 2048, kb * 64, nb * 32, scr, lane); continue; } r -= I_OUT;
        if (r < I_13) { const int e = r >> 10, r2 = r & 1023, kb = r2 >> 5, nb = r2 & 31; const int n = nb * 32 + (lane & 31), g = n >> 3, q = n & 7;
            const float* colp = (q < 4 ? w1 : w3) + (size_t)e * 2048 * 512 + 4 * g + (q & 3);
            tr_item(colp, 512, wt_13 + (size_t)e * 1024 * 2048, 2048, kb * 64, nb * 32, scr, lane); continue; } r -= I_13;
        { const int e = r >> 9, r2 = r & 511, kb = r2 >> 6, nb = r2 & 63;
          tr_item(w2 + (size_t)e * 512 * 2048 + nb * 32 + (lane & 31), 2048, wt_2 + (size_t)e * 2048 * 512, 512, kb * 64, nb * 32, scr, lane); }
    }
}

__device__ __forceinline__ void ph1(const Args& a, LAS unsigned char* lds, int G) {
    const int tid = threadIdx.x, lane = tid & 63, wave = __builtin_amdgcn_readfirstlane(tid >> 6);
    unsigned char* ws = a.ws;
    const float* x = a.in[0]; const float* b_ada = a.in[3]; const float* norm1_w = a.in[4]; const float* w_in = a.in[5]; const float* fbias = a.in[6];
    const float* modp = (const float*)(ws + W::MODP); float* mod = (float*)(ws + W::MOD); bf16_t* xn = (bf16_t*)(ws + W::XN); float* logf_ = (float*)(ws + W::LOGF);
    for (int i = blockIdx.x * 512 + tid; i < 2 * 12288; i += G * 512) { const int b = i / 12288, j = i % 12288; float s = b_ada[j];
        for (int k = 0; k < 16; ++k) s += modp[(k * 2 + b) * 12288 + j];
        mod[i] = s; }
    LAS float* A1 = (LAS float*)(lds + RING_OFF); LAS float* S1 = A1 + 2048; LAS float* SSX = S1 + 2048; LAS float* FAX = SSX + 16 * 8;
    const int col = wave * 256 + lane * 4;
    float wf[4][8];
#pragma unroll
    for (int e = 0; e < 4; ++e) { const float4 w0 = *(const float4*)(w_in + (size_t)(col + e) * 7176 + 3072), w1 = *(const float4*)(w_in + (size_t)(col + e) * 7176 + 3076);
        wf[e][0] = w0.x; wf[e][1] = w0.y; wf[e][2] = w0.z; wf[e][3] = w0.w; wf[e][4] = w1.x; wf[e][5] = w1.y; wf[e][6] = w1.z; wf[e][7] = w1.w; }
    int bprev = -1;
    for (int rb = blockIdx.x; rb < 256; rb += G) {
        const int b = rb >> 7;
        if (b != bprev) { __syncthreads();
            for (int cc = tid; cc < 2048; cc += 512) { float sh = b_ada[cc], sc = b_ada[2048 + cc];
                for (int k = 0; k < 16; ++k) { sh += modp[(k * 2 + b) * 12288 + cc]; sc += modp[(k * 2 + b) * 12288 + 2048 + cc]; }
                A1[cc] = norm1_w[cc] * (1.f + sc); S1[cc] = sh; }
            __syncthreads(); bprev = b; }
        const pg8::f32x4 a1 = *(const LAS pg8::f32x4*)(A1 + col), s1 = *(const LAS pg8::f32x4*)(S1 + col);
        for (int g = 0; g < 4; ++g) {
            const int r0 = rb * 64 + g * 16;
            float4 v[16];
#pragma unroll
            for (int i = 0; i < 16; ++i) v[i] = *(const float4*)(x + (size_t)(r0 + i) * 2048 + col);
#pragma unroll
            for (int i = 0; i < 16; ++i) { const float ss = wave_sum(v[i].x * v[i].x + v[i].y * v[i].y + v[i].z * v[i].z + v[i].w * v[i].w); if (lane == 0) SSX[i * 8 + wave] = ss; }
            __syncthreads();
#pragma unroll
            for (int i = 0; i < 16; ++i) { const pg8::f32x4 p0 = *(const LAS pg8::f32x4*)(SSX + i * 8), p1 = *(const LAS pg8::f32x4*)(SSX + i * 8 + 4);
                const float rstd = rsqrtf(((p0[0] + p0[1]) + (p0[2] + p0[3]) + (p1[0] + p1[1]) + (p1[2] + p1[3])) * (1.f / 2048.f) + 1e-6f);
                float h[4] = {v[i].x * rstd * a1[0] + s1[0], v[i].y * rstd * a1[1] + s1[1], v[i].z * rstd * a1[2] + s1[2], v[i].w * rstd * a1[3] + s1[3]};
                uint2 pk; pk.x = pk2(h[0], h[1]); pk.y = pk2(h[2], h[3]);
                *(uint2*)(xn + (size_t)(r0 + i) * 2048 + col) = pk;
#pragma unroll
                for (int hh = 0; hh < 8; ++hh) { const float p = wave_sum((h[0] * wf[0][hh] + h[1] * wf[1][hh]) + (h[2] * wf[2][hh] + h[3] * wf[3][hh])); if (lane == 0) FAX[(i * 8 + hh) * 8 + wave] = p; } }
            __syncthreads();
            if (tid < 128) { const int i = tid >> 3, hh = tid & 7; const pg8::f32x4 p0 = *(const LAS pg8::f32x4*)(FAX + tid * 8), p1 = *(const LAS pg8::f32x4*)(FAX + tid * 8 + 4);
                const float t = ((p0[0] + p0[1]) + (p0[2] + p0[3])) + ((p1[0] + p1[1]) + (p1[2] + p1[3])) + fbias[hh];
                const int row = r0 + i; logf_[(size_t)((row >> 13) * 8 + hh) * 8192 + (row & 8191)] = log_sigmoid_f(t); }
        }
    }
}

__device__ __forceinline__ void cumsum_bh(const Args& a, LAS unsigned char* lds, int bh) {
    const int tid = threadIdx.x; unsigned char* ws = a.ws;
    const float* p = (const float*)(ws + W::LOGF) + (size_t)bh * 8192 + tid * 16; float* cum = (float*)(ws + W::CUM) + (size_t)bh * 8192 + tid * 16; float* bias = (float*)(ws + W::BIAS) + (size_t)bh * 8192 + tid * 16;
    LAS double* sc = (LAS double*)(lds + RING_OFF);
    double run = 0.0;
#pragma unroll
    for (int i = 0; i < 16; ++i) run += (double)p[i];
    sc[tid] = run; __syncthreads();
    int cur = 0;
    for (int o = 1; o < 512; o <<= 1) { const double t = sc[cur * 512 + tid] + (tid >= o ? sc[cur * 512 + tid - o] : 0.0); sc[(cur ^ 1) * 512 + tid] = t; cur ^= 1; __syncthreads(); }
    double acc = sc[cur * 512 + tid] - run;
#pragma unroll
    for (int i = 0; i < 16; ++i) { acc += (double)p[i]; cum[i] = (float)acc; bias[i] = (float)(-acc * 11.313708498984761); }
    __syncthreads();
}
struct EpiZ {
    static constexpr bool PERM = true, AFTER_DRAIN = false;
    bf16_t* qkv; const float* q_norm_w; const float* k_norm_w; const float* rope; PG8_LAS float* xch;
    __device__ __forceinline__ void operator()(const pg8::f32x4 (&acc)[2][2][4][2], const pg8::Unit& u, int wr, int wc, int fr, int fq) const {
        using pg8::f32x4; using pg8::u32x4;
        const int tt = u.pn >> 2, hp = (u.pn & 3) * 2;
        const int row0 = u.pm * 256 + wr * 64 + fr, b = row0 >> 13, dcol = wc * 32 + 8 * fq;
        bf16_t* base = qkv + (size_t)tt * QKV_ELEMS + ((size_t)(b * 8 + hp) * 8192) * 128 + dcol;
        if (tt < 2) {
#pragma unroll
            for (int ai = 0; ai < 2; ++ai)
#pragma unroll
                for (int m = 0; m < 4; ++m)
#pragma unroll
                    for (int bj = 0; bj < 2; ++bj) { const f32x4 v0 = acc[ai][bj][m][0], v1 = acc[ai][bj][m][1];
                        float s = (v0[0] * v0[0] + v0[1] * v0[1]) + (v0[2] * v0[2] + v0[3] * v0[3]) + (v1[0] * v1[0] + v1[1] * v1[1]) + (v1[2] * v1[2] + v1[3] * v1[3]);
                        s += __shfl_xor(s, 16); s += __shfl_xor(s, 32);
                        if (fq == 0) xch[((ai * 128 + wr * 64 + m * 16 + fr) * 2 + bj) * 4 + wc] = s; }
            asm volatile("s_waitcnt lgkmcnt(0)" ::: "memory"); __builtin_amdgcn_s_barrier(); asm volatile("" ::: "memory");
            const float* nw = tt == 0 ? q_norm_w : k_norm_w; const f32x4 w0 = *(const f32x4*)(nw + dcol), w1 = *(const f32x4*)(nw + dcol + 4);
#pragma unroll
            for (int ai = 0; ai < 2; ++ai)
#pragma unroll
                for (int m = 0; m < 4; ++m) { const int rl = ai * 128 + wr * 64 + m * 16 + fr; const int s_ = (row0 + ai * 128 + m * 16) & 8191;
#pragma unroll
                    for (int bj = 0; bj < 2; ++bj) { const f32x4 p = *(const PG8_LAS f32x4*)(xch + (rl * 2 + bj) * 4);
                        const float rstd = rsqrtf(((p[0] + p[1]) + (p[2] + p[3])) * (1.f / 128.f) + 1e-6f);
                        const f32x4 v0 = acc[ai][bj][m][0] * rstd * w0, v1 = acc[ai][bj][m][1] * rstd * w1;
                        u32x4 w; w.x = pg8::cvt_pk_bf16(v0[0], v0[1]); w.y = pg8::cvt_pk_bf16(v0[2], v0[3]); w.z = pg8::cvt_pk_bf16(v1[0], v1[1]); w.w = pg8::cvt_pk_bf16(v1[2], v1[3]);
                        *(u32x4*)(base + ((size_t)bj * 8192 + s_) * 128) = w; } }
        } else if (tt == 3 || tt == 4) {
            float l2g[2];
#pragma unroll
            for (int bj = 0; bj < 2; ++bj) l2g[bj] = log2f(1.f - exp2f(-5.f - (float)(hp + bj)));
#pragma unroll
            for (int ai = 0; ai < 2; ++ai)
#pragma unroll
                for (int m = 0; m < 4; ++m) { const int s_ = (row0 + ai * 128 + m * 16) & 8191;
                    const f32x4 c0 = *(const f32x4*)(rope + ((size_t)s_ * 64 + (dcol >> 1)) * 2), c1 = *(const f32x4*)(rope + ((size_t)s_ * 64 + (dcol >> 1) + 2) * 2);
#pragma unroll
                    for (int bj = 0; bj < 2; ++bj) { const f32x4 v0 = acc[ai][bj][m][0], v1 = acc[ai][bj][m][1];
                        const float f = tt == 4 ? 0.08838834764831845f * exp2f(-(float)(s_ & 63) * l2g[bj]) : 1.f;
                        const float o0 = (v0[0] * c0[0] - v0[1] * c0[1]) * f, o1 = (v0[0] * c0[1] + v0[1] * c0[0]) * f, o2 = (v0[2] * c0[2] - v0[3] * c0[3]) * f, o3 = (v0[2] * c0[3] + v0[3] * c0[2]) * f;
                        const float o4 = (v1[0] * c1[0] - v1[1] * c1[1]) * f, o5 = (v1[0] * c1[1] + v1[1] * c1[0]) * f, o6 = (v1[2] * c1[2] - v1[3] * c1[3]) * f, o7 = (v1[2] * c1[3] + v1[3] * c1[2]) * f;
                        u32x4 w; w.x = pg8::cvt_pk_bf16(o0, o1); w.y = pg8::cvt_pk_bf16(o2, o3); w.z = pg8::cvt_pk_bf16(o4, o5); w.w = pg8::cvt_pk_bf16(o6, o7);
                        *(u32x4*)(base + ((size_t)bj * 8192 + s_) * 128) = w; } }
        } else {
#pragma unroll
            for (int ai = 0; ai < 2; ++ai)
#pragma unroll
                for (int m = 0; m < 4; ++m) { const int s_ = (row0 + ai * 128 + m * 16) & 8191;
#pragma unroll
                    for (int bj = 0; bj < 2; ++bj) { f32x4 v0 = acc[ai][bj][m][0], v1 = acc[ai][bj][m][1];
                        if (tt == 6) {
#pragma unroll
                            for (int e = 0; e < 4; ++e) { v0[e] = v0[e] / (1.f + __expf(-v0[e])); v1[e] = v1[e] / (1.f + __expf(-v1[e])); } }
                        u32x4 w; w.x = pg8::cvt_pk_bf16(v0[0], v0[1]); w.y = pg8::cvt_pk_bf16(v0[2], v0[3]); w.z = pg8::cvt_pk_bf16(v1[0], v1[1]); w.w = pg8::cvt_pk_bf16(v1[2], v1[3]);
                        *(u32x4*)(base + ((size_t)bj * 8192 + s_) * 128) = w; } }
        }
    }
};


typedef at::BlockRef<at::bf16, at::bf16> ARef;
template <int MODE> __device__ __forceinline__ ARef attn_ref(const Args& a, int L, int pass) {
    const int bh = L >> 4, x = L & 15, qb = pass ? 31 - x : x, b = bh >> 3, h = bh & 7;
    const at::bf16* q = (const at::bf16*)(a.ws + W::QKV) + (MODE ? 3 * QKV_ELEMS : 0); ARef r;
    r.Q = q + ((size_t)bh * 8192 + qb * 256) * 128; r.K = q + QKV_ELEMS + (size_t)bh * 8192 * 128; r.V = q + 2 * QKV_ELEMS + (size_t)bh * 8192 * 128;
    r.O = (at::bf16*)(a.ws + W::MIX) + ((size_t)(b * 8192 + qb * 256)) * 2048 + (MODE ? 1024 : 0) + h * 128; r.P0 = qb * 256; r.bh = bh; r.jlo = 0;
    if (MODE) { const float l2g = log2f(1.f - exp2f(-5.f - (float)h));
        const int dmax = (int)(48.f / -l2g) + 1;
        const int lowk = r.P0 - dmax; r.jlo = lowk > 0 ? lowk >> 6 : 0; }
    return r;
}
template <int MODE> __device__ __forceinline__ void attn_stream(const Args& a, char* lds, int G) {
    int L = blockIdx.x; if (L >= 256) return;
    int pass = 0; ARef cur = attn_ref<MODE>(a, L, 0);
    const at::Extra<at::bf16> X{(const float*)(a.ws + W::BIAS), (const at::bf16*)(a.ws + W::QKV) + 6 * QKV_ELEMS, a.in[9]};
    at::Seam<at::bf16> S;
    at::causal_swa_prime<at::bf16, at::bf16>(cur, at::WBIG, lds, S);
    for (;;) {
        const bool more_pass = pass == 0, more_item = L + G < 256, last = !more_pass && !more_item;
        int Ln = L, passn = 1; if (!more_pass) { passn = 0; Ln = more_item ? L + G : L; }
        const ARef nr = last ? cur : attn_ref<MODE>(a, Ln, passn);
        const at::NextRef<at::bf16> nxt{nr.Q, nr.K, nr.V, nr.jlo};
        at::causal_swa_block<MODE, at::bf16, at::bf16>(cur, nxt, X, 8192, at::WBIG, lds, S);
        if (last) break;
        cur = attn_ref<MODE>(a, Ln, passn); L = Ln; pass = passn;
    }
}


struct EpiX1 {
    static constexpr bool PERM = false, AFTER_DRAIN = false;
    const float* x; const float* mod; float* out;
    __device__ __forceinline__ void operator()(const pg8::f32x4 (&acc)[2][2][4][2], const pg8::Unit& u, int wr, int wc, int fr, int fq) const {
        using pg8::f32x4;
        const int row0 = u.pm * 256 + wr * 64 + fr, b = row0 >> 13, col0 = u.pn * 256 + wc * 32 + 4 * fq;
        f32x4 g[2][2];
#pragma unroll
        for (int bj = 0; bj < 2; ++bj)
#pragma unroll
            for (int n = 0; n < 2; ++n) g[bj][n] = *(const f32x4*)(mod + b * 12288 + 4096 + col0 + bj * 128 + n * 16);
#pragma unroll
        for (int ai = 0; ai < 2; ++ai)
#pragma unroll
            for (int m = 0; m < 4; ++m) { const size_t off = (size_t)(row0 + ai * 128 + m * 16) * 2048 + col0;
#pragma unroll
                for (int bj = 0; bj < 2; ++bj)
#pragma unroll
                    for (int n = 0; n < 2; ++n) { const f32x4 xv = *(const f32x4*)(x + off + bj * 128 + n * 16); *(f32x4*)(out + off + bj * 128 + n * 16) = xv + g[bj][n] * acc[ai][bj][m][n]; }
                if (m & 1) asm volatile("" ::: "memory"); }
    }
};

typedef short bfx8 __attribute__((ext_vector_type(8)));
typedef float f32x16_t __attribute__((ext_vector_type(16)));
__device__ __forceinline__ void split8(const float* v, bfx8& h, bfx8& l) {
    unsigned hw[4], lw[4];
#pragma unroll
    for (int i = 0; i < 4; ++i) { const unsigned h0 = f2bf(v[2 * i]), h1 = f2bf(v[2 * i + 1]); hw[i] = h0 | (h1 << 16);
        const float r0 = v[2 * i] - __uint_as_float(h0 << 16), r1 = v[2 * i + 1] - __uint_as_float(h1 << 16); lw[i] = f2bf(r0) | (f2bf(r1) << 16); }
    typedef unsigned u4 __attribute__((ext_vector_type(4)));
    const u4 hv = {hw[0], hw[1], hw[2], hw[3]}, lv = {lw[0], lw[1], lw[2], lw[3]};
    h = __builtin_bit_cast(bfx8, hv); l = __builtin_bit_cast(bfx8, lv);
}
__device__ __forceinline__ void ph5(const Args& a, LAS unsigned char* lds, int G) {
    const int tid = threadIdx.x, lane = tid & 63, wave = __builtin_amdgcn_readfirstlane(tid >> 6), r32 = lane & 31, hi = lane >> 5;
    unsigned char* ws = a.ws; const float* x1 = a.out;
    const float* norm2_w = a.in[11]; const float* w_coarse = a.in[12]; const float* b_coarse = a.in[13]; const float* w_fine = a.in[14]; const float* b_fine = a.in[15];
    const float* mod = (const float*)(ws + W::MOD); bf16_t* h2 = (bf16_t*)(ws + W::H2);
    int* r_eid = (int*)(ws + W::ROUTE); float* r_gate = (float*)(ws + W::ROUTE + 128 * 1024); int* r_idx = (int*)(ws + W::ROUTE + 256 * 1024); int* cnt = (int*)(ws + W::CTL) + CW_CNT;
    LAS float* A2 = (LAS float*)(lds + RING_OFF); LAS float* S2 = A2 + 2048; LAS float* CST = S2 + 2048; LAS float* SSP = CST + 64; LAS float* RSTD = SSP + 256; LAS float* CP = RSTD + 32; LAS float* FP = CP + 1024; LAS float* WCL = FP + 8192;
    for (int i = tid; i < 2048; i += 512) *(LAS pg8::f32x4*)(WCL + i * 4) = *(const pg8::f32x4*)(w_coarse + (size_t)i * 4);
    const bfx8* wfrw = (const bfx8*)(ws + W::WFR) + (size_t)wave * 16 * 2 * 64;
    int bprev = -1;
    for (int rb = blockIdx.x; rb < 256; rb += G) {
        const int b = rb >> 7;
        if (b != bprev) { __syncthreads(); bprev = b;
            const float* sh = mod + b * 12288 + 6144; const float* sc = sh + 2048;
            for (int cc = tid; cc < 2048; cc += 512) { A2[cc] = norm2_w[cc] * (1.f + sc[cc]); S2[cc] = sh[cc]; }
            __syncthreads();
            for (int c0 = 0; c0 < 36; c0 += 4) {
                float part[4] = {0.f, 0.f, 0.f, 0.f};
#pragma unroll
                for (int q = 0; q < 4; ++q) { const int k = tid * 4 + q; const float sv = S2[k];
                    const float4 wv = c0 == 0 ? *(const float4*)(w_coarse + (size_t)k * 4) : *(const float4*)(w_fine + ((size_t)((c0 - 4) >> 3) * 2048 + k) * 8 + ((c0 - 4) & 7));
                    part[0] += sv * wv.x; part[1] += sv * wv.y; part[2] += sv * wv.z; part[3] += sv * wv.w; }
#pragma unroll
                for (int i = 0; i < 4; ++i) { const float t = wave_sum(part[i]); if (lane == 0) FP[(c0 + i) * 8 + wave] = t; } }
            __syncthreads();
            if (tid < 36) { float t = tid < 4 ? b_coarse[tid] : b_fine[tid - 4];
                for (int w = 0; w < 8; ++w) t += FP[tid * 8 + w];
                CST[tid] = t; }
            __syncthreads(); }
        for (int tile = 0; tile < 2; ++tile) {
            const int r0 = rb * 64 + tile * 32;
            f32x16_t acc = {}; float cacc[4] = {0.f, 0.f, 0.f, 0.f}; float ss = 0.f;
            const float* xr = x1 + (size_t)(r0 + r32) * 2048 + 256 * wave + 8 * hi; const int kb = 256 * wave + 8 * hi;
            unsigned ln = lane; asm volatile("" : "+v"(ln));
#pragma unroll 1
            for (int ch = 0; ch < 4; ++ch) {
                pg8::f32x4 xa[8]; bfx8 ba[8];
#pragma unroll
                for (int i = 0; i < 4; ++i) { xa[2 * i] = *(const pg8::f32x4*)(xr + 64 * ch + 16 * i); xa[2 * i + 1] = *(const pg8::f32x4*)(xr + 64 * ch + 16 * i + 4);
                    ba[2 * i] = (wfrw + ((4 * ch + i) * 2) * 64)[ln]; ba[2 * i + 1] = (wfrw + ((4 * ch + i) * 2 + 1) * 64)[ln]; }
#pragma unroll
                for (int i4 = 0; i4 < 4; ++i4) { const int ks = ch * 4 + i4;
                    const pg8::f32x4 v0 = xa[2 * i4], v1 = xa[2 * i4 + 1];
                    const pg8::f32x4 a0 = *(const LAS pg8::f32x4*)(A2 + kb + 16 * ks), a1 = *(const LAS pg8::f32x4*)(A2 + kb + 16 * ks + 4);
                    ss += (v0[0] * v0[0] + v0[1] * v0[1]) + (v0[2] * v0[2] + v0[3] * v0[3]) + (v1[0] * v1[0] + v1[1] * v1[1]) + (v1[2] * v1[2] + v1[3] * v1[3]);
                    float av[8] = {v0[0] * a0[0], v0[1] * a0[1], v0[2] * a0[2], v0[3] * a0[3], v1[0] * a1[0], v1[1] * a1[1], v1[2] * a1[2], v1[3] * a1[3]};
#pragma unroll
                    for (int i = 0; i < 8; ++i) { const pg8::f32x4 wc = *(const LAS pg8::f32x4*)(WCL + (kb + 16 * ks + i) * 4);
                        cacc[0] += av[i] * wc[0]; cacc[1] += av[i] * wc[1]; cacc[2] += av[i] * wc[2]; cacc[3] += av[i] * wc[3]; }
                    bfx8 ah, al; split8(av, ah, al);
                    acc = __builtin_amdgcn_mfma_f32_32x32x16_bf16(ah, ba[2 * i4], acc, 0, 0, 0);
                    acc = __builtin_amdgcn_mfma_f32_32x32x16_bf16(al, ba[2 * i4], acc, 0, 0, 0);
                    acc = __builtin_amdgcn_mfma_f32_32x32x16_bf16(ah, ba[2 * i4 + 1], acc, 0, 0, 0); }
            }
            ss += __shfl_xor(ss, 32);
#pragma unroll
            for (int g = 0; g < 4; ++g) cacc[g] += __shfl_xor(cacc[g], 32);
            if (hi == 0) { SSP[r32 * 8 + wave] = ss;
#pragma unroll
                for (int g = 0; g < 4; ++g) CP[(wave * 32 + r32) * 4 + g] = cacc[g]; }
#pragma unroll
            for (int r = 0; r < 16; ++r) FP[(wave * 32 + (r & 3) + 8 * (r >> 2) + 4 * hi) * 32 + r32] = acc[r];
            __syncthreads();
            if (tid < 32) { const int row = r0 + tid;
                float s8 = 0.f;
                for (int w = 0; w < 8; ++w) s8 += SSP[tid * 8 + w];
                const float rstd = rsqrtf(s8 * (1.f / 2048.f) + 1e-6f); RSTD[tid] = rstd;
                float cl[4]; int gs = 0;
#pragma unroll
                for (int g = 0; g < 4; ++g) { float t = 0.f; for (int w = 0; w < 8; ++w) t += CP[(w * 32 + tid) * 4 + g]; cl[g] = rstd * t + CST[g]; }
#pragma unroll
                for (int g = 1; g < 4; ++g) if (cl[g] > cl[gs]) gs = g;
                float cmax = cl[0];
#pragma unroll
                for (int g = 1; g < 4; ++g) cmax = fmaxf(cmax, cl[g]);
                float den = 0.f;
#pragma unroll
                for (int g = 0; g < 4; ++g) den += expf(cl[g] - cmax);
                const float pg = 1.f / den;
                float f0 = -3.0e38f, f1 = -3.0e38f; int e0 = 0, e1 = 0;
                for (int e = 0; e < 8; ++e) { float t = 0.f; for (int w = 0; w < 8; ++w) t += FP[(w * 32 + tid) * 32 + gs * 8 + e];
                    const float fl = rstd * t + CST[4 + gs * 8 + e];
                    if (fl > f0) { f1 = f0; e1 = e0; f0 = fl; e0 = e; } else if (fl > f1) { f1 = fl; e1 = e; } }
                const float t1 = expf(f1 - f0); const float g0 = pg / (1.f + t1), g1 = pg * t1 / (1.f + t1);
                const int E0 = gs * 8 + e0, E1 = gs * 8 + e1;
                r_eid[2 * row] = E0; r_eid[2 * row + 1] = E1; r_gate[2 * row] = g0; r_gate[2 * row + 1] = g1;
                r_idx[2 * row] = atomicAdd(cnt + E0, 1); r_idx[2 * row + 1] = atomicAdd(cnt + E1, 1); }
            __syncthreads();
#pragma unroll
            for (int q = 0; q < 4; ++q) { const int rl = wave * 4 + q; const float rstd = RSTD[rl]; const float* xrow = x1 + (size_t)(r0 + rl) * 2048; bf16_t* hrow = h2 + (size_t)(r0 + rl) * 2048;
#pragma unroll
                for (int j = 0; j < 8; ++j) { const int c = j * 256 + lane * 4; const pg8::f32x4 xv = *(const pg8::f32x4*)(xrow + c);
                    const pg8::f32x4 aa = *(const LAS pg8::f32x4*)(A2 + c), sv = *(const LAS pg8::f32x4*)(S2 + c);
                    uint2 pk; pk.x = pk2(xv[0] * rstd * aa[0] + sv[0], xv[1] * rstd * aa[1] + sv[1]); pk.y = pk2(xv[2] * rstd * aa[2] + sv[2], xv[3] * rstd * aa[3] + sv[3]);
                    *(uint2*)(hrow + c) = pk; }
                asm volatile("" ::: "memory"); }
        }
    }
    __syncthreads();
}
__device__ __forceinline__ void ph6(const Args& a, LAS unsigned char* lds, int G) {
    const int tid = threadIdx.x, lane = tid & 63, wave = __builtin_amdgcn_readfirstlane(tid >> 6);
    unsigned char* ws = a.ws;
    const int* cnt = (const int*)(ws + W::CTL) + CW_CNT; int* pstart_g = (int*)(ws + W::TILE); int* tile_e = pstart_g + 64; int* ntile = pstart_g + 512;
    const int* r_eid = (const int*)(ws + W::ROUTE); const int* r_idx = (const int*)(ws + W::ROUTE + 256 * 1024); int* r_slot = (int*)(ws + W::ROUTE + 384 * 1024);
    LAS int* ps = (LAS int*)(lds + RING_OFF);
    if (tid == 0) { int p = 0, t = 0;
        for (int e = 0; e < 32; ++e) { ps[e] = p; const int n = (cnt[e] + 255) >> 8; if (blockIdx.x == 0) { pstart_g[e] = p; for (int i = 0; i < n; ++i) tile_e[t + i] = e; } t += n; p += n * 256; }
        ps[32] = p; if (blockIdx.x == 0) { pstart_g[32] = p; *ntile = t; } }
    __syncthreads();
    const bf16_t* h2 = (const bf16_t*)(ws + W::H2); bf16_t* xs = (bf16_t*)(ws + W::XS);
    for (int mk = blockIdx.x * NWAVES + wave; mk < 2 * M_TOK; mk += G * NWAVES) {
        const int slot = ps[r_eid[mk]] + r_idx[mk]; if (lane == 0) r_slot[mk] = slot;
        const uint4* src = (const uint4*)(h2 + (size_t)(mk >> 1) * 2048) + lane; uint4* dst = (uint4*)(xs + (size_t)slot * 2048) + lane;
        uint4 v[4];
#pragma unroll
        for (int j = 0; j < 4; ++j) v[j] = src[64 * j];
#pragma unroll
        for (int j = 0; j < 4; ++j) dst[64 * j] = v[j];
    }
    __syncthreads();
}
template <int LOG2_NN> struct GroupedOrder {
    const int* tile_e; int nunits, G, c;
    __device__ void init(const int* tile_e_, const int* ntile, int G_, int c_) { tile_e = tile_e_; nunits = *ntile << LOG2_NN; G = G_; c = c_; }
    __device__ bool next(int i, pg8::Unit& u) const { const int L = i * G + c; if (L >= nunits) return false; u.pm = L >> LOG2_NN; u.pn = L & ((1 << LOG2_NN) - 1); u.e = tile_e[u.pm]; return true; }
    __device__ __forceinline__ void a_ready(const pg8::Unit&) const {}
    __device__ __forceinline__ void done(const pg8::Unit&) const {}
};
struct EpiUp {
    static constexpr bool PERM = true, AFTER_DRAIN = false;
    bf16_t* act;
    __device__ __forceinline__ void operator()(const pg8::f32x4 (&acc)[2][2][4][2], const pg8::Unit& u, int wr, int wc, int fr, int fq) const {
        using pg8::f32x4;
        const int row0 = u.pm * 256 + wr * 64 + fr, col0 = u.pn * 128 + wc * 16 + 4 * fq;
#pragma unroll
        for (int ai = 0; ai < 2; ++ai)
#pragma unroll
            for (int m = 0; m < 4; ++m) { bf16_t* rowp = act + (size_t)(row0 + ai * 128 + m * 16) * 512 + col0;
#pragma unroll
                for (int bj = 0; bj < 2; ++bj) { const f32x4 av = acc[ai][bj][m][0], bv = acc[ai][bj][m][1]; float o[4];
#pragma unroll
                    for (int e = 0; e < 4; ++e) o[e] = av[e] * __builtin_amdgcn_rcpf(1.f + __expf(-av[e])) * bv[e];
                    uint2 w; w.x = pg8::cvt_pk_bf16(o[0], o[1]); w.y = pg8::cvt_pk_bf16(o[2], o[3]);
                    *(uint2*)(rowp + bj * 64) = w; } }
    }
};
__device__ __forceinline__ void ph9(const Args& a, int G) {
    const int tid = threadIdx.x, lane = tid & 63, wave = __builtin_amdgcn_readfirstlane(tid >> 6);
    unsigned char* ws = a.ws; float* out = a.out;
    const float* mod = (const float*)(ws + W::MOD); const bf16_t* y = (const bf16_t*)(ws + W::Y);
    const float* r_gate = (const float*)(ws + W::ROUTE + 128 * 1024); const int* r_slot = (const int*)(ws + W::ROUTE + 384 * 1024);
    for (int m = blockIdx.x * NWAVES + wave; m < M_TOK; m += G * NWAVES) {
        const int s0 = r_slot[2 * m], s1 = r_slot[2 * m + 1]; const float g0 = r_gate[2 * m], g1 = r_gate[2 * m + 1];
        const float* g2 = mod + (m >> 13) * 12288 + 10240;
#pragma unroll
        for (int j = 0; j < 8; ++j) { const int c = j * 256 + lane * 4;
            const uint2 ya = *(const uint2*)(y + (size_t)s0 * 2048 + c), yb = *(const uint2*)(y + (size_t)s1 * 2048 + c);
            const pg8::f32x4 xv = *(const pg8::f32x4*)(out + (size_t)m * 2048 + c), gg = *(const pg8::f32x4*)(g2 + c);
            pg8::f32x4 o;
            o[0] = xv[0] + gg[0] * (g0 * __uint_as_float(ya.x << 16) + g1 * __uint_as_float(yb.x << 16));
            o[1] = xv[1] + gg[1] * (g0 * __uint_as_float(ya.x & 0xffff0000u) + g1 * __uint_as_float(yb.x & 0xffff0000u));
            o[2] = xv[2] + gg[2] * (g0 * __uint_as_float(ya.y << 16) + g1 * __uint_as_float(yb.y << 16));
            o[3] = xv[3] + gg[3] * (g0 * __uint_as_float(ya.y & 0xffff0000u) + g1 * __uint_as_float(yb.y & 0xffff0000u));
            *(pg8::f32x4*)(out + (size_t)m * 2048 + c) = o; }
    }
}

__global__ void __launch_bounds__(NWAVES * 64, 2) mk_fwd(Args args) {
    extern __shared__ __attribute__((aligned(16))) unsigned char lds_raw[];
    LAS unsigned char* lds = (LAS unsigned char*)lds_raw;
    volatile LAS unsigned* MISC = (volatile LAS unsigned*)(lds + MISC_OFF);
    const int tid = threadIdx.x, G = gridDim.x;
    unsigned char* ws = args.ws; gu32* ctl = (gu32*)(ws + W::CTL);
    for (int u = tid; u < (LDS_BYTES - MISC_OFF) / 4; u += NWAVES * 64) ((LAS unsigned*)(lds + MISC_OFF))[u] = 0u;
    __syncthreads();
    const int lo = args.ph_lo, hi = args.ph_hi;
    XcdBarrier bar; bar.bar = (unsigned*)(ctl + CW_BAR) + args.li * XCD_BAR_WORDS; bar.x = 0; bar.st = nullptr;
    if (hi - lo > 1) bar = xcd_barrier_post((unsigned*)(ctl + CW_BAR) + args.li * XCD_BAR_WORDS, MISC + 8);
#define IN(k) (lo <= (k) && (k) < hi)
#define BOTH(k) (IN(k) && IN((k) + 1))
    if (IN(0)) { ph0(args, lds, G); if (BOTH(0)) xcd_barrier(bar); }
    if (IN(1)) { ph1(args, lds, G); if (BOTH(1)) xcd_barrier(bar); }
    if (IN(2)) {
        for (int bh = blockIdx.x; bh < 16; bh += G) cumsum_bh(args, lds, bh);
        pg8::Gemm g{(const bf16_t*)(ws + W::XN), (const bf16_t*)(ws + W::WT_IN), M_TOK, 7168, 2048, 0};
        pg8::StaticOrder S; S.init(M_TOK, 7168, G, (int)blockIdx.x);
        EpiZ E{(bf16_t*)(ws + W::QKV), args.in[7], args.in[8], (const float*)(ws + W::ROPE), (PG8_LAS float*)(lds + XCH_OFF)};
        pg8::gemm_phase<EpiZ, pg8::StaticOrder, true, true>(lds + RING_OFF, g, S, E);
        if (BOTH(2)) xcd_barrier(bar);
    }
    if (IN(3)) { attn_stream<0>(args, (char*)lds_raw + RING_OFF, G); attn_stream<1>(args, (char*)lds_raw + RING_OFF, G); if (BOTH(3)) xcd_barrier(bar); }
    if (IN(4)) {
        pg8::Gemm g{(const bf16_t*)(ws + W::MIX), (const bf16_t*)(ws + W::WT_OUT), M_TOK, 2048, 2048, 0};
        pg8::StaticOrder S; S.init(M_TOK, 2048, G, (int)blockIdx.x);
        EpiX1 E{args.in[0], (const float*)(ws + W::MOD), args.out};
        pg8::gemm_phase<EpiX1, pg8::StaticOrder, true, true>(lds + RING_OFF, g, S, E);
        if (BOTH(4)) xcd_barrier(bar);
    }
    if (IN(5)) { ph5(args, lds, G); if (BOTH(5)) xcd_barrier(bar); }
    if (IN(6)) { ph6(args, lds, G); if (BOTH(6)) xcd_barrier(bar); }
    if (IN(7)) {
        pg8::Gemm g{(const bf16_t*)(ws + W::XS), (const bf16_t*)(ws + W::WT_13), 0, 1024, 2048, (size_t)1024 * 2048 * 2};
        GroupedOrder<2> S; S.init((const int*)(ws + W::TILE) + 64, (const int*)(ws + W::TILE) + 512, G, (int)blockIdx.x);
        EpiUp E{(bf16_t*)(ws + W::ACT)};
        pg8::gemm_phase<EpiUp, GroupedOrder<2>, true, true>(lds + RING_OFF, g, S, E);
        if (BOTH(7)) xcd_barrier(bar);
    }
    if (IN(8)) {
        pg8::Gemm g{(const bf16_t*)(ws + W::ACT), (const bf16_t*)(ws + W::WT_2), 0, 2048, 512, (size_t)2048 * 512 * 2};
        GroupedOrder<3> S; S.init((const int*)(ws + W::TILE) + 64, (const int*)(ws + W::TILE) + 512, G, (int)blockIdx.x);
        pg8::EpiBf16<0> E{(bf16_t*)(ws + W::Y), 2048, nullptr, 0, 0, 1.f};
        pg8::gemm_phase<pg8::EpiBf16<0>, GroupedOrder<3>, true, true>(lds + RING_OFF, g, S, E);
        if (BOTH(8)) xcd_barrier(bar);
    }
    if (IN(9)) ph9(args, G);
#undef IN
#undef BOTH
}
extern "C" void kernel_launch(void* const* d_in, const int* in_sizes, int n_in, void* d_out, int out_size, void* d_ws, size_t ws_size, hipStream_t stream) {
    static int grid = 0;
    if (grid == 0) {
        if (n_in != 19 || out_size != M_TOK * DM || ws_size < W::END) { fprintf(stderr, "kernel_launch: built for 19 inputs, %d outputs, >= %zu bytes of workspace; got %d, %d, %zu\n", M_TOK * DM, (size_t)W::END, n_in, out_size, ws_size); grid = -1; return; }
        int dev = 0, cus = 0, per_cu = 0;
        if (hipGetDevice(&dev) != hipSuccess || hipDeviceGetAttribute(&cus, hipDeviceAttributeMultiprocessorCount, dev) != hipSuccess) { fprintf(stderr, "kernel_launch: device query failed\n"); grid = -1; return; }
        if (hipFuncSetAttribute((const void*)mk_fwd, hipFuncAttributeMaxDynamicSharedMemorySize, LDS_BYTES) != hipSuccess) { fprintf(stderr, "kernel_launch: hipFuncSetAttribute failed\n"); grid = -1; return; }
        if (hipOccupancyMaxActiveBlocksPerMultiprocessor(&per_cu, (const void*)mk_fwd, NWAVES * 64, LDS_BYTES) != hipSuccess || per_cu < 1) { fprintf(stderr, "kernel_launch: occupancy query says %d workgroups per CU\n", per_cu); (void)hipGetLastError(); grid = -1; return; }
        grid = cus;
    }
    if (grid < 0) return;
    (void)hipMemsetAsync((char*)d_ws + W::CTL, 0, W::CTL_ZERO_BYTES, stream);
    Args a{};
    for (int i = 0; i < 19; ++i) a.in[i] = (const float*)d_in[i];
    a.out = (float*)d_out; a.ws = (unsigned char*)d_ws; a.ph_lo = 0; a.ph_hi = 10; a.li = 0;
    hipLaunchKernelGGL(mk_fwd, dim3(grid), dim3(NWAVES * 64), LDS_BYTES, stream, a);
}
```

```cpp
#include <hip/hip_runtime.h>
#include <cstdio>
#include <cstdint>
typedef unsigned short bf16_t;
__device__ __forceinline__ float bf2f(bf16_t v) { return __uint_as_float(((unsigned)v) << 16); }
__device__ __forceinline__ unsigned f2bf(float f) { const unsigned u = __float_as_uint(f); return (u + 0x7fffu + ((u >> 16) & 1u)) >> 16; }

constexpr size_t MiB = 1u << 20;
constexpr int M_TOK = 16384, SEQ = 8192, DM = 2048;
constexpr size_t QKV_ELEMS = (size_t)16 * 8192 * 128;
namespace pg8 {
#define PG8_LAS __attribute__((address_space(3)))
typedef short bf16x8 __attribute__((ext_vector_type(8)));
typedef float f32x4 __attribute__((ext_vector_type(4)));
typedef unsigned u32x4 __attribute__((ext_vector_type(4)));
constexpr int BM = 256, BK = 64, HALF = 128, HTB = HALF * BK * 2  , STAGE_BYTES = 8 * HTB, NXCD = 8, WGM = 8;

__host__ __device__ __forceinline__ int lds_byte(int r, int c) { const int st = (r >> 4) * 2 + (c >> 5), rr = r & 15, cc = c & 31, ob = rr * 64 + cc * 2; return st * 1024 + (ob ^ (((ob >> 9) & 1) << 5)); }
__host__ __device__ __forceinline__ void stage_rc(int b, int& R, int& C) { const int st = b / 1024, sb = b % 1024, swz = sb ^ (((sb >> 9) & 1) << 5); R = (st >> 1) * 16 + swz / 64; C = (st & 1) * 32 + (swz % 64) / 2; }
__host__ __device__ __forceinline__ int perm32(int rho) { const int n = rho >> 4, i = rho & 15; return 8 * (i >> 2) + 4 * n + (i & 3); }

struct Unit { int pm, pn, e; };
struct Gemm { const bf16_t* A; const bf16_t* Bt; int M, N, K; size_t estride; };

struct StaticOrder {
    int nM, nN, nwg, G, c;
    __host__ __device__ void init(int M, int N, int G_, int c_) { nM = M / BM; nN = N / BM; nwg = nM * nN; G = G_; c = c_; }
    __host__ __device__ bool next(int i, Unit& u) const {
        const long L = (long)i * G + c; if (L >= nwg) return false;
        int wgid = (int)L; { const int q = nwg / NXCD, r = nwg % NXCD, xcd = wgid % NXCD, off = wgid / NXCD; wgid = (xcd < r ? xcd * (q + 1) : r * (q + 1) + (xcd - r) * q) + off; }
        const int nig = WGM * nN, gid = wgid / nig, fm = gid * WGM, gsz = (nM - fm) < WGM ? (nM - fm) : WGM;
        u.pm = fm + ((wgid % nig) % gsz); u.pn = (wgid % nig) / gsz; u.e = 0; return true;
    }
    __device__ __forceinline__ void a_ready(const Unit&) const {}
    __device__ __forceinline__ void done(const Unit&) const {}
};

__device__ __forceinline__ unsigned cvt_pk_bf16(float lo, float hi) { unsigned r; asm volatile("v_cvt_pk_bf16_f32 %0, %1, %2" : "=v"(r) : "v"(lo), "v"(hi)); return r; }
typedef float f32x2 __attribute__((ext_vector_type(2)));
__device__ __forceinline__ f32x2 gelu_pk(f32x2 v) {
    const f32x2 av = __builtin_elementwise_abs(v), d = av * 0.2316418882f + 1.0f;
    f32x2 t; t.x = __builtin_amdgcn_rcpf(d.x); t.y = __builtin_amdgcn_rcpf(d.y);
    f32x2 q = t * 0.5307027145f + (-0.7265760135f); q = q * t + 0.7107068705f; q = q * t + (-0.142248368f); q = q * t + 0.127414796f; q = q * t;
    const f32x2 s = (v * v) * (-0.72134752044f);
    f32x2 e; e.x = __builtin_amdgcn_exp2f(s.x); e.y = __builtin_amdgcn_exp2f(s.y);
    const f32x2 m = v * (q * e), r = v - m;
    f32x2 o; o.x = v.x < 0.f ? m.x : r.x; o.y = v.y < 0.f ? m.y : r.y; return o;
}

template <int ACT  > struct EpiBf16 {
    static constexpr bool PERM = true, AFTER_DRAIN = false; static_assert(ACT == 0 || ACT == 1, "EpiBf16: ACT is 0 (none) or 1 (gelu_pk)");
    bf16_t* O; int ldc; const float* bias; int split_cols; size_t split_stride; float scale0;
    __device__ __forceinline__ void operator()(const f32x4 (&acc)[2][2][4][2], const Unit& u, int wr, int wc, int fr, int fq) const {
        const int row0 = u.pm * BM + wr * 64 + fr; int colt = u.pn * BM; bf16_t* base = O;
        float sc = 1.f; if (split_cols) { const int t = colt / split_cols; base += (size_t)t * split_stride; colt -= t * split_cols; if (t == 0) sc = scale0; }
        const int col0 = colt + wc * 32 + 8 * fq, bcol0 = u.pn * BM + wc * 32 + 8 * fq;
        f32x4 bv[2][2];
#pragma unroll
        for (int bj = 0; bj < 2; ++bj)
#pragma unroll
            for (int n = 0; n < 2; ++n) bv[bj][n] = bias ? *(const f32x4*)(bias + bcol0 + bj * HALF + 4 * n) : (f32x4){0.f, 0.f, 0.f, 0.f};
#pragma unroll
        for (int ai = 0; ai < 2; ++ai)
#pragma unroll
            for (int m = 0; m < 4; ++m) { bf16_t* rowp = base + (size_t)(row0 + ai * HALF + m * 16) * ldc + col0;
#pragma unroll
                for (int bj = 0; bj < 2; ++bj) { f32x4 v0 = acc[ai][bj][m][0] + bv[bj][0], v1 = acc[ai][bj][m][1] + bv[bj][1];
                    if (ACT == 1) { f32x2 a = gelu_pk((f32x2){v0[0], v0[1]}), b = gelu_pk((f32x2){v0[2], v0[3]}), c = gelu_pk((f32x2){v1[0], v1[1]}), d = gelu_pk((f32x2){v1[2], v1[3]});
                        v0 = (f32x4){a.x, a.y, b.x, b.y}; v1 = (f32x4){c.x, c.y, d.x, d.y}; }
                    v0 = v0 * sc; v1 = v1 * sc; u32x4 w; w.x = cvt_pk_bf16(v0[0], v0[1]); w.y = cvt_pk_bf16(v0[2], v0[3]); w.z = cvt_pk_bf16(v1[0], v1[1]); w.w = cvt_pk_bf16(v1[2], v1[3]);
                    *(u32x4*)(rowp + bj * HALF) = w; } }
    }
};
template <class Epi, class Sched, bool ALIGN_EPI = false, bool SP2 = false>
__device__ __forceinline__ void gemm_phase(PG8_LAS unsigned char* lds, const Gemm g, const Sched& S, const Epi& E) {
    const int tid = threadIdx.x, wid = __builtin_amdgcn_readfirstlane(tid >> 6), lane = tid & 63, wr = wid >> 2, wc = wid & 3, fr = lane & 15, fq = lane >> 4;
    const int K = g.K, nt = K / BK;
    unsigned voffA[2], voffB[2];
#pragma unroll
    for (int i = 0; i < 2; ++i) { int R, C; stage_rc(tid * 16 + i * 8192, R, C); const int Rb = Epi::PERM ? ((R & ~31) + perm32(R & 31)) : R;
        voffA[i] = (unsigned)(R * K + C) * 2u; voffB[i] = (unsigned)(Rb * K + C) * 2u; }
    const size_t kstep = (size_t)(BK * 2);
    const size_t hstep = (size_t)HALF * K * 2;
    const size_t tstep = 2 * hstep;
    const unsigned ldsw = (unsigned)wid * 1024u;
    const int aoff = lds_byte(wr * 64 + fr, fq * 8), boff = lds_byte(wc * 32 + fr, fq * 8);
#define PG8_SA(b, h) (((b) * 2 + (h)) * HTB)
#define PG8_SB(b, h) ((4 + (b) * 2 + (h)) * HTB)
#define PG8_STAGE(bufoff, gbase, voff) do { _Pragma("unroll") for (int _i = 0; _i < 2; ++_i) \
        __builtin_amdgcn_global_load_lds((const unsigned*)((const char*)(gbase) + (voff)[_i]), (PG8_LAS unsigned*)(lds + (bufoff) + ldsw + _i * 8192), 16, 0, 0); } while (0)
#define PG8_LDA(dst, b, h) do { _Pragma("unroll") for (int m = 0; m < 4; ++m) _Pragma("unroll") for (int k = 0; k < 2; ++k) dst[m][k] = *(const PG8_LAS bf16x8*)(lds + PG8_SA(b, h) + aoff + m * 2048 + k * 1024); } while (0)
#define PG8_LDB(dst, b, h) do { _Pragma("unroll") for (int n = 0; n < 2; ++n) _Pragma("unroll") for (int k = 0; k < 2; ++k) dst[n][k] = *(const PG8_LAS bf16x8*)(lds + PG8_SB(b, h) + boff + n * 2048 + k * 1024); } while (0)
#define PG8_MMA(ai, bj, At, Bt) do { __builtin_amdgcn_s_setprio(1); _Pragma("unroll") for (int m = 0; m < 4; ++m) _Pragma("unroll") for (int n = 0; n < 2; ++n) _Pragma("unroll") for (int k = 0; k < 2; ++k) \
        acc[ai][bj][m][n] = __builtin_amdgcn_mfma_f32_16x16x32_bf16(Bt[n][k], At[m][k], acc[ai][bj][m][n], 0, 0, 0); __builtin_amdgcn_s_setprio(0); } while (0)
#define PG8_WAIT_V(n) asm volatile("s_waitcnt vmcnt(" #n ")" ::: "memory")
#define PG8_WAIT_L(n) asm volatile("s_waitcnt lgkmcnt(" #n ")" ::: "memory")
#define PG8_BAR __builtin_amdgcn_s_barrier()
#define PG8_SCHED __builtin_amdgcn_sched_barrier(0)
    Unit cur, nxt; int ui = 0;
    if (!S.next(0, cur)) return;
    f32x4 acc[2][2][4][2];
#pragma unroll
    for (int a = 0; a < 2; ++a)
#pragma unroll
        for (int b = 0; b < 2; ++b)
#pragma unroll
            for (int m = 0; m < 4; ++m)
#pragma unroll
                for (int n = 0; n < 2; ++n) acc[a][b][m][n] = (f32x4){0.f, 0.f, 0.f, 0.f};
    bf16x8 At[4][2], B0[2][2], B1[2][2];
    const char* cA = (const char*)g.A + (size_t)cur.pm * tstep; const char* cB = (const char*)g.Bt + (size_t)cur.pn * tstep + (size_t)cur.e * g.estride;
    S.a_ready(cur);
    if constexpr (SP2) {
        PG8_STAGE(PG8_SB(0, 0), cB, voffB); PG8_STAGE(PG8_SB(0, 1), cB + hstep, voffB); PG8_STAGE(PG8_SA(0, 0), cA, voffA); PG8_STAGE(PG8_SA(0, 1), cA + hstep, voffA);
        if (wr == 1) PG8_BAR;
        PG8_WAIT_V(2); PG8_BAR;
        PG8_STAGE(PG8_SB(1, 0), cB + kstep, voffB); PG8_STAGE(PG8_SA(1, 0), cA + kstep, voffA); PG8_STAGE(PG8_SB(1, 1), cB + hstep + kstep, voffB);
        PG8_WAIT_V(6); PG8_BAR;
    } else {
        PG8_STAGE(PG8_SB(0, 0), cB, voffB); PG8_STAGE(PG8_SA(0, 0), cA, voffA); PG8_STAGE(PG8_SB(0, 1), cB + hstep, voffB); PG8_STAGE(PG8_SA(0, 1), cA + hstep, voffA);
        if (wr == 1) PG8_BAR;
        PG8_WAIT_V(4); PG8_BAR;
        PG8_STAGE(PG8_SB(1, 0), cB + kstep, voffB); PG8_STAGE(PG8_SA(1, 0), cA + kstep, voffA); PG8_STAGE(PG8_SB(1, 1), cB + hstep + kstep, voffB);
        PG8_WAIT_V(6); PG8_BAR;
    }
    for (;;) {
        const bool has_next = S.next(ui + 1, nxt);
        const char* nA = has_next ? (const char*)g.A + (size_t)nxt.pm * tstep : cA; const char* nB = has_next ? (const char*)g.Bt + (size_t)nxt.pn * tstep + (size_t)nxt.e * g.estride : cB;
        for (int t = 0; t < nt; t += 2) {
            const bool last = (t == nt - 2);
            const char* a1 = cA + (size_t)(t + 1) * kstep;
            const char* a2 = last ? nA : cA + (size_t)(t + 2) * kstep; const char* b2 = last ? nB : cB + (size_t)(t + 2) * kstep;
            const char* a3 = a2 + kstep; const char* b3 = b2 + kstep;
            if (last && has_next) S.a_ready(nxt);
            if constexpr (SP2) {
            PG8_LDB(B0, 0, 0); PG8_LDB(B1, 0, 1); PG8_SCHED; PG8_LDA(At, 0, 0); PG8_STAGE(PG8_SA(1, 1), a1 + hstep, voffA);
            PG8_WAIT_V(8); PG8_WAIT_L(0); PG8_BAR; PG8_MMA(0, 0, At, B0); PG8_MMA(0, 1, At, B1); PG8_BAR; PG8_SCHED;
            PG8_LDA(At, 0, 1); PG8_STAGE(PG8_SB(0, 0), b2, voffB); PG8_STAGE(PG8_SB(0, 1), b2 + hstep, voffB); PG8_STAGE(PG8_SA(0, 0), a2, voffA);
            PG8_WAIT_V(8); PG8_WAIT_L(0); PG8_BAR; PG8_MMA(1, 0, At, B0); PG8_MMA(1, 1, At, B1); PG8_BAR; PG8_SCHED;
            PG8_LDB(B0, 1, 0); PG8_LDB(B1, 1, 1); PG8_SCHED; PG8_LDA(At, 1, 0); PG8_STAGE(PG8_SA(0, 1), a2 + hstep, voffA);
            PG8_WAIT_V(8); PG8_WAIT_L(0); PG8_BAR; PG8_MMA(0, 0, At, B0); PG8_MMA(0, 1, At, B1); PG8_BAR; PG8_SCHED;
            PG8_LDA(At, 1, 1); PG8_STAGE(PG8_SB(1, 0), b3, voffB); PG8_STAGE(PG8_SB(1, 1), b3 + hstep, voffB); PG8_STAGE(PG8_SA(1, 0), a3, voffA);
            PG8_WAIT_V(8); PG8_WAIT_L(0); PG8_BAR; PG8_MMA(1, 0, At, B0); PG8_MMA(1, 1, At, B1); PG8_BAR; PG8_SCHED;
            } else {
            PG8_LDB(B0, 0, 0); PG8_SCHED; PG8_LDA(At, 0, 0); PG8_STAGE(PG8_SA(1, 1), a1 + hstep, voffA);
            PG8_WAIT_L(8); PG8_BAR; PG8_WAIT_L(0); PG8_MMA(0, 0, At, B0); PG8_BAR; PG8_SCHED;
            PG8_LDB(B1, 0, 1); PG8_STAGE(PG8_SB(0, 0), b2, voffB);
            PG8_BAR; PG8_WAIT_L(0); PG8_MMA(0, 1, At, B1); PG8_BAR;
            PG8_LDA(At, 0, 1); PG8_STAGE(PG8_SA(0, 0), a2, voffA);
            PG8_BAR; PG8_WAIT_L(0); PG8_MMA(1, 0, At, B0); PG8_BAR; PG8_SCHED;
            PG8_STAGE(PG8_SB(0, 1), b2 + hstep, voffB);
            PG8_WAIT_V(6); PG8_BAR; PG8_MMA(1, 1, At, B1); PG8_BAR;
            PG8_LDB(B0, 1, 0); PG8_SCHED; PG8_LDA(At, 1, 0); PG8_STAGE(PG8_SA(0, 1), a2 + hstep, voffA);
            PG8_WAIT_L(8); PG8_BAR; PG8_WAIT_L(0); PG8_MMA(0, 0, At, B0); PG8_BAR; PG8_SCHED;
            PG8_LDB(B1, 1, 1); PG8_STAGE(PG8_SB(1, 0), b3, voffB);
            PG8_BAR; PG8_WAIT_L(0); PG8_MMA(0, 1, At, B1); PG8_BAR;
            PG8_LDA(At, 1, 1); PG8_STAGE(PG8_SA(1, 0), a3, voffA);
            PG8_BAR; PG8_WAIT_L(0); PG8_MMA(1, 0, At, B0); PG8_BAR; PG8_SCHED;
            PG8_STAGE(PG8_SB(1, 1), b3 + hstep, voffB);
            PG8_WAIT_V(6); PG8_BAR; PG8_MMA(1, 1, At, B1); PG8_BAR;
            }
        }
        if constexpr (ALIGN_EPI) { if (wr == 0) PG8_BAR; }
        if constexpr (!Epi::AFTER_DRAIN) { E(acc, cur, wr, wc, fr, fq); S.done(cur); }
        if (!has_next) break;
#pragma unroll
        for (int a = 0; a < 2; ++a)
#pragma unroll
            for (int b = 0; b < 2; ++b)
#pragma unroll
                for (int m = 0; m < 4; ++m)
#pragma unroll
                    for (int n = 0; n < 2; ++n) acc[a][b][m][n] = (f32x4){0.f, 0.f, 0.f, 0.f};
        cur = nxt; cA = nA; cB = nB; ++ui;
        if constexpr (ALIGN_EPI) { if (wr == 1) PG8_BAR; }
    }
    PG8_WAIT_V(0);
    if constexpr (!ALIGN_EPI) { if (wr == 0) PG8_BAR; }
    PG8_BAR;
    if constexpr (Epi::AFTER_DRAIN) { E.fused(acc, cur, wr, wc, fr, fq, lds, wid, lane); S.done(cur); }
#undef PG8_SA
#undef PG8_SB
#undef PG8_STAGE
#undef PG8_LDA
#undef PG8_LDB
#undef PG8_MMA
#undef PG8_WAIT_V
#undef PG8_WAIT_L
#undef PG8_BAR
#undef PG8_SCHED
}
}
#define GAS __attribute__((address_space(1)))
#define LAS __attribute__((address_space(3)))
typedef GAS unsigned gu32;
typedef GAS unsigned long long gu64;
#define RLX_AGENT __ATOMIC_RELAXED, __HIP_MEMORY_SCOPE_AGENT
#define LDS_WAIT() asm volatile("s_waitcnt lgkmcnt(0)" ::: "memory")
#define VM_WAIT() asm volatile("s_waitcnt vmcnt(0)" ::: "memory")
#define XB_TMO      128
#define XB_XCNT(j)  (256  + 64 * (j))
#define XB_XSUB(j)  (1280 + 64 * (j))
#define XB_XGEN(j)  (2304 + 64 * (j))
#define XB_TOP      3328
#define XB_TOPGEN   3392
#define XCD_BAR_WORDS 3456
#define XB_SPIN_CAP (1u << 18)

__device__ __forceinline__ unsigned xb_ld(unsigned* p)              { return __hip_atomic_load(p, __ATOMIC_RELAXED, __HIP_MEMORY_SCOPE_AGENT); }
__device__ __forceinline__ unsigned xb_add(unsigned* p, unsigned v) { return __hip_atomic_fetch_add(p, v, __ATOMIC_RELAXED, __HIP_MEMORY_SCOPE_AGENT); }
__device__ __forceinline__ unsigned xb_xcc_id() { return (unsigned)__builtin_amdgcn_s_getreg((3 << 11) | 20) & 0xFu; }
#define XB_SPIN(cond, bar) do { unsigned _sp = 0; while (cond) { __builtin_amdgcn_s_sleep(1); \
    if ((++_sp & 255u) == 0u) { if (xb_ld(&(bar)[XB_TMO])) break; if (_sp > XB_SPIN_CAP) { atomicAdd(&(bar)[XB_TMO], 1u); break; } } } } while (0)

struct XcdBarrier {
    unsigned* bar; unsigned x;
    volatile LAS unsigned* st;
};

__device__ __forceinline__ XcdBarrier xcd_barrier_post(unsigned* bar, volatile LAS unsigned* st) {
    XcdBarrier b; b.bar = bar; b.x = xb_xcc_id(); b.st = st;
    if (threadIdx.x == 0) (void)xb_add(&bar[XB_XCNT(b.x)], 1u);
    return b;
}
__device__ __forceinline__ void xcd_barrier_complete(unsigned* bar, unsigned x, unsigned& nloc, unsigned& nx) {
    const unsigned G = gridDim.x * gridDim.y * gridDim.z;
    unsigned sum, cnt, mine, sp = 0u;
    for (;;) {
        sum = 0u; cnt = 0u; mine = 0u;
#pragma unroll
        for (unsigned j = 0; j < 16; ++j) { const unsigned c = xb_ld(&bar[XB_XCNT(j)]); sum += c; cnt += (c > 0u) ? 1u : 0u; mine = (j == x) ? c : mine; }
        if (sum == G) break;
        __builtin_amdgcn_s_sleep(1);
        if ((++sp & 255u) == 0u) { if (xb_ld(&bar[XB_TMO])) break; if (sp > XB_SPIN_CAP) { atomicAdd(&bar[XB_TMO], 1u); break; } }
    }
    nloc = mine > 0u ? mine : 1u; nx = cnt > 0u ? cnt : 1u;
}

__device__ __forceinline__ void xcd_barrier(const XcdBarrier& b) {
    asm volatile("s_waitcnt vmcnt(0)" ::: "memory");
    __syncthreads();
    if (threadIdx.x == 0) {
        unsigned* bar = b.bar;
        __builtin_amdgcn_s_waitcnt(0);
        unsigned nloc = b.st[0], nx = b.st[1];
        if (nloc == 0u) { xcd_barrier_complete(bar, b.x, nloc, nx); b.st[0] = nloc; b.st[1] = nx; }
        const unsigned old = xb_add(&bar[XB_XSUB(b.x)], 1u);
        const unsigned gen = old / nloc;
        if (old + 1u == (gen + 1u) * nloc) {
            __builtin_amdgcn_fence(__ATOMIC_RELEASE, "agent");
            asm volatile("s_waitcnt vmcnt(0)" ::: "memory");
            const unsigned og = xb_add(&bar[XB_TOP], 1u);
            const unsigned tg = og / nx;
            if (og + 1u == (tg + 1u) * nx) xb_add(&bar[XB_TOPGEN], 1u);
            else XB_SPIN(xb_ld(&bar[XB_TOPGEN]) == tg, bar);
            __builtin_amdgcn_fence(__ATOMIC_ACQUIRE, "agent");
            xb_add(&bar[XB_XGEN(b.x)], 1u);
            asm volatile("s_waitcnt vmcnt(0)" ::: "memory");
        } else {
            XB_SPIN(xb_ld(&bar[XB_XGEN(b.x)]) == gen, bar);
            __builtin_amdgcn_fence(__ATOMIC_ACQUIRE, "agent");
            asm volatile("s_waitcnt vmcnt(0)" ::: "memory");
        }
    }
    __syncthreads();
}
namespace at {
constexpr int D = 128; constexpr float THR = 8.f; constexpr bool WSKIP = false; constexpr int WBIG = 1 << 30;
constexpr float SCALE = 0.08838834764831845f;
constexpr int NW = 8, QBLK = 32, KVBLK = 64, QB = NW * QBLK;
constexpr int SHM_V = KVBLK * D * 2, SHM_K = KVBLK * D * 2;
constexpr int LDS_BODY = 2 * SHM_V + 2 * SHM_K + NW * 64 * 4;
constexpr int LDS_BIAS = LDS_BODY, LDS_BYTES = LDS_BODY + 8192 * 4;
using bf16 = unsigned short;
typedef short bf16x8 __attribute__((ext_vector_type(8)));
typedef short s16x4 __attribute__((ext_vector_type(4)));
typedef float f32x16 __attribute__((ext_vector_type(16)));
typedef float f32x4 __attribute__((ext_vector_type(4)));
typedef unsigned u32x4 __attribute__((ext_vector_type(4)));
template <class A, class Bt> struct same_t { static constexpr bool v = false; };
template <class A> struct same_t<A, A> { static constexpr bool v = true; };

#define KSWZ(row, colB) ((row) * 256 + ((colB) ^ (((row) & 7) << 4)))
#define SBAR() __builtin_amdgcn_sched_barrier(0)
__device__ __forceinline__ int v_st(int k, int c) { const int kk = (k & ~0xC) | ((k & 4) << 1) | ((k & 8) >> 1); return ((kk >> 3) * 4 + (c >> 5)) * 512 + ((kk & 7) * 32 + (c & 31)) * 2; }
__device__ __forceinline__ int v_rd_base(int lane) { return ((lane & 3) << 3) | (((lane >> 2) & 3) << 6) | (((lane >> 4) & 1) << 5) | (((lane >> 5) & 1) << 8); }
constexpr int v_rd_off(int d0, int ks, int half) { return d0 * 512 + ks * 4096 + half * 2048; }
__device__ __forceinline__ int crow(int r, int hi) { return (r & 3) + 8 * (r >> 2) + 4 * hi; }
__device__ __forceinline__ unsigned cvtpk(float lo, float hi) {
    unsigned r; asm volatile("v_cvt_pk_bf16_f32 %0, %1, %2" : "=v"(r) : "v"(lo), "v"(hi)); return r;
}
__device__ __forceinline__ bf16x8 pack8(f32x4 a, f32x4 b) {
    u32x4 w = {cvtpk(a[0], a[1]), cvtpk(a[2], a[3]), cvtpk(b[0], b[1]), cvtpk(b[2], b[3])};
    return *reinterpret_cast<bf16x8*>(&w);
}
template <class T> __device__ __forceinline__ bf16x8 load8(const T* p) {
    if constexpr (same_t<T, float>::v) { return pack8(*(const f32x4*)p, *(const f32x4*)(p + 4)); }
    else { return *reinterpret_cast<const bf16x8*>(p); }
}
template <int MODE> __device__ __forceinline__ void mask_tile(f32x16& p0, f32x16& p1, int dq, unsigned W) {
    const float NEG = MODE ? 0.f : -__builtin_inff();
#pragma unroll
    for (int r = 0; r < 16; ++r) {
        const int c = (r & 3) + 8 * (r >> 2);
        if ((unsigned)(dq - c) >= W) p0[r] = NEG;
        if ((unsigned)(dq - c - 32) >= W) p1[r] = NEG;
    }
}
__device__ __forceinline__ void partialRet(f32x16& p0, float rowfac) { for (int r = 0; r < 16; ++r) p0[r] *= rowfac; }
__device__ __forceinline__ void partialSM(f32x16& p0, f32x16& p1, float& m_reg, float& mn, float& alpha) {
    float pmax = p0[0]; for (int r = 1; r < 16; ++r) pmax = fmaxf(pmax, p0[r]); for (int r = 0; r < 16; ++r) pmax = fmaxf(pmax, p1[r]);
    { auto rr = __builtin_amdgcn_permlane32_swap(__float_as_uint(pmax), __float_as_uint(pmax), false, false);
      pmax = fmaxf(__uint_as_float(rr[0]), __uint_as_float(rr[1])); }
    constexpr float C2 = 1.4426950408889634f * SCALE;
    if (__builtin_expect(__all((pmax - m_reg) * SCALE <= THR), 1)) { mn = m_reg; alpha = 1.f; }
    else { mn = fmaxf(m_reg, pmax); alpha = __builtin_amdgcn_exp2f((m_reg - mn) * C2); m_reg = mn; }
    const float mnL = -mn * C2;
    for (int r = 0; r < 16; ++r) p0[r] = fmaf(p0[r], C2, mnL); for (int r = 0; r < 16; ++r) p1[r] = fmaf(p1[r], C2, mnL);
    for (int r = 0; r < 16; ++r) p0[r] = __builtin_amdgcn_exp2f(p0[r]);
}
template <int MODE> __device__ __forceinline__ void finishSM(f32x16& p0, f32x16& p1, float alpha, float& l_reg, bf16x8& pa0, bf16x8& pa1, bf16x8& pa2, bf16x8& pa3) {
    if constexpr (MODE == 0) {
    for (int r = 0; r < 16; ++r) p1[r] = __builtin_amdgcn_exp2f(p1[r]);
    float ps = 0; for (int r = 0; r < 16; ++r) ps += p0[r]; for (int r = 0; r < 16; ++r) ps += p1[r];
    { auto rr = __builtin_amdgcn_permlane32_swap(__float_as_uint(ps), __float_as_uint(ps), false, false);
      ps = __uint_as_float(rr[0]) + __uint_as_float(rr[1]); }
    l_reg = l_reg * alpha + ps;
    } else { for (int r = 0; r < 16; ++r) p1[r] *= alpha; }
#define PK4(P, B_, OUT) do { unsigned a0 = cvtpk(P[B_+0], P[B_+1]), a1 = cvtpk(P[B_+2], P[B_+3]);                          \
        unsigned b0 = cvtpk(P[B_+4], P[B_+5]), b1 = cvtpk(P[B_+6], P[B_+7]);                                             \
        auto r0 = __builtin_amdgcn_permlane32_swap(a0, b0, false, false); auto r1 = __builtin_amdgcn_permlane32_swap(a1, b1, false, false); \
        u32x4 w = {r0[0], r1[0], r0[1], r1[1]}; OUT = *reinterpret_cast<bf16x8*>(&w); } while (0)
    PK4(p0, 0, pa0); PK4(p0, 8, pa1); PK4(p1, 0, pa2); PK4(p1, 8, pa3);
#undef PK4
}
template <int KB, bool SK, int MODE>
__device__ __forceinline__ void qkt(f32x16& p0, f32x16& p1, const char* K_lds, int r32, int hi, const bf16x8* qr, bool act, const float* bt) {
    if (SK && !act) { const float NEG = -__builtin_inff();
#pragma unroll
        for (int r = 0; r < 16; ++r) { p0[r] = NEG; p1[r] = NEG; } return; }
    if constexpr (MODE == 0) {
        const f32x4 b0 = *(const f32x4*)(bt), b1 = *(const f32x4*)(bt + 8), b2 = *(const f32x4*)(bt + 16), b3 = *(const f32x4*)(bt + 24);
        const f32x4 c0 = *(const f32x4*)(bt + 32), c1 = *(const f32x4*)(bt + 40), c2 = *(const f32x4*)(bt + 48), c3 = *(const f32x4*)(bt + 56);
        p0 = f32x16{b0[0], b0[1], b0[2], b0[3], b1[0], b1[1], b1[2], b1[3], b2[0], b2[1], b2[2], b2[3], b3[0], b3[1], b3[2], b3[3]};
        p1 = f32x16{c0[0], c0[1], c0[2], c0[3], c1[0], c1[1], c1[2], c1[3], c2[0], c2[1], c2[2], c2[3], c3[0], c3[1], c3[2], c3[3]};
    } else { p0 = f32x16{}; p1 = f32x16{}; }
    const char* kb[4];
#pragma unroll
    for (int dd = 0; dd < 4; ++dd) kb[dd] = K_lds + KB * SHM_K + KSWZ(r32, (dd * 16 + hi * 8) * 2);
#pragma unroll
    for (int d0 = 0; d0 < 8; ++d0) { const char* a = kb[d0 & 3] + (d0 >> 2) * 128;
        bf16x8 b0 = *reinterpret_cast<const bf16x8*>(a);
        bf16x8 b1 = *reinterpret_cast<const bf16x8*>(a + 32 * 256);
        p0 = __builtin_amdgcn_mfma_f32_32x32x16_bf16(b0, qr[d0], p0, 0, 0, 0);
        p1 = __builtin_amdgcn_mfma_f32_32x32x16_bf16(b1, qr[d0], p1, 0, 0, 0); }
}
template <int VB, bool SK>
__device__ __forceinline__ void pv_tile(f32x16* o, int vb0, bf16x8 pa0, bf16x8 pa1, bf16x8 pa2, bf16x8 pa3, bool act) {
    if (SK && !act) return;
#define TRRD(dst, off) asm volatile("ds_read_b64_tr_b16 %0, %1 offset:%2" : "=&v"(dst) : "v"(vb0), "i"(off) : "memory")
#define PV_D0(d0) do { s16x4 l0, l1, l2, l3, h0, h1, h2, h3; constexpr int b_ = VB * SHM_V + v_rd_off(d0, 0, 0);     \
        TRRD(l0, b_); TRRD(h0, b_ + 2048); TRRD(l1, b_ + 4096); TRRD(h1, b_ + 6144); TRRD(l2, b_ + 8192); TRRD(h2, b_ + 10240); TRRD(l3, b_ + 12288); TRRD(h3, b_ + 14336); \
        asm volatile("s_waitcnt lgkmcnt(0)" ::: "memory"); SBAR();                 \
        o[d0] = __builtin_amdgcn_mfma_f32_32x32x16_bf16(pa0, (bf16x8){l0[0], l0[1], l0[2], l0[3], h0[0], h0[1], h0[2], h0[3]}, o[d0], 0, 0, 0);   \
        o[d0] = __builtin_amdgcn_mfma_f32_32x32x16_bf16(pa1, (bf16x8){l1[0], l1[1], l1[2], l1[3], h1[0], h1[1], h1[2], h1[3]}, o[d0], 0, 0, 0);   \
        o[d0] = __builtin_amdgcn_mfma_f32_32x32x16_bf16(pa2, (bf16x8){l2[0], l2[1], l2[2], l2[3], h2[0], h2[1], h2[2], h2[3]}, o[d0], 0, 0, 0);   \
        o[d0] = __builtin_amdgcn_mfma_f32_32x32x16_bf16(pa3, (bf16x8){l3[0], l3[1], l3[2], l3[3], h3[0], h3[1], h3[2], h3[3]}, o[d0], 0, 0, 0); } while (0)
    PV_D0(0); PV_D0(1); PV_D0(2); PV_D0(3);
#undef PV_D0
#undef TRRD
}

template <class TIn, class TOut> struct BlockRef { const TIn* Q; const TIn* K; const TIn* V; TOut* O; int P0; int jlo; int bh; };
template <class TIn> struct NextRef { const TIn* Q; const TIn* K; const TIn* V; int jlo; };
template <class TIn> struct Extra { const float* bias; const TIn* G; const float* nw; const TIn* S; };
constexpr int LDO = 2048;
template <class TIn> struct Seam {
    bf16x8 qr[8];
    bf16x8 st_v0, st_v1, st_k0, st_k1; f32x4 sf0, sf1, sf2, sf3;
    f32x4 tq[16];
};
#define ROW(p, k0, rr) ((p) + (unsigned)(((k0) + (rr)) * D + sc))
#define VMW() asm volatile("s_waitcnt vmcnt(0)" ::: "memory")
#define VMWN(n) asm volatile("s_waitcnt vmcnt(%0)" :: "i"(n) : "memory")
#define SLOAD_H(Kp, Vp, k0) do { S.st_v0 = load8<TIn>(ROW(Vp, k0, sr)); S.st_v1 = load8<TIn>(ROW(Vp, k0, 32 + sr));              \
                         S.st_k0 = load8<TIn>(ROW(Kp, k0, sr)); S.st_k1 = load8<TIn>(ROW(Kp, k0, 32 + sr)); } while (0)
#define SWRITE_HK(bf) do { *(bf16x8*)(K_lds + (bf) * SHM_K + kws) = S.st_k0; *(bf16x8*)(K_lds + (bf) * SHM_K + kws + 32 * 256) = S.st_k1; } while (0)
#define SWRITE_HV(bf) do { *(bf16x8*)(V_lds + (bf) * SHM_V + vst0) = S.st_v0; *(bf16x8*)(V_lds + (bf) * SHM_V + vst1) = S.st_v1; } while (0)
#define SWRITE_H(bf) do { SWRITE_HV(bf); SWRITE_HK(bf); } while (0)
#define SLOAD_F(p, k0) do { S.sf0 = *(const f32x4*)ROW(p, k0, sr); S.sf1 = *(const f32x4*)(ROW(p, k0, sr) + 4);                \
                            S.sf2 = *(const f32x4*)ROW(p, k0, 32 + sr); S.sf3 = *(const f32x4*)(ROW(p, k0, 32 + sr) + 4); } while (0)
#define SWRITE_KF(bf) do { *(bf16x8*)(K_lds + (bf) * SHM_K + kws) = pack8(S.sf0, S.sf1); *(bf16x8*)(K_lds + (bf) * SHM_K + kws + 32 * 256) = pack8(S.sf2, S.sf3); } while (0)
#define SWRITE_VF(bf) do { *(bf16x8*)(V_lds + (bf) * SHM_V + vst0) = pack8(S.sf0, S.sf1); *(bf16x8*)(V_lds + (bf) * SHM_V + vst1) = pack8(S.sf2, S.sf3); } while (0)
template <class TIn, class TOut>
__device__ __forceinline__ void causal_swa_prime(const BlockRef<TIn, TOut>& cur, int W, char* lds, Seam<TIn>& S) {
    constexpr bool F32 = same_t<TIn, float>::v;
    const int tid = threadIdx.x, wid = __builtin_amdgcn_readfirstlane(tid >> 6), lane = tid & 63, r32 = lane & 31, hi = lane >> 5;
    const int sr = tid >> 4, sc = (tid & 15) * 8, kws = KSWZ(sr, sc * 2); char* K_lds = lds + 2 * SHM_V;
    const int kb0 = cur.jlo * KVBLK;
    for (int d0 = 0; d0 < 8; ++d0) S.qr[d0] = load8<TIn>(cur.Q + (unsigned)((wid * QBLK + r32) * D + d0 * 16 + hi * 8));
    if constexpr (F32) { SLOAD_F((const float*)cur.K, kb0); VMW(); SWRITE_KF(0); SBAR(); SLOAD_F((const float*)cur.V, kb0); }
    else { SLOAD_H(cur.K, cur.V, kb0); VMW(); SWRITE_HK(0); }
    __syncthreads();
}
template <int MODE, class TIn, class TOut>
__device__ __forceinline__ void causal_swa_block(const BlockRef<TIn, TOut>& cur, const NextRef<TIn>& nxt, const Extra<TIn>& X, int skv, int W, char* lds, Seam<TIn>& S) {
    constexpr bool F32 = same_t<TIn, float>::v;
    int tid_ = threadIdx.x; asm volatile("" : "+v"(tid_));
    const int tid = tid_, wid = __builtin_amdgcn_readfirstlane(tid >> 6), lane = tid & 63, r32 = lane & 31, hi = lane >> 5;
    const int j_lo = cur.jlo;
    int j_hi = (cur.P0 + QB - 1) / KVBLK + 1; if (j_hi > skv / KVBLK) j_hi = skv / KVBLK;
    const int NT = j_hi - j_lo;
    const int kbn = nxt.jlo * KVBLK;
    const int qlo = cur.P0 + wid * QBLK, qm = qlo + r32 - 4 * hi;
    char* V_lds = lds; char* K_lds = lds + 2 * SHM_V;
    float* ws = (float*)(lds + 2 * SHM_V + 2 * SHM_K) + wid * 64; float* li_l = ws, * al_l = ws + 32;
    float m_reg = -1e30f, l_reg = 0; f32x16 o[4] = {};
    const int sr = tid >> 4, sc = (tid & 15) * 8, vst0 = v_st(sr, sc), vst1 = v_st(32 + sr, sc), kws = KSWZ(sr, sc * 2);
    const int vb0 = (int)(uintptr_t)V_lds + v_rd_base(lane);
    const TIn* Kh = cur.K; const TIn* Vh = cur.V;
    const float* bl = (const float*)(lds + LDS_BIAS) + 4 * hi;
    if constexpr (MODE == 0) { for (int i = tid; i < NT * 16; i += 64 * NW) *(f32x4*)(lds + LDS_BIAS + i * 16) = *(const f32x4*)(X.bias + (size_t)cur.bh * 8192 + j_lo * KVBLK + i * 4); __syncthreads(); }
    const float l2g = MODE ? log2f(1.f - exp2f(-5.f - (float)(cur.bh & 7))) : 0.f;
    if constexpr (MODE == 1) {
        const TIn* Sg = X.S + ((size_t)(cur.bh * 32 + (cur.P0 >> 8))) * 16384 + (unsigned)(r32 * D + hi * 8);
        const float fq = __builtin_amdgcn_exp2f(l2g * (float)(wid * QBLK + r32 + 1));
#pragma unroll
        for (int d0 = 0; d0 < 8; ++d0) { const u32x4 qw = *reinterpret_cast<const u32x4*>(&S.qr[d0]); u32x4 sw;
#pragma unroll
            for (int i = 0; i < 4; ++i) sw[i] = cvtpk(__uint_as_float(qw[i] << 16) * fq, __uint_as_float(qw[i] & 0xffff0000u) * fq);
            const bf16x8 qs = *reinterpret_cast<const bf16x8*>(&sw);
#pragma unroll
            for (int eb = 0; eb < 4; ++eb) { const bf16x8 sb = *reinterpret_cast<const bf16x8*>(Sg + eb * 32 * D + d0 * 16); o[eb] = __builtin_amdgcn_mfma_f32_32x32x16_bf16(qs, sb, o[eb], 0, 0, 0); }
            if (d0 & 1) asm volatile("" ::: "memory"); }
    }
#define BT(t) (bl + (t) * KVBLK)
#define PSM(P0_, P1_, mnX, alX, t) do { if constexpr (MODE == 0) partialSM(P0_, P1_, m_reg, mnX, alX); else { alX = __builtin_amdgcn_exp2f(l2g * (float)(qlo + r32 - KBASE(t))); partialRet(P0_, alX); } } while (0)
#define RESC(a) do { if (MODE == 0 && __any((a) < 1.f)) { if (hi == 0) al_l[r32] = (a); asm volatile("s_waitcnt lgkmcnt(0)" ::: "memory");              \
                     for (int d_ = 0; d_ < 4; ++d_) for (int r = 0; r < 16; ++r) o[d_][r] *= al_l[crow(r, hi)]; } } while (0)
#define KBASE(t) ((j_lo + (t)) * KVBLK)
#define ACT(t) (KBASE(t) <= qlo + QBLK - 1 && KBASE(t) + KVBLK - 1 >= qlo - W + 1)
#define MASKT(P0_, P1_, t) do { const int kb_ = KBASE(t); if ((!SK || ACT(t)) && (kb_ + KVBLK - 1 > qlo || kb_ <= qlo + QBLK - 1 - W)) mask_tile<MODE>(P0_, P1_, qm - kb_, (unsigned)W); } while (0)
    constexpr int NQL = F32 ? 16 : 8;
    constexpr bool SK = WSKIP && !F32;
#define SEAM_K0() do { VMWN(NQL); if constexpr (F32) { SWRITE_KF(0); SBAR(); SLOAD_F((const float*)nxt.V, kbn); } else { SWRITE_HK(0); } SBAR(); } while (0)
    f32x16 pA0, pA1, pB0, pB1; float mnA, mnB, alA, alB; bf16x8 pa0, pa1, pa2, pa3;
    if constexpr (F32) { VMW(); SWRITE_VF(0); SBAR(); } else { SWRITE_HV(0); SBAR(); }
    if (NT > 1) { if constexpr (F32) SLOAD_F((const float*)Kh, KBASE(1)); else SLOAD_H(Kh, Vh, KBASE(1)); }
    SBAR(); qkt<0, SK, MODE>(pA0, pA1, K_lds, r32, hi, S.qr, ACT(0), BT(0));
    if constexpr (F32) { if (NT > 1) { VMW(); SWRITE_KF(1); SBAR(); SLOAD_F((const float*)Vh, KBASE(1)); } }
    MASKT(pA0, pA1, 0); PSM(pA0, pA1, mnA, alA, 0);
    if (NT > 1) { VMW(); if constexpr (F32) { SWRITE_VF(1); SBAR(); if (NT > 2) SLOAD_F((const float*)Kh, KBASE(2)); } else SWRITE_H(1); }
    __syncthreads();
#define HALF_STEP(PX0, PX1, mnX, alX, PY0, PY1, alY, t, KB, VB, SB) do {                                                      \
        SBAR(); qkt<KB, SK, MODE>(PX0, PX1, K_lds, r32, hi, S.qr, ACT(t), BT(t));                                \
        finishSM<MODE>(PY0, PY1, alY, l_reg, pa0, pa1, pa2, pa3); SBAR();                                                           \
        if ((t) + 1 < NT) { if constexpr (F32) { VMW(); SWRITE_KF(SB); SBAR(); SLOAD_F((const float*)Vh, KBASE((t) + 1)); }  \
                            else { SLOAD_H(Kh, Vh, KBASE((t) + 1)); } SBAR(); }                                               \
        pv_tile<VB, SK>(o, vb0, pa0, pa1, pa2, pa3, ACT((t) - 1)); MASKT(PX0, PX1, (t)); PSM(PX0, PX1, mnX, alX, (t));                                        \
        __syncthreads();                                                                                                      \
        if ((t) + 1 < NT) { VMW(); if constexpr (F32) { SWRITE_VF(SB); SBAR(); if ((t) + 2 < NT) SLOAD_F((const float*)Kh, KBASE((t) + 2)); } \
                            else { SWRITE_H(SB); } }                                                                          \
        RESC(alX); __syncthreads(); } while (0)
    for (int t = 1; t + 1 < NT; t += 2) {
        HALF_STEP(pB0, pB1, mnB, alB, pA0, pA1, alA, t, 1, 0, 0);
        HALF_STEP(pA0, pA1, mnA, alA, pB0, pB1, alB, t + 1, 0, 1, 1);
    }
    const bool even = (NT & 1) == 0;
    if (even) { SBAR(); qkt<1, SK, MODE>(pB0, pB1, K_lds, r32, hi, S.qr, ACT(NT - 1), BT(NT - 1)); SBAR(); }
#define QROW(e) (nxt.Q + (size_t)(wid * QBLK + r32) * D + ((e) >> 1) * 16 + hi * 8 + ((e) & 1) * 4)
    if constexpr (F32) { SLOAD_F((const float*)nxt.K, kbn); SBAR();
#pragma unroll
        for (int e = 0; e < 8; ++e) S.tq[e] = *(const f32x4*)QROW(e); }
    else { SLOAD_H(nxt.K, nxt.V, kbn); SBAR();
#pragma unroll
        for (int d0 = 0; d0 < 8; ++d0) S.qr[d0] = load8<TIn>(nxt.Q + (unsigned)((wid * QBLK + r32) * D + d0 * 16 + hi * 8)); }
    SBAR();
    finishSM<MODE>(pA0, pA1, alA, l_reg, pa0, pa1, pa2, pa3); SBAR();
    if constexpr (F32) {
#pragma unroll
        for (int e = 8; e < 16; ++e) S.tq[e] = *(const f32x4*)QROW(e); SBAR(); }
#undef QROW
    pv_tile<0, SK>(o, vb0, pa0, pa1, pa2, pa3, ACT(even ? NT - 2 : NT - 1));
    if (even) { MASKT(pB0, pB1, NT - 1); PSM(pB0, pB1, mnB, alB, NT - 1); __syncthreads(); RESC(alB);
        finishSM<MODE>(pB0, pB1, alB, l_reg, pa0, pa1, pa2, pa3); SBAR(); pv_tile<1, SK>(o, vb0, pa0, pa1, pa2, pa3, ACT(NT - 1)); }
    SBAR(); SEAM_K0();
    float rli[16];
    if constexpr (MODE == 0) {
        if (hi == 0) li_l[r32] = l_reg; asm volatile("s_waitcnt lgkmcnt(0)" ::: "memory");
#pragma unroll
        for (int r = 0; r < 16; ++r) rli[r] = __builtin_amdgcn_rcpf(li_l[crow(r, hi)]);
    } else {
#pragma unroll
        for (int r = 0; r < 16; ++r) { float sq = (o[0][r] * o[0][r] + o[1][r] * o[1][r]) + (o[2][r] * o[2][r] + o[3][r] * o[3][r]);
            sq += __shfl_xor(sq, 1); sq += __shfl_xor(sq, 2); sq += __shfl_xor(sq, 4); sq += __shfl_xor(sq, 8); sq += __shfl_xor(sq, 16);
            rli[r] = rsqrtf(sq * (1.f / 128.f) + 1e-6f); }
    }
    { int t2 = threadIdx.x; asm volatile("" : "+v"(t2));
      const int w2 = __builtin_amdgcn_readfirstlane(t2 >> 6), c2 = t2 & 31, h2 = (t2 >> 5) & 1;
      TOut* Ow = cur.O + (unsigned)((w2 * QBLK + 4 * h2) * LDO + c2);
      float nwv[4] = {1.f, 1.f, 1.f, 1.f}; const TIn* Gp = nullptr;
      if constexpr (MODE == 1) { Gp = X.G + ((size_t)cur.bh * 8192 + cur.P0) * D + (unsigned)((w2 * QBLK + 4 * h2) * D + c2);
#pragma unroll
          for (int d0 = 0; d0 < 4; ++d0) nwv[d0] = X.nw[(cur.bh & 7) * D + d0 * 32 + c2]; }
#pragma unroll
      for (int r = 0; r < 16; ++r) { const int ro = (r & 3) + 8 * (r >> 2);
          float v[4];
#pragma unroll
          for (int d0 = 0; d0 < 4; ++d0) { v[d0] = o[d0][r] * rli[r];
              if constexpr (MODE == 1) { const unsigned gq = Gp[ro * D + d0 * 32]; v[d0] *= nwv[d0] * __uint_as_float(gq << 16); } }
#pragma unroll
          for (int d0 = 0; d0 < 4; ++d0) { const float vn = __shfl_xor(v[d0], 1);
              if ((c2 & 1) == 0) *(unsigned*)(Ow + ro * LDO + d0 * 32) = cvtpk(v[d0], vn); }
          if ((r & 3) == 3) asm volatile("" ::: "memory"); } }
    if constexpr (F32) {
#pragma unroll
        for (int d0 = 0; d0 < 8; ++d0) S.qr[d0] = pack8(S.tq[2 * d0], S.tq[2 * d0 + 1]); }
    __syncthreads();
#undef RESC
#undef BT
#undef PSM
#undef KBASE
#undef ACT
#undef MASKT
#undef SEAM_K0
#undef HALF_STEP
}
#undef ROW
#undef VMW
#undef VMWN
#undef SLOAD_H
#undef SWRITE_HK
#undef SWRITE_HV
#undef SWRITE_H
#undef SLOAD_F
#undef SWRITE_KF
#undef SWRITE_VF

}
constexpr int NWAVES = 8;
namespace W {
constexpr size_t CTL = 0, CTL_ZERO_BYTES = 1 * MiB;
constexpr size_t MOD = 1 * MiB, MODP = 2 * MiB, ROPE = 4 * MiB, LOGF = 8 * MiB, CUM = 9 * MiB, BIAS = 9 * MiB + 512 * 1024, ROUTE = 10 * MiB, TILE = 11 * MiB, JLO = 12 * MiB, WFR = 13 * MiB;
constexpr size_t XN = 16 * MiB, MIX = 80 * MiB, WT_IN = 144 * MiB, WT_OUT = 172 * MiB, WT_13 = 180 * MiB, WT_2 = 308 * MiB, QKV = 372 * MiB, END = 596 * MiB;
constexpr size_t KVS = XN, ST = XN + 32 * MiB;
constexpr size_t H2 = XN, XS = QKV, ACT = QKV + 160 * MiB, Y = 16 * MiB;
constexpr size_t NV_RO = 596 * MiB, NV_UP = 596 * MiB, NV_Z = 144 * MiB, NV_END = 676 * MiB;
}
constexpr int CW_CNT = 0;
constexpr int CW_BAR = 4096;
constexpr int RING_OFF = 0, RING_BYTES = 131072, XCH_OFF = 131072, XCH_BYTES = 8192, MISC_OFF = XCH_OFF + XCH_BYTES, LDS_BYTES = 147456;

struct Args { const float* in[19]; float* out; unsigned char* ws; int ph_lo, ph_hi, li, pad; };

__device__ __forceinline__ float wave_sum(float v) {
#pragma unroll
    for (int o = 1; o < 64; o <<= 1) v += __shfl_xor(v, o);
    return v;
}
__device__ __forceinline__ unsigned pk2(float lo, float hi) { return f2bf(lo) | (f2bf(hi) << 16); }
__device__ __forceinline__ float log_sigmoid_f(float x) { return x >= 0.f ? -log1pf(expf(-x)) : x - log1pf(expf(x)); }

__device__ __forceinline__ void tr_item(const float* colp, size_t ldw, bf16_t* WT, int K, int k0, int n0, LAS float* scr, int lane) {
#pragma unroll 8
    for (int i = 0; i < 32; ++i) { const int kk = 2 * i + (lane >> 5); scr[kk * 33 + (lane & 31)] = colp[(size_t)(k0 + kk) * ldw]; }
    LDS_WAIT(); asm volatile("" ::: "memory");
    const int c = lane & 7;
#pragma unroll
    for (int j = 0; j < 4; ++j) { const int n = (lane >> 3) + 8 * j; const LAS float* s = scr + (8 * c) * 33 + n;
        uint4 o; o.x = pk2(s[0 * 33], s[1 * 33]); o.y = pk2(s[2 * 33], s[3 * 33]); o.z = pk2(s[4 * 33], s[5 * 33]); o.w = pk2(s[6 * 33], s[7 * 33]);
        *(uint4*)(WT + (size_t)(n0 + n) * K + k0 + 8 * c) = o; }
    LDS_WAIT(); asm volatile("" ::: "memory");
}
__device__ __forceinline__ int win_src(int n) {
    const int tt = n >> 10;
    if (tt < 3) return n;
    if (tt < 5) { const int d = n & 127; return 8 + (n & ~127) + (d & 1) * 64 + (d >> 1); }
    return n + 8;
}
__device__ __forceinline__ void ph0(const Args& a, LAS unsigned char* lds, int G) {
    const int tid = threadIdx.x, lane = tid & 63, wave = __builtin_amdgcn_readfirstlane(tid >> 6);
    unsigned char* ws = a.ws;
    LAS float* cact = (LAS float*)(lds + RING_OFF + 98304);
    const float* c = a.in[1]; const float* w_ada = a.in[2];
    for (int i = tid; i < 4096; i += 512) { const float cv = c[i]; cact[i] = cv / (1.f + expf(-cv)); }
    __syncthreads();
    float* modp = (float*)(ws + W::MODP);
    for (int it = blockIdx.x; it < 384; it += G) { const int cb = it % 24, ks = it / 24, j = cb * 512 + tid; float a0 = 0.f, a1 = 0.f;
#pragma unroll 8
        for (int k = ks * 128; k < ks * 128 + 128; ++k) { const float w = w_ada[(size_t)k * 12288 + j]; a0 += cact[k] * w; a1 += cact[2048 + k] * w; }
        modp[(ks * 2 + 0) * 12288 + j] = a0; modp[(ks * 2 + 1) * 12288 + j] = a1; }
    float2* rope = (float2*)(ws + W::ROPE);
    for (int i = blockIdx.x * 512 + tid; i < 8192 * 64; i += G * 512) { const int s = i >> 6, j = i & 63;
        const float theta = powf(10000.f, -(float)j / 64.f); const float ang = (float)s * theta;
        const double ad = (double)ang, TWO_PI = 6.283185307179586; const double kq = rint(ad / TWO_PI); const float r = (float)(ad - kq * TWO_PI);
        rope[i] = make_float2(cosf(r), sinf(r)); }
    { bf16_t* wfr = (bf16_t*)(ws + W::WFR); const float* w_fine = a.in[14];
      for (int i = blockIdx.x * 512 + tid; i < 8 * 16 * 64 * 8; i += G * 512) { const int e8 = i & 7, ln = (i >> 3) & 63, ks = (i >> 9) & 15, w = i >> 13, col = ln & 31, hf = ln >> 5;
          const float wv = w_fine[((size_t)(col >> 3) * 2048 + 256 * w + 16 * ks + 8 * hf + e8) * 8 + (col & 7)]; const unsigned h = f2bf(wv), l = f2bf(wv - __uint_as_float(h << 16));
          wfr[(((size_t)(w * 16 + ks) * 2 + 0) * 64 + ln) * 8 + e8] = (bf16_t)h; wfr[(((size_t)(w * 16 + ks) * 2 + 1) * 64 + ln) * 8 + e8] = (bf16_t)l; } }
    LAS float* scr = (LAS float*)(lds + RING_OFF + wave * 12288);
    const float* w_in = a.in[5]; const float* w_out = a.in[10]; const float* w1 = a.in[16]; const float* w3 = a.in[17]; const float* w2 = a.in[18];
    bf16_t* wt_in = (bf16_t*)(ws + W::WT_IN); bf16_t* wt_out = (bf16_t*)(ws + W::WT_OUT); bf16_t* wt_13 = (bf16_t*)(ws + W::WT_13); bf16_t* wt_2 = (bf16_t*)(ws + W::WT_2);
    constexpr int I_IN = 32 * 224, I_OUT = 32 * 64, I_13 = 32 * 1024, I_2 = 32 * 512, NITEMS = I_IN + I_OUT + I_13 + I_2;
    const int gw = blockIdx.x * NWAVES + wave, NGW = G * NWAVES;
    for (int it = gw; it < NITEMS; it += NGW) {
        int r = it;
        if (r < I_IN) { const int kb = r / 224, nb = r % 224; tr_item(w_in + win_src(nb * 32 + (lane & 31)), 7176, wt_in, 2048, kb * 64, nb * 32, scr, lane); continue; } r -= I_IN;
        if (r < I_OUT) { const int kb = r / 64, nb = r % 64; tr_item(w_out + nb * 32 + (lane & 31), 2048, wt_out, 2048, kb * 64, nb * 32, scr, lane); continue; } r -= I_OUT;
        if (r < I_13) { const int e = r >> 10, r2 = r & 1023, kb = r2 >> 5, nb = r2 & 31; const int n = nb * 32 + (lane & 31), g = n >> 3, q = n & 7;
            const float* colp = (q < 4 ? w1 : w3) + (size_t)e * 2048 * 512 + 4 * g + (q & 3);
            tr_item(colp, 512, wt_13 + (size_t)e * 1024 * 2048, 2048, kb * 64, nb * 32, scr, lane); continue; } r -= I_13;
        { const int e = r >> 9, r2 = r & 511, kb = r2 >> 6, nb = r2 & 63;
          tr_item(w2 + (size_t)e * 512 * 2048 + nb * 32 + (lane & 31), 2048, wt_2 + (size_t)e * 2048 * 512, 512, kb * 64, nb * 32, scr, lane); }
    }
}

__device__ __forceinline__ void ph1(const Args& a, LAS unsigned char* lds, int G) {
    const int tid = threadIdx.x, lane = tid & 63, wave = __builtin_amdgcn_readfirstlane(tid >> 6);
    unsigned char* ws = a.ws;
    const float* x = a.in[0]; const float* b_ada = a.in[3]; const float* norm1_w = a.in[4]; const float* w_in = a.in[5]; const float* fbias = a.in[6];
    const float* modp = (const float*)(ws + W::MODP); float* mod = (float*)(ws + W::MOD); bf16_t* xn = (bf16_t*)(ws + W::XN); float* logf_ = (float*)(ws + W::LOGF);
    for (int i = blockIdx.x * 512 + tid; i < 2 * 12288; i += G * 512) { const int b = i / 12288, j = i % 12288; float s = b_ada[j];
        for (int k = 0; k < 16; ++k) s += modp[(k * 2 + b) * 12288 + j];
        mod[i] = s; }
    LAS float* A1 = (LAS float*)(lds + RING_OFF); LAS float* S1 = A1 + 2048; LAS float* SSX = S1 + 2048; LAS float* FAX = SSX + 16 * 8;
    const int col = wave * 256 + lane * 4;
    float wf[4][8];
#pragma unroll
    for (int e = 0; e < 4; ++e) { const float4 w0 = *(const float4*)(w_in + (size_t)(col + e) * 7176 + 3072), w1 = *(const float4*)(w_in + (size_t)(col + e) * 7176 + 3076);
        wf[e][0] = w0.x; wf[e][1] = w0.y; wf[e][2] = w0.z; wf[e][3] = w0.w; wf[e][4] = w1.x; wf[e][5] = w1.y; wf[e][6] = w1.z; wf[e][7] = w1.w; }
    int bprev = -1;
    for (int rb = blockIdx.x; rb < 256; rb += G) {
        const int b = rb >> 7;
        if (b != bprev) { __syncthreads();
            for (int cc = tid; cc < 2048; cc += 512) { float sh = b_ada[cc], sc = b_ada[2048 + cc];
                for (int k = 0; k < 16; ++k) { sh += modp[(k * 2 + b) * 12288 + cc]; sc += modp[(k * 2 + b) * 12288 + 2048 + cc]; }
                A1[cc] = norm1_w[cc] * (1.f + sc); S1[cc] = sh; }
            __syncthreads(); bprev = b; }
        const pg8::f32x4 a1 = *(const LAS pg8::f32x4*)(A1 + col), s1 = *(const LAS pg8::f32x4*)(S1 + col);
        for (int g = 0; g < 4; ++g) {
            const int r0 = rb * 64 + g * 16;
            float4 v[16];
#pragma unroll
            for (int i = 0; i < 16; ++i) v[i] = *(const float4*)(x + (size_t)(r0 + i) * 2048 + col);
#pragma unroll
            for (int i = 0; i < 16; ++i) { const float ss = wave_sum(v[i].x * v[i].x + v[i].y * v[i].y + v[i].z * v[i].z + v[i].w * v[i].w); if (lane == 0) SSX[i * 8 + wave] = ss; }
            __syncthreads();
#pragma unroll
            for (int i = 0; i < 16; ++i) { const pg8::f32x4 p0 = *(const LAS pg8::f32x4*)(SSX + i * 8), p1 = *(const LAS pg8::f32x4*)(SSX + i * 8 + 4);
                const float rstd = rsqrtf(((p0[0] + p0[1]) + (p0[2] + p0[3]) + (p1[0] + p1[1]) + (p1[2] + p1[3])) * (1.f / 2048.f) + 1e-6f);
                float h[4] = {v[i].x * rstd * a1[0] + s1[0], v[i].y * rstd * a1[1] + s1[1], v[i].z * rstd * a1[2] + s1[2], v[i].w * rstd * a1[3] + s1[3]};
                uint2 pk; pk.x = pk2(h[0], h[1]); pk.y = pk2(h[2], h[3]);
                *(uint2*)(xn + (size_t)(r0 + i) * 2048 + col) = pk;
#pragma unroll
                for (int hh = 0; hh < 8; ++hh) { const float p = wave_sum((h[0] * wf[0][hh] + h[1] * wf[1][hh]) + (h[2] * wf[2][hh] + h[3] * wf[3][hh])); if (lane == 0) FAX[(i * 8 + hh) * 8 + wave] = p; } }
            __syncthreads();
            if (tid < 128) { const int i = tid >> 3, hh = tid & 7; const pg8::f32x4 p0 = *(const LAS pg8::f32x4*)(FAX + tid * 8), p1 = *(const LAS pg8::f32x4*)(FAX + tid * 8 + 4);
                const float t = ((p0[0] + p0[1]) + (p0[2] + p0[3])) + ((p1[0] + p1[1]) + (p1[2] + p1[3])) + fbias[hh];
                const int row = r0 + i; logf_[(size_t)((row >> 13) * 8 + hh) * 8192 + (row & 8191)] = log_sigmoid_f(t); }
        }
    }
}

__device__ __forceinline__ void cumsum_bh(const Args& a, LAS unsigned char* lds, int bh) {
    const int tid = threadIdx.x; unsigned char* ws = a.ws;
    const float* p = (const float*)(ws + W::LOGF) + (size_t)bh * 8192 + tid * 16; float* cum = (float*)(ws + W::CUM) + (size_t)bh * 8192 + tid * 16; float* bias = (float*)(ws + W::BIAS) + (size_t)bh * 8192 + tid * 16;
    LAS double* sc = (LAS double*)(lds + RING_OFF);
    double run = 0.0;
#pragma unroll
    for (int i = 0; i < 16; ++i) run += (double)p[i];
    sc[tid] = run; __syncthreads();
    int cur = 0;
    for (int o = 1; o < 512; o <<= 1) { const double t = sc[cur * 512 + tid] + (tid >= o ? sc[cur * 512 + tid - o] : 0.0); sc[(cur ^ 1) * 512 + tid] = t; cur ^= 1; __syncthreads(); }
    double acc = sc[cur * 512 + tid] - run;
    LAS float* TE = (LAS float*)(lds + RING_OFF + 16384); LAS float* BS = TE + 128; LAS int* JL = (LAS int*)(BS + 32);
#pragma unroll
    for (int i = 0; i < 16; ++i) { acc += (double)p[i]; cum[i] = (float)acc; bias[i] = (float)(-acc * 11.313708498984761);
        if (i == 0 && (tid & 15) == 0) BS[tid >> 4] = (float)acc;
        if (i == 15 && (tid & 3) == 3) TE[tid >> 2] = (float)acc; }
    if (tid < 32) JL[tid] = 4 * tid;
    __syncthreads();
    float mq = 0.f, mk = 0.f;
    for (int i = 0; i < 128; ++i) { mq = fmaxf(mq, fabsf(a.in[7][i])); mk = fmaxf(mk, fabsf(a.in[8][i])); }
    const float thr = 30.f + 2.f * 11.313708498984761f * mq * mk;
    for (int pr = tid; pr < 32 * 128; pr += 512) { const int qb = pr >> 7, j = pr & 127; if (j <= 4 * qb && TE[j] < BS[qb] + thr) atomicMin((int*)(JL + qb), j); }
    __syncthreads();
    if (tid < 32) ((int*)(ws + W::JLO))[bh * 32 + tid] = JL[tid];
    __syncthreads();
}
struct EpiZ {
    static constexpr bool PERM = true, AFTER_DRAIN = false;
    bf16_t* qkv; const float* q_norm_w; const float* k_norm_w; const float* rope; PG8_LAS float* xch;
    __device__ __forceinline__ void operator()(const pg8::f32x4 (&acc)[2][2][4][2], const pg8::Unit& u, int wr, int wc, int fr, int fq) const {
        using pg8::f32x4; using pg8::u32x4;
        const int tt = u.pn >> 2, hp = (u.pn & 3) * 2;
        const int row0 = u.pm * 256 + wr * 64 + fr, b = row0 >> 13, dcol = wc * 32 + 8 * fq;
        bf16_t* base = qkv + (size_t)tt * QKV_ELEMS + ((size_t)(b * 8 + hp) * 8192) * 128 + dcol;
        if (tt < 2) {
#pragma unroll
            for (int ai = 0; ai < 2; ++ai)
#pragma unroll
                for (int m = 0; m < 4; ++m)
#pragma unroll
                    for (int bj = 0; bj < 2; ++bj) { const f32x4 v0 = acc[ai][bj][m][0], v1 = acc[ai][bj][m][1];
                        float s = (v0[0] * v0[0] + v0[1] * v0[1]) + (v0[2] * v0[2] + v0[3] * v0[3]) + (v1[0] * v1[0] + v1[1] * v1[1]) + (v1[2] * v1[2] + v1[3] * v1[3]);
                        s += __shfl_xor(s, 16); s += __shfl_xor(s, 32);
                        if (fq == 0) xch[((ai * 128 + wr * 64 + m * 16 + fr) * 2 + bj) * 4 + wc] = s; }
            asm volatile("s_waitcnt lgkmcnt(0)" ::: "memory"); __builtin_amdgcn_s_barrier(); asm volatile("" ::: "memory");
            const float* nw = tt == 0 ? q_norm_w : k_norm_w; const f32x4 w0 = *(const f32x4*)(nw + dcol), w1 = *(const f32x4*)(nw + dcol + 4);
#pragma unroll
            for (int ai = 0; ai < 2; ++ai)
#pragma unroll
                for (int m = 0; m < 4; ++m) { const int rl = ai * 128 + wr * 64 + m * 16 + fr; const int s_ = (row0 + ai * 128 + m * 16) & 8191;
#pragma unroll
                    for (int bj = 0; bj < 2; ++bj) { const f32x4 p = *(const PG8_LAS f32x4*)(xch + (rl * 2 + bj) * 4);
                        const float rstd = rsqrtf(((p[0] + p[1]) + (p[2] + p[3])) * (1.f / 128.f) + 1e-6f);
                        const f32x4 v0 = acc[ai][bj][m][0] * rstd * w0, v1 = acc[ai][bj][m][1] * rstd * w1;
                        u32x4 w; w.x = pg8::cvt_pk_bf16(v0[0], v0[1]); w.y = pg8::cvt_pk_bf16(v0[2], v0[3]); w.z = pg8::cvt_pk_bf16(v1[0], v1[1]); w.w = pg8::cvt_pk_bf16(v1[2], v1[3]);
                        *(u32x4*)(base + ((size_t)bj * 8192 + s_) * 128) = w; } }
        } else if (tt == 3 || tt == 4) {
            float l2g[2];
#pragma unroll
            for (int bj = 0; bj < 2; ++bj) l2g[bj] = log2f(1.f - exp2f(-5.f - (float)(hp + bj)));
#pragma unroll
            for (int ai = 0; ai < 2; ++ai)
#pragma unroll
                for (int m = 0; m < 4; ++m) { const int s_ = (row0 + ai * 128 + m * 16) & 8191;
                    const f32x4 c0 = *(const f32x4*)(rope + ((size_t)s_ * 64 + (dcol >> 1)) * 2), c1 = *(const f32x4*)(rope + ((size_t)s_ * 64 + (dcol >> 1) + 2) * 2);
#pragma unroll
                    for (int bj = 0; bj < 2; ++bj) { const f32x4 v0 = acc[ai][bj][m][0], v1 = acc[ai][bj][m][1];
                        const float f = tt == 4 ? 0.08838834764831845f * exp2f(-(float)(s_ & 63) * l2g[bj]) : 1.f;
                        const float o0 = (v0[0] * c0[0] - v0[1] * c0[1]) * f, o1 = (v0[0] * c0[1] + v0[1] * c0[0]) * f, o2 = (v0[2] * c0[2] - v0[3] * c0[3]) * f, o3 = (v0[2] * c0[3] + v0[3] * c0[2]) * f;
                        const float o4 = (v1[0] * c1[0] - v1[1] * c1[1]) * f, o5 = (v1[0] * c1[1] + v1[1] * c1[0]) * f, o6 = (v1[2] * c1[2] - v1[3] * c1[3]) * f, o7 = (v1[2] * c1[3] + v1[3] * c1[2]) * f;
                        u32x4 w; w.x = pg8::cvt_pk_bf16(o0, o1); w.y = pg8::cvt_pk_bf16(o2, o3); w.z = pg8::cvt_pk_bf16(o4, o5); w.w = pg8::cvt_pk_bf16(o6, o7);
                        *(u32x4*)(base + ((size_t)bj * 8192 + s_) * 128) = w; } }
        } else {
#pragma unroll
            for (int ai = 0; ai < 2; ++ai)
#pragma unroll
                for (int m = 0; m < 4; ++m) { const int s_ = (row0 + ai * 128 + m * 16) & 8191;
#pragma unroll
                    for (int bj = 0; bj < 2; ++bj) { f32x4 v0 = acc[ai][bj][m][0], v1 = acc[ai][bj][m][1];
                        if (tt == 6) {
#pragma unroll
                            for (int e = 0; e < 4; ++e) { v0[e] = v0[e] / (1.f + __expf(-v0[e])); v1[e] = v1[e] / (1.f + __expf(-v1[e])); } }
                        u32x4 w; w.x = pg8::cvt_pk_bf16(v0[0], v0[1]); w.y = pg8::cvt_pk_bf16(v0[2], v0[3]); w.z = pg8::cvt_pk_bf16(v1[0], v1[1]); w.w = pg8::cvt_pk_bf16(v1[2], v1[3]);
                        *(u32x4*)(base + ((size_t)bj * 8192 + s_) * 128) = w; } }
        }
    }
};


__device__ __forceinline__ void kv_units(const Args& a, char* lds, int G) {
    using namespace at;
    const int tid = threadIdx.x, wid = __builtin_amdgcn_readfirstlane(tid >> 6), lane = tid & 63, r32 = lane & 31, hi = lane >> 5;
    const int sr = tid >> 4, sc = (tid & 15) * 8, st0 = v_st(sr, sc), st1 = v_st(32 + sr, sc);
    const int dblk = wid >> 1, eb0 = (wid & 1) * 2;
    const int kb_ = (int)(uintptr_t)lds + v_rd_base(lane) + dblk * 512, vb_ = (int)(uintptr_t)lds + 32768 + v_rd_base(lane) + eb0 * 512;
    const bf16* q = (const bf16*)(a.ws + W::QKV); float* kvs = (float*)(a.ws + W::KVS);
#define TRRD(dst, base, off) asm volatile("ds_read_b64_tr_b16 %0, %1 offset:%2" : "=&v"(dst) : "v"(base), "i"(off) : "memory")
#define KV_STEP(BUF, KS) do { s16x4 al, ah, b0l, b0h, b1l, b1h; constexpr int o_ = (BUF) * 16384 + (KS) * 4096; \
        TRRD(al, kb_, o_); TRRD(ah, kb_, o_ + 2048); TRRD(b0l, vb_, o_); TRRD(b0h, vb_, o_ + 2048); TRRD(b1l, vb_, o_ + 512); TRRD(b1h, vb_, o_ + 512 + 2048); \
        asm volatile("s_waitcnt lgkmcnt(0)" ::: "memory"); SBAR(); \
        const bf16x8 A_ = {al[0], al[1], al[2], al[3], ah[0], ah[1], ah[2], ah[3]}; \
        acc0 = __builtin_amdgcn_mfma_f32_32x32x16_bf16(A_, (bf16x8){b0l[0], b0l[1], b0l[2], b0l[3], b0h[0], b0h[1], b0h[2], b0h[3]}, acc0, 0, 0, 0); \
        acc1 = __builtin_amdgcn_mfma_f32_32x32x16_bf16(A_, (bf16x8){b1l[0], b1l[1], b1l[2], b1l[3], b1h[0], b1h[1], b1h[2], b1h[3]}, acc1, 0, 0, 0); } while (0)
#define KV_LOAD(T) do { k0 = *(const bf16x8*)(Kp + (unsigned)((64 * (T) + sr) * 128 + sc)); k1 = *(const bf16x8*)(Kp + (unsigned)((64 * (T) + 32 + sr) * 128 + sc)); \
                        v0 = *(const bf16x8*)(Vp + (unsigned)((64 * (T) + sr) * 128 + sc)); v1 = *(const bf16x8*)(Vp + (unsigned)((64 * (T) + 32 + sr) * 128 + sc)); } while (0)
#define KV_WRITE(BUF) do { *(bf16x8*)(lds + (BUF) * 16384 + st0) = k0; *(bf16x8*)(lds + (BUF) * 16384 + st1) = k1; *(bf16x8*)(lds + 32768 + (BUF) * 16384 + st0) = v0; *(bf16x8*)(lds + 32768 + (BUF) * 16384 + st1) = v1; } while (0)
#define KV_TILE(T, BUF) do { if ((T) < 3) KV_LOAD((T) + 1); if ((T) > 0) { acc0 *= g64; acc1 *= g64; } \
        KV_STEP(BUF, 0); KV_STEP(BUF, 1); KV_STEP(BUF, 2); KV_STEP(BUF, 3); if ((T) < 3) { KV_WRITE(1 - (BUF)); } __syncthreads(); } while (0)
    for (int L = blockIdx.x; L < 512; L += G) {
        const int bh = L >> 5, c = L & 31;
        const float l2g = log2f(1.f - exp2f(-5.f - (float)(bh & 7))), g64 = exp2f(64.f * l2g), g63 = exp2f(63.f * l2g);
        const bf16* Kp = q + 4 * QKV_ELEMS + ((size_t)bh * 8192 + c * 256) * 128; const bf16* Vp = q + 5 * QKV_ELEMS + ((size_t)bh * 8192 + c * 256) * 128;
        f32x16 acc0 = {}, acc1 = {}; bf16x8 k0, k1, v0, v1;
        KV_LOAD(0); KV_WRITE(0); __syncthreads();
        KV_TILE(0, 0); KV_TILE(1, 1); KV_TILE(2, 0); KV_TILE(3, 1);
        float* out = kvs + ((size_t)(bh * 32 + c)) * 16384 + (unsigned)((dblk * 32 + 4 * hi) * 128 + eb0 * 32 + r32);
#pragma unroll
        for (int r = 0; r < 16; ++r) { const int ro = (r & 3) + 8 * (r >> 2); out[ro * 128] = g63 * acc0[r]; out[ro * 128 + 32] = g63 * acc1[r]; }
    }
#undef TRRD
#undef KV_STEP
#undef KV_LOAD
#undef KV_WRITE
#undef KV_TILE
}
__device__ __forceinline__ void scan_units(const Args& a, LAS unsigned char* lds, int G) {
    const int tid = threadIdx.x, dl = tid >> 6, e2 = (tid & 63) * 2;
    const float* kvs = (const float*)(a.ws + W::KVS); bf16_t* st = (bf16_t*)(a.ws + W::ST);
    LAS bf16_t* T = (LAS bf16_t*)(lds + RING_OFF);
    for (int L = blockIdx.x; L < 256; L += G) {
        const int bh = L >> 4, d0 = (L & 15) * 8;
        const float g256 = exp2f(256.f * log2f(1.f - exp2f(-5.f - (float)(bh & 7))));
        float2 kv[32];
#pragma unroll
        for (int c = 0; c < 32; ++c) kv[c] = *(const float2*)(kvs + ((size_t)(bh * 32 + c)) * 16384 + (d0 + dl) * 128 + e2);
        float s0 = 0.f, s1 = 0.f;
#pragma unroll
        for (int c = 0; c < 32; ++c) {
            T[e2 * 8 + dl] = (bf16_t)f2bf(s0); T[(e2 + 1) * 8 + dl] = (bf16_t)f2bf(s1);
            __syncthreads();
            if (tid < 128) *(pg8::u32x4*)(st + (((size_t)(bh * 32 + c)) * 128 + tid) * 128 + d0) = *(const LAS pg8::u32x4*)(T + tid * 8);
            s0 = g256 * s0 + kv[c].x; s1 = g256 * s1 + kv[c].y;
            __syncthreads();
        }
    }
}
typedef at::BlockRef<at::bf16, at::bf16> ARef;
template <int MODE> __device__ __forceinline__ ARef attn_ref(const Args& a, int L, int pass) {
    const int bh = L >> 4, x = L & 15, qb = pass ? 31 - x : x, b = bh >> 3, h = bh & 7;
    const at::bf16* q = (const at::bf16*)(a.ws + W::QKV) + (MODE ? 3 * QKV_ELEMS : 0); ARef r;
    r.Q = q + ((size_t)bh * 8192 + qb * 256) * 128; r.K = q + QKV_ELEMS + (size_t)bh * 8192 * 128; r.V = q + 2 * QKV_ELEMS + (size_t)bh * 8192 * 128;
    r.O = (at::bf16*)(a.ws + W::MIX) + ((size_t)(b * 8192 + qb * 256)) * 2048 + (MODE ? 1024 : 0) + h * 128; r.P0 = qb * 256; r.bh = bh; r.jlo = MODE ? 0 : ((const int*)(a.ws + W::JLO))[bh * 32 + qb];
    if (MODE) r.jlo = 4 * qb;
    return r;
}
template <int MODE> __device__ __forceinline__ void attn_stream(const Args& a, char* lds, int G) {
    int L = blockIdx.x; if (L >= 256) return;
    int pass = 0; ARef cur = attn_ref<MODE>(a, L, 0);
    const at::Extra<at::bf16> X{(const float*)(a.ws + W::BIAS), (const at::bf16*)(a.ws + W::QKV) + 6 * QKV_ELEMS, a.in[9], (const at::bf16*)(a.ws + W::ST)};
    at::Seam<at::bf16> S;
    at::causal_swa_prime<at::bf16, at::bf16>(cur, at::WBIG, lds, S);
    for (;;) {
        const bool more_pass = pass == 0, more_item = L + G < 256, last = !more_pass && !more_item;
        int Ln = L, passn = 1; if (!more_pass) { passn = 0; Ln = more_item ? L + G : L; }
        const ARef nr = last ? cur : attn_ref<MODE>(a, Ln, passn);
        const at::NextRef<at::bf16> nxt{nr.Q, nr.K, nr.V, nr.jlo};
        at::causal_swa_block<MODE, at::bf16, at::bf16>(cur, nxt, X, 8192, at::WBIG, lds, S);
        if (last) break;
        cur = attn_ref<MODE>(a, Ln, passn); L = Ln; pass = passn;
    }
}


struct EpiX1 {
    static constexpr bool PERM = false, AFTER_DRAIN = false;
    const float* x; const float* mod; float* out;
    __device__ __forceinline__ void operator()(const pg8::f32x4 (&acc)[2][2][4][2], const pg8::Unit& u, int wr, int wc, int fr, int fq) const {
        using pg8::f32x4;
        const int row0 = u.pm * 256 + wr * 64 + fr, b = row0 >> 13, col0 = u.pn * 256 + wc * 32 + 4 * fq;
        f32x4 g[2][2];
#pragma unroll
        for (int bj = 0; bj < 2; ++bj)
#pragma unroll
            for (int n = 0; n < 2; ++n) g[bj][n] = *(const f32x4*)(mod + b * 12288 + 4096 + col0 + bj * 128 + n * 16);
#pragma unroll
        for (int ai = 0; ai < 2; ++ai)
#pragma unroll
            for (int m = 0; m < 4; ++m) { const size_t off = (size_t)(row0 + ai * 128 + m * 16) * 2048 + col0;
#pragma unroll
                for (int bj = 0; bj < 2; ++bj)
#pragma unroll
                    for (int n = 0; n < 2; ++n) { const f32x4 xv = *(const f32x4*)(x + off + bj * 128 + n * 16); *(f32x4*)(out + off + bj * 128 + n * 16) = xv + g[bj][n] * acc[ai][bj][m][n]; }
                if (m & 1) asm volatile("" ::: "memory"); }
    }
};

typedef short bfx8 __attribute__((ext_vector_type(8)));
typedef float f32x16_t __attribute__((ext_vector_type(16)));
__device__ __forceinline__ void split8(const float* v, bfx8& h, bfx8& l) {
    unsigned hw[4], lw[4];
#pragma unroll
    for (int i = 0; i < 4; ++i) { const unsigned h0 = f2bf(v[2 * i]), h1 = f2bf(v[2 * i + 1]); hw[i] = h0 | (h1 << 16);
        const float r0 = v[2 * i] - __uint_as_float(h0 << 16), r1 = v[2 * i + 1] - __uint_as_float(h1 << 16); lw[i] = f2bf(r0) | (f2bf(r1) << 16); }
    typedef unsigned u4 __attribute__((ext_vector_type(4)));
    const u4 hv = {hw[0], hw[1], hw[2], hw[3]}, lv = {lw[0], lw[1], lw[2], lw[3]};
    h = __builtin_bit_cast(bfx8, hv); l = __builtin_bit_cast(bfx8, lv);
}
__device__ __forceinline__ void ph5(const Args& a, LAS unsigned char* lds, int G) {
    const int tid = threadIdx.x, lane = tid & 63, wave = __builtin_amdgcn_readfirstlane(tid >> 6), r32 = lane & 31, hi = lane >> 5;
    unsigned char* ws = a.ws; const float* x1 = a.out;
    const float* norm2_w = a.in[11]; const float* w_coarse = a.in[12]; const float* b_coarse = a.in[13]; const float* w_fine = a.in[14]; const float* b_fine = a.in[15];
    const float* mod = (const float*)(ws + W::MOD); bf16_t* h2 = (bf16_t*)(ws + W::H2);
    int* r_eid = (int*)(ws + W::ROUTE); float* r_gate = (float*)(ws + W::ROUTE + 128 * 1024); int* r_idx = (int*)(ws + W::ROUTE + 256 * 1024); int* cnt = (int*)(ws + W::CTL) + CW_CNT;
    LAS float* A2 = (LAS float*)(lds + RING_OFF); LAS float* S2 = A2 + 2048; LAS float* CST = S2 + 2048; LAS float* SSP = CST + 64; LAS float* RSTD = SSP + 256; LAS float* CP = RSTD + 32; LAS float* FP = CP + 1024; LAS float* WCL = FP + 8192;
    for (int i = tid; i < 2048; i += 512) *(LAS pg8::f32x4*)(WCL + i * 4) = *(const pg8::f32x4*)(w_coarse + (size_t)i * 4);
    const bfx8* wfrw = (const bfx8*)(ws + W::WFR) + (size_t)wave * 16 * 2 * 64;
    int bprev = -1;
    for (int rb = blockIdx.x; rb < 256; rb += G) {
        const int b = rb >> 7;
        if (b != bprev) { __syncthreads(); bprev = b;
            const float* sh = mod + b * 12288 + 6144; const float* sc = sh + 2048;
            for (int cc = tid; cc < 2048; cc += 512) { A2[cc] = norm2_w[cc] * (1.f + sc[cc]); S2[cc] = sh[cc]; }
            __syncthreads();
            for (int c0 = 0; c0 < 36; c0 += 4) {
                float part[4] = {0.f, 0.f, 0.f, 0.f};
#pragma unroll
                for (int q = 0; q < 4; ++q) { const int k = tid * 4 + q; const float sv = S2[k];
                    const float4 wv = c0 == 0 ? *(const float4*)(w_coarse + (size_t)k * 4) : *(const float4*)(w_fine + ((size_t)((c0 - 4) >> 3) * 2048 + k) * 8 + ((c0 - 4) & 7));
                    part[0] += sv * wv.x; part[1] += sv * wv.y; part[2] += sv * wv.z; part[3] += sv * wv.w; }
#pragma unroll
                for (int i = 0; i < 4; ++i) { const float t = wave_sum(part[i]); if (lane == 0) FP[(c0 + i) * 8 + wave] = t; } }
            __syncthreads();
            if (tid < 36) { float t = tid < 4 ? b_coarse[tid] : b_fine[tid - 4];
                for (int w = 0; w < 8; ++w) t += FP[tid * 8 + w];
                CST[tid] = t; }
            __syncthreads(); }
        for (int tile = 0; tile < 2; ++tile) {
            const int r0 = rb * 64 + tile * 32;
            f32x16_t acc = {}; float cacc[4] = {0.f, 0.f, 0.f, 0.f}; float ss = 0.f;
            const float* xr = x1 + (size_t)(r0 + r32) * 2048 + 256 * wave + 8 * hi; const int kb = 256 * wave + 8 * hi;
            unsigned ln = lane; asm volatile("" : "+v"(ln));
#pragma unroll 1
            for (int ch = 0; ch < 4; ++ch) {
                pg8::f32x4 xa[8]; bfx8 ba[8];
#pragma unroll
                for (int i = 0; i < 4; ++i) { xa[2 * i] = *(const pg8::f32x4*)(xr + 64 * ch + 16 * i); xa[2 * i + 1] = *(const pg8::f32x4*)(xr + 64 * ch + 16 * i + 4);
                    ba[2 * i] = (wfrw + ((4 * ch + i) * 2) * 64)[ln]; ba[2 * i + 1] = (wfrw + ((4 * ch + i) * 2 + 1) * 64)[ln]; }
#pragma unroll
                for (int i4 = 0; i4 < 4; ++i4) { const int ks = ch * 4 + i4;
                    const pg8::f32x4 v0 = xa[2 * i4], v1 = xa[2 * i4 + 1];
                    const pg8::f32x4 a0 = *(const LAS pg8::f32x4*)(A2 + kb + 16 * ks), a1 = *(const LAS pg8::f32x4*)(A2 + kb + 16 * ks + 4);
                    ss += (v0[0] * v0[0] + v0[1] * v0[1]) + (v0[2] * v0[2] + v0[3] * v0[3]) + (v1[0] * v1[0] + v1[1] * v1[1]) + (v1[2] * v1[2] + v1[3] * v1[3]);
                    float av[8] = {v0[0] * a0[0], v0[1] * a0[1], v0[2] * a0[2], v0[3] * a0[3], v1[0] * a1[0], v1[1] * a1[1], v1[2] * a1[2], v1[3] * a1[3]};
#pragma unroll
                    for (int i = 0; i < 8; ++i) { const pg8::f32x4 wc = *(const LAS pg8::f32x4*)(WCL + (kb + 16 * ks + i) * 4);
                        cacc[0] += av[i] * wc[0]; cacc[1] += av[i] * wc[1]; cacc[2] += av[i] * wc[2]; cacc[3] += av[i] * wc[3]; }
                    bfx8 ah, al; split8(av, ah, al);
                    acc = __builtin_amdgcn_mfma_f32_32x32x16_bf16(ah, ba[2 * i4], acc, 0, 0, 0);
                    acc = __builtin_amdgcn_mfma_f32_32x32x16_bf16(al, ba[2 * i4], acc, 0, 0, 0);
                    acc = __builtin_amdgcn_mfma_f32_32x32x16_bf16(ah, ba[2 * i4 + 1], acc, 0, 0, 0); }
            }
            ss += __shfl_xor(ss, 32);
#pragma unroll
            for (int g = 0; g < 4; ++g) cacc[g] += __shfl_xor(cacc[g], 32);
            if (hi == 0) { SSP[r32 * 8 + wave] = ss;
#pragma unroll
                for (int g = 0; g < 4; ++g) CP[(wave * 32 + r32) * 4 + g] = cacc[g]; }
#pragma unroll
            for (int r = 0; r < 16; ++r) FP[(wave * 32 + (r & 3) + 8 * (r >> 2) + 4 * hi) * 32 + r32] = acc[r];
            __syncthreads();
            if (tid < 32) { const int row = r0 + tid;
                float s8 = 0.f;
                for (int w = 0; w < 8; ++w) s8 += SSP[tid * 8 + w];
                const float rstd = rsqrtf(s8 * (1.f / 2048.f) + 1e-6f); RSTD[tid] = rstd;
                float cl[4]; int gs = 0;
#pragma unroll
                for (int g = 0; g < 4; ++g) { float t = 0.f; for (int w = 0; w < 8; ++w) t += CP[(w * 32 + tid) * 4 + g]; cl[g] = rstd * t + CST[g]; }
#pragma unroll
                for (int g = 1; g < 4; ++g) if (cl[g] > cl[gs]) gs = g;
                float cmax = cl[0];
#pragma unroll
                for (int g = 1; g < 4; ++g) cmax = fmaxf(cmax, cl[g]);
                float den = 0.f;
#pragma unroll
                for (int g = 0; g < 4; ++g) den += expf(cl[g] - cmax);
                const float pg = 1.f / den;
                float f0 = -3.0e38f, f1 = -3.0e38f; int e0 = 0, e1 = 0;
                for (int e = 0; e < 8; ++e) { float t = 0.f; for (int w = 0; w < 8; ++w) t += FP[(w * 32 + tid) * 32 + gs * 8 + e];
                    const float fl = rstd * t + CST[4 + gs * 8 + e];
                    if (fl > f0) { f1 = f0; e1 = e0; f0 = fl; e0 = e; } else if (fl > f1) { f1 = fl; e1 = e; } }
                const float t1 = expf(f1 - f0); const float g0 = pg / (1.f + t1), g1 = pg * t1 / (1.f + t1);
                const int E0 = gs * 8 + e0, E1 = gs * 8 + e1;
                r_eid[2 * row] = E0; r_eid[2 * row + 1] = E1; r_gate[2 * row] = g0; r_gate[2 * row + 1] = g1;
                r_idx[2 * row] = atomicAdd(cnt + E0, 1); r_idx[2 * row + 1] = atomicAdd(cnt + E1, 1); }
            __syncthreads();
#pragma unroll
            for (int q = 0; q < 4; ++q) { const int rl = wave * 4 + q; const float rstd = RSTD[rl]; const float* xrow = x1 + (size_t)(r0 + rl) * 2048; bf16_t* hrow = h2 + (size_t)(r0 + rl) * 2048;
#pragma unroll
                for (int j = 0; j < 8; ++j) { const int c = j * 256 + lane * 4; const pg8::f32x4 xv = *(const pg8::f32x4*)(xrow + c);
                    const pg8::f32x4 aa = *(const LAS pg8::f32x4*)(A2 + c), sv = *(const LAS pg8::f32x4*)(S2 + c);
                    uint2 pk; pk.x = pk2(xv[0] * rstd * aa[0] + sv[0], xv[1] * rstd * aa[1] + sv[1]); pk.y = pk2(xv[2] * rstd * aa[2] + sv[2], xv[3] * rstd * aa[3] + sv[3]);
                    *(uint2*)(hrow + c) = pk; }
                asm volatile("" ::: "memory"); }
        }
    }
    __syncthreads();
}
__device__ __forceinline__ void ph6(const Args& a, LAS unsigned char* lds, int G) {
    const int tid = threadIdx.x, lane = tid & 63, wave = __builtin_amdgcn_readfirstlane(tid >> 6);
    unsigned char* ws = a.ws;
    const int* cnt = (const int*)(ws + W::CTL) + CW_CNT; int* pstart_g = (int*)(ws + W::TILE); int* tile_e = pstart_g + 64; int* ntile = pstart_g + 512;
    const int* r_eid = (const int*)(ws + W::ROUTE); const int* r_idx = (const int*)(ws + W::ROUTE + 256 * 1024); int* r_slot = (int*)(ws + W::ROUTE + 384 * 1024);
    LAS int* ps = (LAS int*)(lds + RING_OFF);
    if (tid == 0) { int p = 0, t = 0;
        for (int e = 0; e < 32; ++e) { ps[e] = p; const int n = (cnt[e] + 255) >> 8; if (blockIdx.x == 0) { pstart_g[e] = p; for (int i = 0; i < n; ++i) tile_e[t + i] = e; } t += n; p += n * 256; }
        ps[32] = p; if (blockIdx.x == 0) { pstart_g[32] = p; *ntile = t; } }
    __syncthreads();
    const bf16_t* h2 = (const bf16_t*)(ws + W::H2); bf16_t* xs = (bf16_t*)(ws + W::XS);
    for (int mk = blockIdx.x * NWAVES + wave; mk < 2 * M_TOK; mk += G * NWAVES) {
        const int slot = ps[r_eid[mk]] + r_idx[mk]; if (lane == 0) r_slot[mk] = slot;
        const uint4* src = (const uint4*)(h2 + (size_t)(mk >> 1) * 2048) + lane; uint4* dst = (uint4*)(xs + (size_t)slot * 2048) + lane;
        uint4 v[4];
#pragma unroll
        for (int j = 0; j < 4; ++j) v[j] = src[64 * j];
#pragma unroll
        for (int j = 0; j < 4; ++j) dst[64 * j] = v[j];
    }
    __syncthreads();
}
template <int LOG2_NN> struct GroupedOrder {
    const int* tile_e; int nunits, G, c;
    __device__ void init(const int* tile_e_, const int* ntile, int G_, int c_) { tile_e = tile_e_; nunits = *ntile << LOG2_NN; G = G_; c = c_; }
    __device__ bool next(int i, pg8::Unit& u) const { const int L = i * G + c; if (L >= nunits) return false; u.pm = L >> LOG2_NN; u.pn = L & ((1 << LOG2_NN) - 1); u.e = tile_e[u.pm]; return true; }
    __device__ __forceinline__ void a_ready(const pg8::Unit&) const {}
    __device__ __forceinline__ void done(const pg8::Unit&) const {}
};
struct EpiUp {
    static constexpr bool PERM = true, AFTER_DRAIN = false;
    bf16_t* act;
    __device__ __forceinline__ void operator()(const pg8::f32x4 (&acc)[2][2][4][2], const pg8::Unit& u, int wr, int wc, int fr, int fq) const {
        using pg8::f32x4;
        const int row0 = u.pm * 256 + wr * 64 + fr, col0 = u.pn * 128 + wc * 16 + 4 * fq;
#pragma unroll
        for (int ai = 0; ai < 2; ++ai)
#pragma unroll
            for (int m = 0; m < 4; ++m) { bf16_t* rowp = act + (size_t)(row0 + ai * 128 + m * 16) * 512 + col0;
#pragma unroll
                for (int bj = 0; bj < 2; ++bj) { const f32x4 av = acc[ai][bj][m][0], bv = acc[ai][bj][m][1]; float o[4];
#pragma unroll
                    for (int e = 0; e < 4; ++e) o[e] = av[e] * __builtin_amdgcn_rcpf(1.f + __expf(-av[e])) * bv[e];
                    uint2 w; w.x = pg8::cvt_pk_bf16(o[0], o[1]); w.y = pg8::cvt_pk_bf16(o[2], o[3]);
                    *(uint2*)(rowp + bj * 64) = w; } }
    }
};
__device__ __forceinline__ void ph9(const Args& a, int G) {
    const int tid = threadIdx.x, lane = tid & 63, wave = __builtin_amdgcn_readfirstlane(tid >> 6);
    unsigned char* ws = a.ws; float* out = a.out;
    const float* mod = (const float*)(ws + W::MOD); const bf16_t* y = (const bf16_t*)(ws + W::Y);
    const float* r_gate = (const float*)(ws + W::ROUTE + 128 * 1024); const int* r_slot = (const int*)(ws + W::ROUTE + 384 * 1024);
    for (int m = blockIdx.x * NWAVES + wave; m < M_TOK; m += G * NWAVES) {
        const int s0 = r_slot[2 * m], s1 = r_slot[2 * m + 1]; const float g0 = r_gate[2 * m], g1 = r_gate[2 * m + 1];
        const float* g2 = mod + (m >> 13) * 12288 + 10240;
#pragma unroll
        for (int j = 0; j < 8; ++j) { const int c = j * 256 + lane * 4;
            const uint2 ya = *(const uint2*)(y + (size_t)s0 * 2048 + c), yb = *(const uint2*)(y + (size_t)s1 * 2048 + c);
            const pg8::f32x4 xv = *(const pg8::f32x4*)(out + (size_t)m * 2048 + c), gg = *(const pg8::f32x4*)(g2 + c);
            pg8::f32x4 o;
            o[0] = xv[0] + gg[0] * (g0 * __uint_as_float(ya.x << 16) + g1 * __uint_as_float(yb.x << 16));
            o[1] = xv[1] + gg[1] * (g0 * __uint_as_float(ya.x & 0xffff0000u) + g1 * __uint_as_float(yb.x & 0xffff0000u));
            o[2] = xv[2] + gg[2] * (g0 * __uint_as_float(ya.y << 16) + g1 * __uint_as_float(yb.y << 16));
            o[3] = xv[3] + gg[3] * (g0 * __uint_as_float(ya.y & 0xffff0000u) + g1 * __uint_as_float(yb.y & 0xffff0000u));
            *(pg8::f32x4*)(out + (size_t)m * 2048 + c) = o; }
    }
}

__global__ void __launch_bounds__(NWAVES * 64, 2) mk_fwd(Args args) {
    extern __shared__ __attribute__((aligned(16))) unsigned char lds_raw[];
    LAS unsigned char* lds = (LAS unsigned char*)lds_raw;
    volatile LAS unsigned* MISC = (volatile LAS unsigned*)(lds + MISC_OFF);
    const int tid = threadIdx.x, G = gridDim.x;
    unsigned char* ws = args.ws; gu32* ctl = (gu32*)(ws + W::CTL);
    for (int u = tid; u < (LDS_BYTES - MISC_OFF) / 4; u += NWAVES * 64) ((LAS unsigned*)(lds + MISC_OFF))[u] = 0u;
    __syncthreads();
    const int lo = args.ph_lo, hi = args.ph_hi;
    XcdBarrier bar; bar.bar = (unsigned*)(ctl + CW_BAR) + args.li * XCD_BAR_WORDS; bar.x = 0; bar.st = nullptr;
    if (hi - lo > 1) bar = xcd_barrier_post((unsigned*)(ctl + CW_BAR) + args.li * XCD_BAR_WORDS, MISC + 8);
#define IN(k) (lo <= (k) && (k) < hi)
#define BOTH(k) (IN(k) && IN((k) + 1))
    if (IN(0)) { ph0(args, lds, G); if (BOTH(0)) xcd_barrier(bar); }
    if (IN(1)) { ph1(args, lds, G); if (BOTH(1)) xcd_barrier(bar); }
    if (IN(2)) {
        for (int bh = blockIdx.x; bh < 16; bh += G) cumsum_bh(args, lds, bh);
        pg8::Gemm g{(const bf16_t*)(ws + W::XN), (const bf16_t*)(ws + W::WT_IN), M_TOK, 7168, 2048, 0};
        pg8::StaticOrder S; S.init(M_TOK, 7168, G, (int)blockIdx.x);
        EpiZ E{(bf16_t*)(ws + W::QKV), args.in[7], args.in[8], (const float*)(ws + W::ROPE), (PG8_LAS float*)(lds + XCH_OFF)};
        pg8::gemm_phase<EpiZ, pg8::StaticOrder, true, true>(lds + RING_OFF, g, S, E);
        if (BOTH(2)) xcd_barrier(bar);
    }
    if (IN(3)) { kv_units(args, (char*)lds_raw + RING_OFF, G); attn_stream<0>(args, (char*)lds_raw + RING_OFF, G); if (BOTH(3)) xcd_barrier(bar); }
    if (IN(4)) { scan_units(args, lds, G); if (BOTH(4)) xcd_barrier(bar); }
    if (IN(5)) { attn_stream<1>(args, (char*)lds_raw + RING_OFF, G); if (BOTH(5)) xcd_barrier(bar); }
    if (IN(6)) {
        pg8::Gemm g{(const bf16_t*)(ws + W::MIX), (const bf16_t*)(ws + W::WT_OUT), M_TOK, 2048, 2048, 0};
        pg8::StaticOrder S; S.init(M_TOK, 2048, G, (int)blockIdx.x);
        EpiX1 E{args.in[0], (const float*)(ws + W::MOD), args.out};
        pg8::gemm_phase<EpiX1, pg8::StaticOrder, true, true>(lds + RING_OFF, g, S, E);
        if (BOTH(6)) xcd_barrier(bar);
    }
    if (IN(7)) { ph5(args, lds, G); if (BOTH(7)) xcd_barrier(bar); }
    if (IN(8)) { ph6(args, lds, G); if (BOTH(8)) xcd_barrier(bar); }
    if (IN(9)) {
        pg8::Gemm g{(const bf16_t*)(ws + W::XS), (const bf16_t*)(ws + W::WT_13), 0, 1024, 2048, (size_t)1024 * 2048 * 2};
        GroupedOrder<2> S; S.init((const int*)(ws + W::TILE) + 64, (const int*)(ws + W::TILE) + 512, G, (int)blockIdx.x);
        EpiUp E{(bf16_t*)(ws + W::ACT)};
        pg8::gemm_phase<EpiUp, GroupedOrder<2>, true, true>(lds + RING_OFF, g, S, E);
        if (BOTH(9)) xcd_barrier(bar);
    }
    if (IN(10)) {
        pg8::Gemm g{(const bf16_t*)(ws + W::ACT), (const bf16_t*)(ws + W::WT_2), 0, 2048, 512, (size_t)2048 * 512 * 2};
        GroupedOrder<3> S; S.init((const int*)(ws + W::TILE) + 64, (const int*)(ws + W::TILE) + 512, G, (int)blockIdx.x);
        pg8::EpiBf16<0> E{(bf16_t*)(ws + W::Y), 2048, nullptr, 0, 0, 1.f};
        pg8::gemm_phase<pg8::EpiBf16<0>, GroupedOrder<3>, true, true>(lds + RING_OFF, g, S, E);
        if (BOTH(10)) xcd_barrier(bar);
    }
    if (IN(11)) ph9(args, G);
#undef IN
#undef BOTH
}
extern "C" void kernel_launch(void* const* d_in, const int* in_sizes, int n_in, void* d_out, int out_size, void* d_ws, size_t ws_size, hipStream_t stream) {
    static int grid = 0;
    if (grid == 0) {
        if (n_in != 19 || out_size != M_TOK * DM || ws_size < W::END) { fprintf(stderr, "kernel_launch: built for 19 inputs, %d outputs, >= %zu bytes of workspace; got %d, %d, %zu\n", M_TOK * DM, (size_t)W::END, n_in, out_size, ws_size); grid = -1; return; }
        int dev = 0, cus = 0, per_cu = 0;
        if (hipGetDevice(&dev) != hipSuccess || hipDeviceGetAttribute(&cus, hipDeviceAttributeMultiprocessorCount, dev) != hipSuccess) { fprintf(stderr, "kernel_launch: device query failed\n"); grid = -1; return; }
        if (hipFuncSetAttribute((const void*)mk_fwd, hipFuncAttributeMaxDynamicSharedMemorySize, LDS_BYTES) != hipSuccess) { fprintf(stderr, "kernel_launch: hipFuncSetAttribute failed\n"); grid = -1; return; }
        if (hipOccupancyMaxActiveBlocksPerMultiprocessor(&per_cu, (const void*)mk_fwd, NWAVES * 64, LDS_BYTES) != hipSuccess || per_cu < 1) { fprintf(stderr, "kernel_launch: occupancy query says %d workgroups per CU\n", per_cu); (void)hipGetLastError(); grid = -1; return; }
        grid = cus;
    }
    if (grid < 0) return;
    (void)hipMemsetAsync((char*)d_ws + W::CTL, 0, W::CTL_ZERO_BYTES, stream);
    Args a{};
    for (int i = 0; i < 19; ++i) a.in[i] = (const float*)d_in[i];
    a.out = (float*)d_out; a.ws = (unsigned char*)d_ws; a.ph_lo = 0; a.ph_hi = 12; a.li = 0;
    hipLaunchKernelGGL(mk_fwd, dim3(grid), dim3(NWAVES * 64), LDS_BYTES, stream, a);
}
```

```cpp
#include <hip/hip_runtime.h>
#include <cstdio>
#include <cstdint>
typedef unsigned short bf16_t;
__device__ __forceinline__ float bf2f(bf16_t v) { return __uint_as_float(((unsigned)v) << 16); }
__device__ __forceinline__ unsigned f2bf(float f) { const unsigned u = __float_as_uint(f); return (u + 0x7fffu + ((u >> 16) & 1u)) >> 16; }

constexpr size_t MiB = 1u << 20;
constexpr int M_TOK = 16384, SEQ = 8192, DM = 2048;
constexpr size_t QKV_ELEMS = (size_t)16 * 8192 * 128;
namespace pg8 {
#define PG8_LAS __attribute__((address_space(3)))
typedef short bf16x8 __attribute__((ext_vector_type(8)));
typedef float f32x4 __attribute__((ext_vector_type(4)));
typedef unsigned u32x4 __attribute__((ext_vector_type(4)));
constexpr int BM = 256, BK = 64, HALF = 128, HTB = HALF * BK * 2  , STAGE_BYTES = 8 * HTB, NXCD = 8, WGM = 8;

__host__ __device__ __forceinline__ int lds_byte(int r, int c) { const int st = (r >> 4) * 2 + (c >> 5), rr = r & 15, cc = c & 31, ob = rr * 64 + cc * 2; return st * 1024 + (ob ^ (((ob >> 9) & 1) << 5)); }
__host__ __device__ __forceinline__ void stage_rc(int b, int& R, int& C) { const int st = b / 1024, sb = b % 1024, swz = sb ^ (((sb >> 9) & 1) << 5); R = (st >> 1) * 16 + swz / 64; C = (st & 1) * 32 + (swz % 64) / 2; }
__host__ __device__ __forceinline__ int perm32(int rho) { const int n = rho >> 4, i = rho & 15; return 8 * (i >> 2) + 4 * n + (i & 3); }

struct Unit { int pm, pn, e; };
struct Gemm { const bf16_t* A; const bf16_t* Bt; int M, N, K; size_t estride; };

struct StaticOrder {
    int nM, nN, nwg, G, c;
    __host__ __device__ void init(int M, int N, int G_, int c_) { nM = M / BM; nN = N / BM; nwg = nM * nN; G = G_; c = c_; }
    __host__ __device__ bool next(int i, Unit& u) const {
        const long L = (long)i * G + c; if (L >= nwg) return false;
        int wgid = (int)L; { const int q = nwg / NXCD, r = nwg % NXCD, xcd = wgid % NXCD, off = wgid / NXCD; wgid = (xcd < r ? xcd * (q + 1) : r * (q + 1) + (xcd - r) * q) + off; }
        const int nig = WGM * nN, gid = wgid / nig, fm = gid * WGM, gsz = (nM - fm) < WGM ? (nM - fm) : WGM;
        u.pm = fm + ((wgid % nig) % gsz); u.pn = (wgid % nig) / gsz; u.e = 0; return true;
    }
    __device__ __forceinline__ void a_ready(const Unit&) const {}
    __device__ __forceinline__ void done(const Unit&) const {}
};

__device__ __forceinline__ unsigned cvt_pk_bf16(float lo, float hi) { unsigned r; asm volatile("v_cvt_pk_bf16_f32 %0, %1, %2" : "=v"(r) : "v"(lo), "v"(hi)); return r; }
typedef float f32x2 __attribute__((ext_vector_type(2)));
__device__ __forceinline__ f32x2 gelu_pk(f32x2 v) {
    const f32x2 av = __builtin_elementwise_abs(v), d = av * 0.2316418882f + 1.0f;
    f32x2 t; t.x = __builtin_amdgcn_rcpf(d.x); t.y = __builtin_amdgcn_rcpf(d.y);
    f32x2 q = t * 0.5307027145f + (-0.7265760135f); q = q * t + 0.7107068705f; q = q * t + (-0.142248368f); q = q * t + 0.127414796f; q = q * t;
    const f32x2 s = (v * v) * (-0.72134752044f);
    f32x2 e; e.x = __builtin_amdgcn_exp2f(s.x); e.y = __builtin_amdgcn_exp2f(s.y);
    const f32x2 m = v * (q * e), r = v - m;
    f32x2 o; o.x = v.x < 0.f ? m.x : r.x; o.y = v.y < 0.f ? m.y : r.y; return o;
}

template <int ACT  > struct EpiBf16 {
    static constexpr bool PERM = true, AFTER_DRAIN = false; static_assert(ACT == 0 || ACT == 1, "EpiBf16: ACT is 0 (none) or 1 (gelu_pk)");
    bf16_t* O; int ldc; const float* bias; int split_cols; size_t split_stride; float scale0;
    __device__ __forceinline__ void operator()(const f32x4 (&acc)[2][2][4][2], const Unit& u, int wr, int wc, int fr, int fq) const {
        const int row0 = u.pm * BM + wr * 64 + fr; int colt = u.pn * BM; bf16_t* base = O;
        float sc = 1.f; if (split_cols) { const int t = colt / split_cols; base += (size_t)t * split_stride; colt -= t * split_cols; if (t == 0) sc = scale0; }
        const int col0 = colt + wc * 32 + 8 * fq, bcol0 = u.pn * BM + wc * 32 + 8 * fq;
        f32x4 bv[2][2];
#pragma unroll
        for (int bj = 0; bj < 2; ++bj)
#pragma unroll
            for (int n = 0; n < 2; ++n) bv[bj][n] = bias ? *(const f32x4*)(bias + bcol0 + bj * HALF + 4 * n) : (f32x4){0.f, 0.f, 0.f, 0.f};
#pragma unroll
        for (int ai = 0; ai < 2; ++ai)
#pragma unroll
            for (int m = 0; m < 4; ++m) { bf16_t* rowp = base + (size_t)(row0 + ai * HALF + m * 16) * ldc + col0;
#pragma unroll
                for (int bj = 0; bj < 2; ++bj) { f32x4 v0 = acc[ai][bj][m][0] + bv[bj][0], v1 = acc[ai][bj][m][1] + bv[bj][1];
                    if (ACT == 1) { f32x2 a = gelu_pk((f32x2){v0[0], v0[1]}), b = gelu_pk((f32x2){v0[2], v0[3]}), c = gelu_pk((f32x2){v1[0], v1[1]}), d = gelu_pk((f32x2){v1[2], v1[3]});
                        v0 = (f32x4){a.x, a.y, b.x, b.y}; v1 = (f32x4){c.x, c.y, d.x, d.y}; }
                    v0 = v0 * sc; v1 = v1 * sc; u32x4 w; w.x = cvt_pk_bf16(v0[0], v0[1]); w.y = cvt_pk_bf16(v0[2], v0[3]); w.z = cvt_pk_bf16(v1[0], v1[1]); w.w = cvt_pk_bf16(v1[2], v1[3]);
                    *(u32x4*)(rowp + bj * HALF) = w; } }
    }
};
template <class Epi, class Sched, bool ALIGN_EPI = false, bool SP2 = false>
__device__ __forceinline__ void gemm_phase(PG8_LAS unsigned char* lds, const Gemm g, const Sched& S, const Epi& E) {
    const int tid = threadIdx.x, wid = __builtin_amdgcn_readfirstlane(tid >> 6), lane = tid & 63, wr = wid >> 2, wc = wid & 3, fr = lane & 15, fq = lane >> 4;
    const int K = g.K, nt = K / BK;
    unsigned voffA[2], voffB[2];
#pragma unroll
    for (int i = 0; i < 2; ++i) { int R, C; stage_rc(tid * 16 + i * 8192, R, C); const int Rb = Epi::PERM ? ((R & ~31) + perm32(R & 31)) : R;
        voffA[i] = (unsigned)(R * K + C) * 2u; voffB[i] = (unsigned)(Rb * K + C) * 2u; }
    const size_t kstep = (size_t)(BK * 2);
    const size_t hstep = (size_t)HALF * K * 2;
    const size_t tstep = 2 * hstep;
    const unsigned ldsw = (unsigned)wid * 1024u;
    const int aoff = lds_byte(wr * 64 + fr, fq * 8), boff = lds_byte(wc * 32 + fr, fq * 8);
#define PG8_SA(b, h) (((b) * 2 + (h)) * HTB)
#define PG8_SB(b, h) ((4 + (b) * 2 + (h)) * HTB)
#define PG8_STAGE(bufoff, gbase, voff) do { _Pragma("unroll") for (int _i = 0; _i < 2; ++_i) \
        __builtin_amdgcn_global_load_lds((const unsigned*)((const char*)(gbase) + (voff)[_i]), (PG8_LAS unsigned*)(lds + (bufoff) + ldsw + _i * 8192), 16, 0, 0); } while (0)
#define PG8_LDA(dst, b, h) do { _Pragma("unroll") for (int m = 0; m < 4; ++m) _Pragma("unroll") for (int k = 0; k < 2; ++k) dst[m][k] = *(const PG8_LAS bf16x8*)(lds + PG8_SA(b, h) + aoff + m * 2048 + k * 1024); } while (0)
#define PG8_LDB(dst, b, h) do { _Pragma("unroll") for (int n = 0; n < 2; ++n) _Pragma("unroll") for (int k = 0; k < 2; ++k) dst[n][k] = *(const PG8_LAS bf16x8*)(lds + PG8_SB(b, h) + boff + n * 2048 + k * 1024); } while (0)
#define PG8_MMA(ai, bj, At, Bt) do { __builtin_amdgcn_s_setprio(1); _Pragma("unroll") for (int m = 0; m < 4; ++m) _Pragma("unroll") for (int n = 0; n < 2; ++n) _Pragma("unroll") for (int k = 0; k < 2; ++k) \
        acc[ai][bj][m][n] = __builtin_amdgcn_mfma_f32_16x16x32_bf16(Bt[n][k], At[m][k], acc[ai][bj][m][n], 0, 0, 0); __builtin_amdgcn_s_setprio(0); } while (0)
#define PG8_WAIT_V(n) asm volatile("s_waitcnt vmcnt(" #n ")" ::: "memory")
#define PG8_WAIT_L(n) asm volatile("s_waitcnt lgkmcnt(" #n ")" ::: "memory")
#define PG8_BAR __builtin_amdgcn_s_barrier()
#define PG8_SCHED __builtin_amdgcn_sched_barrier(0)
    Unit cur, nxt; int ui = 0;
    if (!S.next(0, cur)) return;
    f32x4 acc[2][2][4][2];
#pragma unroll
    for (int a = 0; a < 2; ++a)
#pragma unroll
        for (int b = 0; b < 2; ++b)
#pragma unroll
            for (int m = 0; m < 4; ++m)
#pragma unroll
                for (int n = 0; n < 2; ++n) acc[a][b][m][n] = (f32x4){0.f, 0.f, 0.f, 0.f};
    bf16x8 At[4][2], B0[2][2], B1[2][2];
    const char* cA = (const char*)g.A + (size_t)cur.pm * tstep; const char* cB = (const char*)g.Bt + (size_t)cur.pn * tstep + (size_t)cur.e * g.estride;
    S.a_ready(cur);
    if constexpr (SP2) {
        PG8_STAGE(PG8_SB(0, 0), cB, voffB); PG8_STAGE(PG8_SB(0, 1), cB + hstep, voffB); PG8_STAGE(PG8_SA(0, 0), cA, voffA); PG8_STAGE(PG8_SA(0, 1), cA + hstep, voffA);
        if (wr == 1) PG8_BAR;
        PG8_WAIT_V(2); PG8_BAR;
        PG8_STAGE(PG8_SB(1, 0), cB + kstep, voffB); PG8_STAGE(PG8_SA(1, 0), cA + kstep, voffA); PG8_STAGE(PG8_SB(1, 1), cB + hstep + kstep, voffB);
        PG8_WAIT_V(6); PG8_BAR;
    } else {
        PG8_STAGE(PG8_SB(0, 0), cB, voffB); PG8_STAGE(PG8_SA(0, 0), cA, voffA); PG8_STAGE(PG8_SB(0, 1), cB + hstep, voffB); PG8_STAGE(PG8_SA(0, 1), cA + hstep, voffA);
        if (wr == 1) PG8_BAR;
        PG8_WAIT_V(4); PG8_BAR;
        PG8_STAGE(PG8_SB(1, 0), cB + kstep, voffB); PG8_STAGE(PG8_SA(1, 0), cA + kstep, voffA); PG8_STAGE(PG8_SB(1, 1), cB + hstep + kstep, voffB);
        PG8_WAIT_V(6); PG8_BAR;
    }
    for (;;) {
        const bool has_next = S.next(ui + 1, nxt);
        const char* nA = has_next ? (const char*)g.A + (size_t)nxt.pm * tstep : cA; const char* nB = has_next ? (const char*)g.Bt + (size_t)nxt.pn * tstep + (size_t)nxt.e * g.estride : cB;
        for (int t = 0; t < nt; t += 2) {
            const bool last = (t == nt - 2);
            const char* a1 = cA + (size_t)(t + 1) * kstep;
            const char* a2 = last ? nA : cA + (size_t)(t + 2) * kstep; const char* b2 = last ? nB : cB + (size_t)(t + 2) * kstep;
            const char* a3 = a2 + kstep; const char* b3 = b2 + kstep;
            if (last && has_next) S.a_ready(nxt);
            if constexpr (SP2) {
            PG8_LDB(B0, 0, 0); PG8_LDB(B1, 0, 1); PG8_SCHED; PG8_LDA(At, 0, 0); PG8_STAGE(PG8_SA(1, 1), a1 + hstep, voffA);
            PG8_WAIT_V(8); PG8_WAIT_L(0); PG8_BAR; PG8_MMA(0, 0, At, B0); PG8_MMA(0, 1, At, B1); PG8_BAR; PG8_SCHED;
            PG8_LDA(At, 0, 1); PG8_STAGE(PG8_SB(0, 0), b2, voffB); PG8_STAGE(PG8_SB(0, 1), b2 + hstep, voffB); PG8_STAGE(PG8_SA(0, 0), a2, voffA);
            PG8_WAIT_V(8); PG8_WAIT_L(0); PG8_BAR; PG8_MMA(1, 0, At, B0); PG8_MMA(1, 1, At, B1); PG8_BAR; PG8_SCHED;
            PG8_LDB(B0, 1, 0); PG8_LDB(B1, 1, 1); PG8_SCHED; PG8_LDA(At, 1, 0); PG8_STAGE(PG8_SA(0, 1), a2 + hstep, voffA);
            PG8_WAIT_V(8); PG8_WAIT_L(0); PG8_BAR; PG8_MMA(0, 0, At, B0); PG8_MMA(0, 1, At, B1); PG8_BAR; PG8_SCHED;
            PG8_LDA(At, 1, 1); PG8_STAGE(PG8_SB(1, 0), b3, voffB); PG8_STAGE(PG8_SB(1, 1), b3 + hstep, voffB); PG8_STAGE(PG8_SA(1, 0), a3, voffA);
            PG8_WAIT_V(8); PG8_WAIT_L(0); PG8_BAR; PG8_MMA(1, 0, At, B0); PG8_MMA(1, 1, At, B1); PG8_BAR; PG8_SCHED;
            } else {
            PG8_LDB(B0, 0, 0); PG8_SCHED; PG8_LDA(At, 0, 0); PG8_STAGE(PG8_SA(1, 1), a1 + hstep, voffA);
            PG8_WAIT_L(8); PG8_BAR; PG8_WAIT_L(0); PG8_MMA(0, 0, At, B0); PG8_BAR; PG8_SCHED;
            PG8_LDB(B1, 0, 1); PG8_STAGE(PG8_SB(0, 0), b2, voffB);
            PG8_BAR; PG8_WAIT_L(0); PG8_MMA(0, 1, At, B1); PG8_BAR;
            PG8_LDA(At, 0, 1); PG8_STAGE(PG8_SA(0, 0), a2, voffA);
            PG8_BAR; PG8_WAIT_L(0); PG8_MMA(1, 0, At, B0); PG8_BAR; PG8_SCHED;
            PG8_STAGE(PG8_SB(0, 1), b2 + hstep, voffB);
            PG8_WAIT_V(6); PG8_BAR; PG8_MMA(1, 1, At, B1); PG8_BAR;
            PG8_LDB(B0, 1, 0); PG8_SCHED; PG8_LDA(At, 1, 0); PG8_STAGE(PG8_SA(0, 1), a2 + hstep, voffA);
            PG8_WAIT_L(8); PG8_BAR; PG8_WAIT_L(0); PG8_MMA(0, 0, At, B0); PG8_BAR; PG8_SCHED;
            PG8_LDB(B1, 1, 1); PG8_STAGE(PG8_SB(1, 0), b3, voffB);
            PG8_BAR; PG8_WAIT_L(0); PG8_MMA(0, 1, At, B1); PG8_BAR;
            PG8_LDA(At, 1, 1); PG8_STAGE(PG8_SA(1, 0), a3, voffA);
            PG8_BAR; PG8_WAIT_L(0); PG8_MMA(1, 0, At, B0); PG8_BAR; PG8_SCHED;
            PG8_STAGE(PG8_SB(1, 1), b3 + hstep, voffB);
            PG8_WAIT_V(6); PG8_BAR; PG8_MMA(1, 1, At, B1); PG8_BAR;
            }
        }
        if constexpr (ALIGN_EPI) { if (wr == 0) PG8_BAR; }
        if constexpr (!Epi::AFTER_DRAIN) { E(acc, cur, wr, wc, fr, fq); S.done(cur); }
        if (!has_next) break;
#pragma unroll
        for (int a = 0; a < 2; ++a)
#pragma unroll
            for (int b = 0; b < 2; ++b)
#pragma unroll
                for (int m = 0; m < 4; ++m)
#pragma unroll
                    for (int n = 0; n < 2; ++n) acc[a][b][m][n] = (f32x4){0.f, 0.f, 0.f, 0.f};
        cur = nxt; cA = nA; cB = nB; ++ui;
        if constexpr (ALIGN_EPI) { if (wr == 1) PG8_BAR; }
    }
    PG8_WAIT_V(0);
    if constexpr (!ALIGN_EPI) { if (wr == 0) PG8_BAR; }
    PG8_BAR;
    if constexpr (Epi::AFTER_DRAIN) { E.fused(acc, cur, wr, wc, fr, fq, lds, wid, lane); S.done(cur); }
#undef PG8_SA
#undef PG8_SB
#undef PG8_STAGE
#undef PG8_LDA
#undef PG8_LDB
#undef PG8_MMA
#undef PG8_WAIT_V
#undef PG8_WAIT_L
#undef PG8_BAR
#undef PG8_SCHED
}
}
#define GAS __attribute__((address_space(1)))
#define LAS __attribute__((address_space(3)))
typedef GAS unsigned gu32;
typedef GAS unsigned long long gu64;
#define RLX_AGENT __ATOMIC_RELAXED, __HIP_MEMORY_SCOPE_AGENT
#define LDS_WAIT() asm volatile("s_waitcnt lgkmcnt(0)" ::: "memory")
#define VM_WAIT() asm volatile("s_waitcnt vmcnt(0)" ::: "memory")
#define XB_TMO      128
#define XB_XCNT(j)  (256  + 64 * (j))
#define XB_XSUB(j)  (1280 + 64 * (j))
#define XB_XGEN(j)  (2304 + 64 * (j))
#define XB_TOP      3328
#define XB_TOPGEN   3392
#define XCD_BAR_WORDS 3456
#define XB_SPIN_CAP (1u << 18)

__device__ __forceinline__ unsigned xb_ld(unsigned* p)              { return __hip_atomic_load(p, __ATOMIC_RELAXED, __HIP_MEMORY_SCOPE_AGENT); }
__device__ __forceinline__ unsigned xb_add(unsigned* p, unsigned v) { return __hip_atomic_fetch_add(p, v, __ATOMIC_RELAXED, __HIP_MEMORY_SCOPE_AGENT); }
__device__ __forceinline__ unsigned xb_xcc_id() { return (unsigned)__builtin_amdgcn_s_getreg((3 << 11) | 20) & 0xFu; }
#define XB_SPIN(cond, bar) do { unsigned _sp = 0; while (cond) { __builtin_amdgcn_s_sleep(1); \
    if ((++_sp & 255u) == 0u) { if (xb_ld(&(bar)[XB_TMO])) break; if (_sp > XB_SPIN_CAP) { atomicAdd(&(bar)[XB_TMO], 1u); break; } } } } while (0)

struct XcdBarrier {
    unsigned* bar; unsigned x;
    volatile LAS unsigned* st;
};

__device__ __forceinline__ XcdBarrier xcd_barrier_post(unsigned* bar, volatile LAS unsigned* st) {
    XcdBarrier b; b.bar = bar; b.x = xb_xcc_id(); b.st = st;
    if (threadIdx.x == 0) (void)xb_add(&bar[XB_XCNT(b.x)], 1u);
    return b;
}
__device__ __forceinline__ void xcd_barrier_complete(unsigned* bar, unsigned x, unsigned& nloc, unsigned& nx) {
    const unsigned G = gridDim.x * gridDim.y * gridDim.z;
    unsigned sum, cnt, mine, sp = 0u;
    for (;;) {
        sum = 0u; cnt = 0u; mine = 0u;
#pragma unroll
        for (unsigned j = 0; j < 16; ++j) { const unsigned c = xb_ld(&bar[XB_XCNT(j)]); sum += c; cnt += (c > 0u) ? 1u : 0u; mine = (j == x) ? c : mine; }
        if (sum == G) break;
        __builtin_amdgcn_s_sleep(1);
        if ((++sp & 255u) == 0u) { if (xb_ld(&bar[XB_TMO])) break; if (sp > XB_SPIN_CAP) { atomicAdd(&bar[XB_TMO], 1u); break; } }
    }
    nloc = mine > 0u ? mine : 1u; nx = cnt > 0u ? cnt : 1u;
}

__device__ __forceinline__ void xcd_barrier(const XcdBarrier& b) {
    asm volatile("s_waitcnt vmcnt(0)" ::: "memory");
    __syncthreads();
    if (threadIdx.x == 0) {
        unsigned* bar = b.bar;
        __builtin_amdgcn_s_waitcnt(0);
        unsigned nloc = b.st[0], nx = b.st[1];
        if (nloc == 0u) { xcd_barrier_complete(bar, b.x, nloc, nx); b.st[0] = nloc; b.st[1] = nx; }
        const unsigned old = xb_add(&bar[XB_XSUB(b.x)], 1u);
        const unsigned gen = old / nloc;
        if (old + 1u == (gen + 1u) * nloc) {
            __builtin_amdgcn_fence(__ATOMIC_RELEASE, "agent");
            asm volatile("s_waitcnt vmcnt(0)" ::: "memory");
            const unsigned og = xb_add(&bar[XB_TOP], 1u);
            const unsigned tg = og / nx;
            if (og + 1u == (tg + 1u) * nx) xb_add(&bar[XB_TOPGEN], 1u);
            else XB_SPIN(xb_ld(&bar[XB_TOPGEN]) == tg, bar);
            __builtin_amdgcn_fence(__ATOMIC_ACQUIRE, "agent");
            xb_add(&bar[XB_XGEN(b.x)], 1u);
            asm volatile("s_waitcnt vmcnt(0)" ::: "memory");
        } else {
            XB_SPIN(xb_ld(&bar[XB_XGEN(b.x)]) == gen, bar);
            __builtin_amdgcn_fence(__ATOMIC_ACQUIRE, "agent");
            asm volatile("s_waitcnt vmcnt(0)" ::: "memory");
        }
    }
    __syncthreads();
}
namespace at {
constexpr int D = 128; constexpr float THR = 8.f; constexpr bool WSKIP = false; constexpr int WBIG = 1 << 30;
constexpr float SCALE = 0.08838834764831845f;
constexpr int NW = 8, QBLK = 32, KVBLK = 64, QB = NW * QBLK;
constexpr int SHM_V = KVBLK * D * 2, SHM_K = KVBLK * D * 2;
constexpr int LDS_BODY = 2 * SHM_V + 2 * SHM_K + NW * 64 * 4;
constexpr int LDS_BIAS = LDS_BODY, LDS_BYTES = LDS_BODY + 8192 * 4;
using bf16 = unsigned short;
typedef short bf16x8 __attribute__((ext_vector_type(8)));
typedef short s16x4 __attribute__((ext_vector_type(4)));
typedef float f32x16 __attribute__((ext_vector_type(16)));
typedef float f32x4 __attribute__((ext_vector_type(4)));
typedef unsigned u32x4 __attribute__((ext_vector_type(4)));
template <class A, class Bt> struct same_t { static constexpr bool v = false; };
template <class A> struct same_t<A, A> { static constexpr bool v = true; };

#define KSWZ(row, colB) ((row) * 256 + ((colB) ^ (((row) & 7) << 4)))
#define SBAR() __builtin_amdgcn_sched_barrier(0)
__device__ __forceinline__ int v_st(int k, int c) { const int kk = (k & ~0xC) | ((k & 4) << 1) | ((k & 8) >> 1); return ((kk >> 3) * 4 + (c >> 5)) * 512 + ((kk & 7) * 32 + (c & 31)) * 2; }
__device__ __forceinline__ int v_rd_base(int lane) { return ((lane & 3) << 3) | (((lane >> 2) & 3) << 6) | (((lane >> 4) & 1) << 5) | (((lane >> 5) & 1) << 8); }
constexpr int v_rd_off(int d0, int ks, int half) { return d0 * 512 + ks * 4096 + half * 2048; }
__device__ __forceinline__ int crow(int r, int hi) { return (r & 3) + 8 * (r >> 2) + 4 * hi; }
__device__ __forceinline__ unsigned cvtpk(float lo, float hi) {
    unsigned r; asm volatile("v_cvt_pk_bf16_f32 %0, %1, %2" : "=v"(r) : "v"(lo), "v"(hi)); return r;
}
__device__ __forceinline__ bf16x8 pack8(f32x4 a, f32x4 b) {
    u32x4 w = {cvtpk(a[0], a[1]), cvtpk(a[2], a[3]), cvtpk(b[0], b[1]), cvtpk(b[2], b[3])};
    return *reinterpret_cast<bf16x8*>(&w);
}
template <class T> __device__ __forceinline__ bf16x8 load8(const T* p) {
    if constexpr (same_t<T, float>::v) { return pack8(*(const f32x4*)p, *(const f32x4*)(p + 4)); }
    else { return *reinterpret_cast<const bf16x8*>(p); }
}
template <int MODE> __device__ __forceinline__ void mask_tile(f32x16& p0, f32x16& p1, int dq, unsigned W) {
    const float NEG = MODE ? 0.f : -__builtin_inff();
#pragma unroll
    for (int r = 0; r < 16; ++r) {
        const int c = (r & 3) + 8 * (r >> 2);
        if ((unsigned)(dq - c) >= W) p0[r] = NEG;
        if ((unsigned)(dq - c - 32) >= W) p1[r] = NEG;
    }
}
__device__ __forceinline__ void partialRet(f32x16& p0, float rowfac) { for (int r = 0; r < 16; ++r) p0[r] *= rowfac; }
__device__ __forceinline__ void partialSM(f32x16& p0, f32x16& p1, float& m_reg, float& mn, float& alpha) {
    float pmax = p0[0]; for (int r = 1; r < 16; ++r) pmax = fmaxf(pmax, p0[r]); for (int r = 0; r < 16; ++r) pmax = fmaxf(pmax, p1[r]);
    { auto rr = __builtin_amdgcn_permlane32_swap(__float_as_uint(pmax), __float_as_uint(pmax), false, false);
      pmax = fmaxf(__uint_as_float(rr[0]), __uint_as_float(rr[1])); }
    constexpr float C2 = 1.4426950408889634f * SCALE;
    if (__builtin_expect(__all((pmax - m_reg) * SCALE <= THR), 1)) { mn = m_reg; alpha = 1.f; }
    else { mn = fmaxf(m_reg, pmax); alpha = __builtin_amdgcn_exp2f((m_reg - mn) * C2); m_reg = mn; }
    const float mnL = -mn * C2;
    for (int r = 0; r < 16; ++r) p0[r] = fmaf(p0[r], C2, mnL); for (int r = 0; r < 16; ++r) p1[r] = fmaf(p1[r], C2, mnL);
    for (int r = 0; r < 16; ++r) p0[r] = __builtin_amdgcn_exp2f(p0[r]);
}
template <int MODE> __device__ __forceinline__ void finishSM(f32x16& p0, f32x16& p1, float alpha, float& l_reg, bf16x8& pa0, bf16x8& pa1, bf16x8& pa2, bf16x8& pa3) {
    if constexpr (MODE == 0) {
    for (int r = 0; r < 16; ++r) p1[r] = __builtin_amdgcn_exp2f(p1[r]);
    float ps = 0; for (int r = 0; r < 16; ++r) ps += p0[r]; for (int r = 0; r < 16; ++r) ps += p1[r];
    { auto rr = __builtin_amdgcn_permlane32_swap(__float_as_uint(ps), __float_as_uint(ps), false, false);
      ps = __uint_as_float(rr[0]) + __uint_as_float(rr[1]); }
    l_reg = l_reg * alpha + ps;
    } else { for (int r = 0; r < 16; ++r) p1[r] *= alpha; }
#define PK4(P, B_, OUT) do { unsigned a0 = cvtpk(P[B_+0], P[B_+1]), a1 = cvtpk(P[B_+2], P[B_+3]);                          \
        unsigned b0 = cvtpk(P[B_+4], P[B_+5]), b1 = cvtpk(P[B_+6], P[B_+7]);                                             \
        auto r0 = __builtin_amdgcn_permlane32_swap(a0, b0, false, false); auto r1 = __builtin_amdgcn_permlane32_swap(a1, b1, false, false); \
        u32x4 w = {r0[0], r1[0], r0[1], r1[1]}; OUT = *reinterpret_cast<bf16x8*>(&w); } while (0)
    PK4(p0, 0, pa0); PK4(p0, 8, pa1); PK4(p1, 0, pa2); PK4(p1, 8, pa3);
#undef PK4
}
template <int KB, bool SK, int MODE>
__device__ __forceinline__ void qkt(f32x16& p0, f32x16& p1, const char* K_lds, int r32, int hi, const bf16x8* qr, bool act, const float* bt) {
    if (SK && !act) { const float NEG = -__builtin_inff();
#pragma unroll
        for (int r = 0; r < 16; ++r) { p0[r] = NEG; p1[r] = NEG; } return; }
    if constexpr (MODE == 0) {
        const f32x4 b0 = *(const f32x4*)(bt), b1 = *(const f32x4*)(bt + 8), b2 = *(const f32x4*)(bt + 16), b3 = *(const f32x4*)(bt + 24);
        const f32x4 c0 = *(const f32x4*)(bt + 32), c1 = *(const f32x4*)(bt + 40), c2 = *(const f32x4*)(bt + 48), c3 = *(const f32x4*)(bt + 56);
        p0 = f32x16{b0[0], b0[1], b0[2], b0[3], b1[0], b1[1], b1[2], b1[3], b2[0], b2[1], b2[2], b2[3], b3[0], b3[1], b3[2], b3[3]};
        p1 = f32x16{c0[0], c0[1], c0[2], c0[3], c1[0], c1[1], c1[2], c1[3], c2[0], c2[1], c2[2], c2[3], c3[0], c3[1], c3[2], c3[3]};
    } else { p0 = f32x16{}; p1 = f32x16{}; }
    const char* kb[4];
#pragma unroll
    for (int dd = 0; dd < 4; ++dd) kb[dd] = K_lds + KB * SHM_K + KSWZ(r32, (dd * 16 + hi * 8) * 2);
#pragma unroll
    for (int d0 = 0; d0 < 8; ++d0) { const char* a = kb[d0 & 3] + (d0 >> 2) * 128;
        bf16x8 b0 = *reinterpret_cast<const bf16x8*>(a);
        bf16x8 b1 = *reinterpret_cast<const bf16x8*>(a + 32 * 256);
        p0 = __builtin_amdgcn_mfma_f32_32x32x16_bf16(b0, qr[d0], p0, 0, 0, 0);
        p1 = __builtin_amdgcn_mfma_f32_32x32x16_bf16(b1, qr[d0], p1, 0, 0, 0); }
}
template <int VB, bool SK>
__device__ __forceinline__ void pv_tile(f32x16* o, int vb0, bf16x8 pa0, bf16x8 pa1, bf16x8 pa2, bf16x8 pa3, bool act) {
    if (SK && !act) return;
#define TRRD(dst, off) asm volatile("ds_read_b64_tr_b16 %0, %1 offset:%2" : "=&v"(dst) : "v"(vb0), "i"(off) : "memory")
#define PV_D0(d0) do { s16x4 l0, l1, l2, l3, h0, h1, h2, h3; constexpr int b_ = VB * SHM_V + v_rd_off(d0, 0, 0);     \
        TRRD(l0, b_); TRRD(h0, b_ + 2048); TRRD(l1, b_ + 4096); TRRD(h1, b_ + 6144); TRRD(l2, b_ + 8192); TRRD(h2, b_ + 10240); TRRD(l3, b_ + 12288); TRRD(h3, b_ + 14336); \
        asm volatile("s_waitcnt lgkmcnt(0)" ::: "memory"); SBAR();                 \
        o[d0] = __builtin_amdgcn_mfma_f32_32x32x16_bf16(pa0, (bf16x8){l0[0], l0[1], l0[2], l0[3], h0[0], h0[1], h0[2], h0[3]}, o[d0], 0, 0, 0);   \
        o[d0] = __builtin_amdgcn_mfma_f32_32x32x16_bf16(pa1, (bf16x8){l1[0], l1[1], l1[2], l1[3], h1[0], h1[1], h1[2], h1[3]}, o[d0], 0, 0, 0);   \
        o[d0] = __builtin_amdgcn_mfma_f32_32x32x16_bf16(pa2, (bf16x8){l2[0], l2[1], l2[2], l2[3], h2[0], h2[1], h2[2], h2[3]}, o[d0], 0, 0, 0);   \
        o[d0] = __builtin_amdgcn_mfma_f32_32x32x16_bf16(pa3, (bf16x8){l3[0], l3[1], l3[2], l3[3], h3[0], h3[1], h3[2], h3[3]}, o[d0], 0, 0, 0); } while (0)
    PV_D0(0); PV_D0(1); PV_D0(2); PV_D0(3);
#undef PV_D0
#undef TRRD
}

template <class TIn, class TOut> struct BlockRef { const TIn* Q; const TIn* K; const TIn* V; TOut* O; int P0; int jlo; int bh; };
template <class TIn> struct NextRef { const TIn* Q; const TIn* K; const TIn* V; int jlo; };
template <class TIn> struct Extra { const float* bias; const TIn* G; const float* nw; const TIn* S; };
constexpr int LDO = 2048;
template <class TIn> struct Seam {
    bf16x8 qr[8];
    bf16x8 st_v0, st_v1, st_k0, st_k1; f32x4 sf0, sf1, sf2, sf3;
    f32x4 tq[16];
};
#define ROW(p, k0, rr) ((p) + (unsigned)(((k0) + (rr)) * D + sc))
#define VMW() asm volatile("s_waitcnt vmcnt(0)" ::: "memory")
#define VMWN(n) asm volatile("s_waitcnt vmcnt(%0)" :: "i"(n) : "memory")
#define SLOAD_H(Kp, Vp, k0) do { S.st_v0 = load8<TIn>(ROW(Vp, k0, sr)); S.st_v1 = load8<TIn>(ROW(Vp, k0, 32 + sr));              \
                         S.st_k0 = load8<TIn>(ROW(Kp, k0, sr)); S.st_k1 = load8<TIn>(ROW(Kp, k0, 32 + sr)); } while (0)
#define SWRITE_HK(bf) do { *(bf16x8*)(K_lds + (bf) * SHM_K + kws) = S.st_k0; *(bf16x8*)(K_lds + (bf) * SHM_K + kws + 32 * 256) = S.st_k1; } while (0)
#define SWRITE_HV(bf) do { *(bf16x8*)(V_lds + (bf) * SHM_V + vst0) = S.st_v0; *(bf16x8*)(V_lds + (bf) * SHM_V + vst1) = S.st_v1; } while (0)
#define SWRITE_H(bf) do { SWRITE_HV(bf); SWRITE_HK(bf); } while (0)
#define SLOAD_F(p, k0) do { S.sf0 = *(const f32x4*)ROW(p, k0, sr); S.sf1 = *(const f32x4*)(ROW(p, k0, sr) + 4);                \
                            S.sf2 = *(const f32x4*)ROW(p, k0, 32 + sr); S.sf3 = *(const f32x4*)(ROW(p, k0, 32 + sr) + 4); } while (0)
#define SWRITE_KF(bf) do { *(bf16x8*)(K_lds + (bf) * SHM_K + kws) = pack8(S.sf0, S.sf1); *(bf16x8*)(K_lds + (bf) * SHM_K + kws + 32 * 256) = pack8(S.sf2, S.sf3); } while (0)
#define SWRITE_VF(bf) do { *(bf16x8*)(V_lds + (bf) * SHM_V + vst0) = pack8(S.sf0, S.sf1); *(bf16x8*)(V_lds + (bf) * SHM_V + vst1) = pack8(S.sf2, S.sf3); } while (0)
template <class TIn, class TOut>
__device__ __forceinline__ void causal_swa_prime(const BlockRef<TIn, TOut>& cur, int W, char* lds, Seam<TIn>& S) {
    constexpr bool F32 = same_t<TIn, float>::v;
    const int tid = threadIdx.x, wid = __builtin_amdgcn_readfirstlane(tid >> 6), lane = tid & 63, r32 = lane & 31, hi = lane >> 5;
    const int sr = tid >> 4, sc = (tid & 15) * 8, kws = KSWZ(sr, sc * 2); char* K_lds = lds + 2 * SHM_V;
    const int kb0 = cur.jlo * KVBLK;
    for (int d0 = 0; d0 < 8; ++d0) S.qr[d0] = load8<TIn>(cur.Q + (unsigned)((wid * QBLK + r32) * D + d0 * 16 + hi * 8));
    if constexpr (F32) { SLOAD_F((const float*)cur.K, kb0); VMW(); SWRITE_KF(0); SBAR(); SLOAD_F((const float*)cur.V, kb0); }
    else { SLOAD_H(cur.K, cur.V, kb0); VMW(); SWRITE_HK(0); }
    __syncthreads();
}
template <int MODE, class TIn, class TOut>
__device__ __forceinline__ void causal_swa_block(const BlockRef<TIn, TOut>& cur, const NextRef<TIn>& nxt, const Extra<TIn>& X, int skv, int W, char* lds, Seam<TIn>& S) {
    constexpr bool F32 = same_t<TIn, float>::v;
    int tid_ = threadIdx.x; asm volatile("" : "+v"(tid_));
    const int tid = tid_, wid = __builtin_amdgcn_readfirstlane(tid >> 6), lane = tid & 63, r32 = lane & 31, hi = lane >> 5;
    const int j_lo = cur.jlo;
    int j_hi = (cur.P0 + QB - 1) / KVBLK + 1; if (j_hi > skv / KVBLK) j_hi = skv / KVBLK;
    const int NT = j_hi - j_lo;
    const int kbn = nxt.jlo * KVBLK;
    const int qlo = cur.P0 + wid * QBLK, qm = qlo + r32 - 4 * hi;
    char* V_lds = lds; char* K_lds = lds + 2 * SHM_V;
    float* ws = (float*)(lds + 2 * SHM_V + 2 * SHM_K) + wid * 64; float* li_l = ws, * al_l = ws + 32;
    float m_reg = -1e30f, l_reg = 0; f32x16 o[4] = {};
    const int sr = tid >> 4, sc = (tid & 15) * 8, vst0 = v_st(sr, sc), vst1 = v_st(32 + sr, sc), kws = KSWZ(sr, sc * 2);
    const int vb0 = (int)(uintptr_t)V_lds + v_rd_base(lane);
    const TIn* Kh = cur.K; const TIn* Vh = cur.V;
    const float* bl = (const float*)(lds + LDS_BIAS) + 4 * hi;
    if constexpr (MODE == 0) { for (int i = tid; i < NT * 16; i += 64 * NW) *(f32x4*)(lds + LDS_BIAS + i * 16) = *(const f32x4*)(X.bias + (size_t)cur.bh * 8192 + j_lo * KVBLK + i * 4); __syncthreads(); }
    const float l2g = MODE ? log2f(1.f - exp2f(-5.f - (float)(cur.bh & 7))) : 0.f;
    if constexpr (MODE == 1) {
        const TIn* Sg = X.S + ((size_t)(cur.bh * 32 + (cur.P0 >> 8))) * 16384 + (unsigned)(r32 * D + hi * 8);
        const float fq = __builtin_amdgcn_exp2f(l2g * (float)(wid * QBLK + r32 + 1));
#pragma unroll
        for (int d0 = 0; d0 < 8; ++d0) { const u32x4 qw = *reinterpret_cast<const u32x4*>(&S.qr[d0]); u32x4 sw;
#pragma unroll
            for (int i = 0; i < 4; ++i) sw[i] = cvtpk(__uint_as_float(qw[i] << 16) * fq, __uint_as_float(qw[i] & 0xffff0000u) * fq);
            const bf16x8 qs = *reinterpret_cast<const bf16x8*>(&sw);
#pragma unroll
            for (int eb = 0; eb < 4; ++eb) { const bf16x8 sb = *reinterpret_cast<const bf16x8*>(Sg + eb * 32 * D + d0 * 16); o[eb] = __builtin_amdgcn_mfma_f32_32x32x16_bf16(qs, sb, o[eb], 0, 0, 0); }
            if (d0 & 1) asm volatile("" ::: "memory"); }
    }
#define BT(t) (bl + (t) * KVBLK)
#define PSM(P0_, P1_, mnX, alX, t) do { if constexpr (MODE == 0) partialSM(P0_, P1_, m_reg, mnX, alX); else { alX = __builtin_amdgcn_exp2f(l2g * (float)(qlo + r32 - KBASE(t))); partialRet(P0_, alX); } } while (0)
#define RESC(a) do { if (MODE == 0 && __any((a) < 1.f)) { if (hi == 0) al_l[r32] = (a); asm volatile("s_waitcnt lgkmcnt(0)" ::: "memory");              \
                     for (int d_ = 0; d_ < 4; ++d_) for (int r = 0; r < 16; ++r) o[d_][r] *= al_l[crow(r, hi)]; } } while (0)
#define KBASE(t) ((j_lo + (t)) * KVBLK)
#define ACT(t) (KBASE(t) <= qlo + QBLK - 1 && KBASE(t) + KVBLK - 1 >= qlo - W + 1)
#define MASKT(P0_, P1_, t) do { const int kb_ = KBASE(t); if ((!SK || ACT(t)) && (kb_ + KVBLK - 1 > qlo || kb_ <= qlo + QBLK - 1 - W)) mask_tile<MODE>(P0_, P1_, qm - kb_, (unsigned)W); } while (0)
    constexpr int NQL = F32 ? 16 : 8;
    constexpr bool SK = WSKIP && !F32;
#define SEAM_K0() do { VMWN(NQL); if constexpr (F32) { SWRITE_KF(0); SBAR(); SLOAD_F((const float*)nxt.V, kbn); } else { SWRITE_HK(0); } SBAR(); } while (0)
    f32x16 pA0, pA1, pB0, pB1; float mnA, mnB, alA, alB; bf16x8 pa0, pa1, pa2, pa3;
    if constexpr (F32) { VMW(); SWRITE_VF(0); SBAR(); } else { SWRITE_HV(0); SBAR(); }
    if (NT > 1) { if constexpr (F32) SLOAD_F((const float*)Kh, KBASE(1)); else SLOAD_H(Kh, Vh, KBASE(1)); }
    SBAR(); qkt<0, SK, MODE>(pA0, pA1, K_lds, r32, hi, S.qr, ACT(0), BT(0));
    if constexpr (F32) { if (NT > 1) { VMW(); SWRITE_KF(1); SBAR(); SLOAD_F((const float*)Vh, KBASE(1)); } }
    MASKT(pA0, pA1, 0); PSM(pA0, pA1, mnA, alA, 0);
    if (NT > 1) { VMW(); if constexpr (F32) { SWRITE_VF(1); SBAR(); if (NT > 2) SLOAD_F((const float*)Kh, KBASE(2)); } else SWRITE_H(1); }
    __syncthreads();
#define HALF_STEP(PX0, PX1, mnX, alX, PY0, PY1, alY, t, KB, VB, SB) do {                                                      \
        SBAR(); qkt<KB, SK, MODE>(PX0, PX1, K_lds, r32, hi, S.qr, ACT(t), BT(t));                                \
        finishSM<MODE>(PY0, PY1, alY, l_reg, pa0, pa1, pa2, pa3); SBAR();                                                           \
        if ((t) + 1 < NT) { if constexpr (F32) { VMW(); SWRITE_KF(SB); SBAR(); SLOAD_F((const float*)Vh, KBASE((t) + 1)); }  \
                            else { SLOAD_H(Kh, Vh, KBASE((t) + 1)); } SBAR(); }                                               \
        pv_tile<VB, SK>(o, vb0, pa0, pa1, pa2, pa3, ACT((t) - 1)); MASKT(PX0, PX1, (t)); PSM(PX0, PX1, mnX, alX, (t));                                        \
        __syncthreads();                                                                                                      \
        if ((t) + 1 < NT) { VMW(); if constexpr (F32) { SWRITE_VF(SB); SBAR(); if ((t) + 2 < NT) SLOAD_F((const float*)Kh, KBASE((t) + 2)); } \
                            else { SWRITE_H(SB); } }                                                                          \
        RESC(alX); __syncthreads(); } while (0)
    for (int t = 1; t + 1 < NT; t += 2) {
        HALF_STEP(pB0, pB1, mnB, alB, pA0, pA1, alA, t, 1, 0, 0);
        HALF_STEP(pA0, pA1, mnA, alA, pB0, pB1, alB, t + 1, 0, 1, 1);
    }
    const bool even = (NT & 1) == 0;
    if (even) { SBAR(); qkt<1, SK, MODE>(pB0, pB1, K_lds, r32, hi, S.qr, ACT(NT - 1), BT(NT - 1)); SBAR(); }
#define QROW(e) (nxt.Q + (size_t)(wid * QBLK + r32) * D + ((e) >> 1) * 16 + hi * 8 + ((e) & 1) * 4)
    if constexpr (F32) { SLOAD_F((const float*)nxt.K, kbn); SBAR();
#pragma unroll
        for (int e = 0; e < 8; ++e) S.tq[e] = *(const f32x4*)QROW(e); }
    else { SLOAD_H(nxt.K, nxt.V, kbn); SBAR();
#pragma unroll
        for (int d0 = 0; d0 < 8; ++d0) S.qr[d0] = load8<TIn>(nxt.Q + (unsigned)((wid * QBLK + r32) * D + d0 * 16 + hi * 8)); }
    SBAR();
    finishSM<MODE>(pA0, pA1, alA, l_reg, pa0, pa1, pa2, pa3); SBAR();
    if constexpr (F32) {
#pragma unroll
        for (int e = 8; e < 16; ++e) S.tq[e] = *(const f32x4*)QROW(e); SBAR(); }
#undef QROW
    pv_tile<0, SK>(o, vb0, pa0, pa1, pa2, pa3, ACT(even ? NT - 2 : NT - 1));
    if (even) { MASKT(pB0, pB1, NT - 1); PSM(pB0, pB1, mnB, alB, NT - 1); __syncthreads(); RESC(alB);
        finishSM<MODE>(pB0, pB1, alB, l_reg, pa0, pa1, pa2, pa3); SBAR(); pv_tile<1, SK>(o, vb0, pa0, pa1, pa2, pa3, ACT(NT - 1)); }
    SBAR(); SEAM_K0();
    float rli[16];
    if constexpr (MODE == 0) {
        if (hi == 0) li_l[r32] = l_reg; asm volatile("s_waitcnt lgkmcnt(0)" ::: "memory");
#pragma unroll
        for (int r = 0; r < 16; ++r) rli[r] = __builtin_amdgcn_rcpf(li_l[crow(r, hi)]);
    } else {
#pragma unroll
        for (int r = 0; r < 16; ++r) { float sq = (o[0][r] * o[0][r] + o[1][r] * o[1][r]) + (o[2][r] * o[2][r] + o[3][r] * o[3][r]);
            sq += __shfl_xor(sq, 1); sq += __shfl_xor(sq, 2); sq += __shfl_xor(sq, 4); sq += __shfl_xor(sq, 8); sq += __shfl_xor(sq, 16);
            rli[r] = rsqrtf(sq * (1.f / 128.f) + 1e-6f); }
    }
    { int t2 = threadIdx.x; asm volatile("" : "+v"(t2));
      const int w2 = __builtin_amdgcn_readfirstlane(t2 >> 6), c2 = t2 & 31, h2 = (t2 >> 5) & 1;
      TOut* Ow = cur.O + (unsigned)((w2 * QBLK + 4 * h2) * LDO + c2);
      float nwv[4] = {1.f, 1.f, 1.f, 1.f}; const TIn* Gp = nullptr;
      if constexpr (MODE == 1) { Gp = X.G + ((size_t)cur.bh * 8192 + cur.P0) * D + (unsigned)((w2 * QBLK + 4 * h2) * D + c2);
#pragma unroll
          for (int d0 = 0; d0 < 4; ++d0) nwv[d0] = X.nw[(cur.bh & 7) * D + d0 * 32 + c2]; }
#pragma unroll
      for (int r = 0; r < 16; ++r) { const int ro = (r & 3) + 8 * (r >> 2);
          float v[4];
#pragma unroll
          for (int d0 = 0; d0 < 4; ++d0) { v[d0] = o[d0][r] * rli[r];
              if constexpr (MODE == 1) { const unsigned gq = Gp[ro * D + d0 * 32]; v[d0] *= nwv[d0] * __uint_as_float(gq << 16); } }
#pragma unroll
          for (int d0 = 0; d0 < 4; ++d0) { const float vn = __shfl_xor(v[d0], 1);
              if ((c2 & 1) == 0) *(unsigned*)(Ow + ro * LDO + d0 * 32) = cvtpk(v[d0], vn); }
          if ((r & 3) == 3) asm volatile("" ::: "memory"); } }
    if constexpr (F32) {
#pragma unroll
        for (int d0 = 0; d0 < 8; ++d0) S.qr[d0] = pack8(S.tq[2 * d0], S.tq[2 * d0 + 1]); }
    __syncthreads();
#undef RESC
#undef BT
#undef PSM
#undef KBASE
#undef ACT
#undef MASKT
#undef SEAM_K0
#undef HALF_STEP
}
#undef ROW
#undef VMW
#undef VMWN
#undef SLOAD_H
#undef SWRITE_HK
#undef SWRITE_HV
#undef SWRITE_H
#undef SLOAD_F
#undef SWRITE_KF
#undef SWRITE_VF

}
constexpr int NWAVES = 8;
namespace W {
constexpr size_t CTL = 0, CTL_ZERO_BYTES = 1 * MiB;
constexpr size_t MOD = 1 * MiB, MODP = 2 * MiB, ROPE = 4 * MiB, LOGF = 8 * MiB, CUM = 9 * MiB, BIAS = 9 * MiB + 512 * 1024, ROUTE = 10 * MiB, TILE = 11 * MiB, JLO = 12 * MiB, WFR = 13 * MiB, A2S2 = 14 * MiB;
constexpr size_t XN = 16 * MiB, MIX = 80 * MiB, WT_IN = 144 * MiB, WT_OUT = 172 * MiB, WT_13 = 180 * MiB, WT_2 = 308 * MiB, QKV = 372 * MiB, END = 596 * MiB;
constexpr size_t KVS = XN, ST = XN + 32 * MiB;
constexpr size_t H2 = XN, XS = QKV, ACT = QKV + 160 * MiB, Y = 16 * MiB;
constexpr size_t NV_RO = 596 * MiB, NV_UP = 596 * MiB, NV_Z = 144 * MiB, NV_END = 676 * MiB;
}
constexpr int CW_CNT = 0, CNT_STRIDE = 64;
constexpr int CW_BAR = 4096;
constexpr int RING_OFF = 0, RING_BYTES = 131072, XCH_OFF = 131072, XCH_BYTES = 8192, LDS_BYTES = 163840, MISC_OFF = LDS_BYTES - 512;

struct Args { const float* in[19]; float* out; unsigned char* ws; int ph_lo, ph_hi, li, pad; };

__device__ __forceinline__ float wave_sum(float v) {
#define WS_DPP(ctrl, rmask, bc) v += __int_as_float(__builtin_amdgcn_update_dpp(0, __float_as_int(v), ctrl, rmask, 0xF, bc))
    WS_DPP(0x111, 0xF, true); WS_DPP(0x112, 0xF, true); WS_DPP(0x114, 0xF, true); WS_DPP(0x118, 0xF, true);
    WS_DPP(0x142, 0xA, false); WS_DPP(0x143, 0xC, false);
#undef WS_DPP
    return __int_as_float(__builtin_amdgcn_readlane(__float_as_int(v), 63));
}
__device__ __forceinline__ unsigned pk2(float lo, float hi) { return f2bf(lo) | (f2bf(hi) << 16); }
__device__ __forceinline__ float log_sigmoid_f(float x) { return x >= 0.f ? -log1pf(expf(-x)) : x - log1pf(expf(x)); }

__device__ __forceinline__ void tr_item(const float* colp, size_t ldw, bf16_t* WT, int K, int k0, int n0, LAS float* scr, int lane) {
#pragma unroll 8
    for (int i = 0; i < 32; ++i) { const int kk = 2 * i + (lane >> 5); scr[kk * 33 + (lane & 31)] = colp[(size_t)(k0 + kk) * ldw]; }
    LDS_WAIT(); asm volatile("" ::: "memory");
    const int c = lane & 7;
#pragma unroll
    for (int j = 0; j < 4; ++j) { const int n = (lane >> 3) + 8 * j; const LAS float* s = scr + (8 * c) * 33 + n;
        uint4 o; o.x = pk2(s[0 * 33], s[1 * 33]); o.y = pk2(s[2 * 33], s[3 * 33]); o.z = pk2(s[4 * 33], s[5 * 33]); o.w = pk2(s[6 * 33], s[7 * 33]);
        *(uint4*)(WT + (size_t)(n0 + n) * K + k0 + 8 * c) = o; }
    LDS_WAIT(); asm volatile("" ::: "memory");
}
__device__ __forceinline__ void tr_item4(const float* colp4, size_t ldw, bf16_t* WT, int K, int k0, int n0, LAS float* scr, int lane) {
    const int kr = lane >> 3, cq = (lane & 7) * 4;
    pg8::f32x4 v[8];
#pragma unroll
    for (int i = 0; i < 8; ++i) v[i] = *(const pg8::f32x4*)(colp4 + (size_t)(k0 + i * 8 + kr) * ldw);
#pragma unroll
    for (int i = 0; i < 8; ++i) { const int kk = i * 8 + kr;
        scr[kk * 33 + cq] = v[i][0]; scr[kk * 33 + cq + 1] = v[i][1]; scr[kk * 33 + cq + 2] = v[i][2]; scr[kk * 33 + cq + 3] = v[i][3]; }
    LDS_WAIT(); asm volatile("" ::: "memory");
    const int c = lane & 7;
#pragma unroll
    for (int j = 0; j < 4; ++j) { const int n = (lane >> 3) + 8 * j; const LAS float* s = scr + (8 * c) * 33 + n;
        uint4 o; o.x = pk2(s[0 * 33], s[1 * 33]); o.y = pk2(s[2 * 33], s[3 * 33]); o.z = pk2(s[4 * 33], s[5 * 33]); o.w = pk2(s[6 * 33], s[7 * 33]);
        *(uint4*)(WT + (size_t)(n0 + n) * K + k0 + 8 * c) = o; }
    LDS_WAIT(); asm volatile("" ::: "memory");
}
__device__ __forceinline__ int win_src(int n) {
    const int tt = n >> 10;
    if (tt < 3) return n;
    if (tt < 5) { const int d = n & 127; return 8 + (n & ~127) + (d & 1) * 64 + (d >> 1); }
    return n + 8;
}
__device__ __forceinline__ void ph0(const Args& a, LAS unsigned char* lds, int G) {
    const int tid = threadIdx.x, lane = tid & 63, wave = __builtin_amdgcn_readfirstlane(tid >> 6);
    unsigned char* ws = a.ws;
    LAS float* cact = (LAS float*)(lds + RING_OFF + 98304);
    const float* c = a.in[1]; const float* w_ada = a.in[2];
    for (int i = tid; i < 4096; i += 512) { const float cv = c[i]; cact[i] = cv / (1.f + expf(-cv)); }
    __syncthreads();
    float* modp = (float*)(ws + W::MODP);
    LAS float* red = (LAS float*)(lds + RING_OFF);
    for (int it = blockIdx.x; it < 192; it += G) { const int cb = it % 12, ks = it / 12; const int col = cb * 1024 + lane * 4, k0 = ks * 128 + wave * 16;
        pg8::f32x4 w[16];
#pragma unroll
        for (int i = 0; i < 16; ++i) w[i] = *(const pg8::f32x4*)(w_ada + (size_t)(k0 + i) * 12288 + col);
        pg8::f32x4 a0 = {0.f, 0.f, 0.f, 0.f}, a1 = {0.f, 0.f, 0.f, 0.f}, b0 = a0, b1 = a0, c0 = a0, c1 = a0, d0 = a0, d1 = a0;
        (void)b0; (void)b1; (void)c0; (void)c1; (void)d0; (void)d1;
#pragma unroll
        for (int i = 0; i < 16; ++i) { a0 += w[i] * cact[k0 + i]; a1 += w[i] * cact[2048 + k0 + i]; }
        pg8::f32x4 e0[3], e1[3];
#pragma unroll
        for (int q = 1; q < 4; ++q) { pg8::f32x4 t0 = {0.f, 0.f, 0.f, 0.f}, t1 = t0;
#pragma unroll
            for (int i = 0; i < 16; ++i) w[i] = *(const pg8::f32x4*)(w_ada + (size_t)(k0 + i) * 12288 + col + q * 256);
#pragma unroll
            for (int i = 0; i < 16; ++i) { t0 += w[i] * cact[k0 + i]; t1 += w[i] * cact[2048 + k0 + i]; }
            e0[q - 1] = t0; e1[q - 1] = t1; }
        __syncthreads();
        *(LAS pg8::f32x4*)(red + (wave * 2 + 0) * 1024 + lane * 4) = a0; *(LAS pg8::f32x4*)(red + (wave * 2 + 1) * 1024 + lane * 4) = a1;
#pragma unroll
        for (int q = 1; q < 4; ++q) { *(LAS pg8::f32x4*)(red + (wave * 2 + 0) * 1024 + q * 256 + lane * 4) = e0[q - 1]; *(LAS pg8::f32x4*)(red + (wave * 2 + 1) * 1024 + q * 256 + lane * 4) = e1[q - 1]; }
        __syncthreads();
        for (int i = tid; i < 2048; i += 512) { const int bb = i >> 10, cc = i & 1023; float t = 0.f;
#pragma unroll
            for (int wv = 0; wv < 8; ++wv) t += red[(wv * 2 + bb) * 1024 + cc];
            modp[(ks * 2 + bb) * 12288 + cb * 1024 + cc] = t; }
    }
    __syncthreads();
    float2* rope = (float2*)(ws + W::ROPE);
    for (int i = blockIdx.x * 512 + tid; i < 8192 * 64; i += G * 512) { const int s = i >> 6, j = i & 63;
        const float theta = powf(10000.f, -(float)j / 64.f); const float ang = (float)s * theta;
        const double ad = (double)ang, TWO_PI = 6.283185307179586; const double kq = rint(ad / TWO_PI); const float r = (float)(ad - kq * TWO_PI);
        rope[i] = make_float2(cosf(r), sinf(r)); }
    { bf16_t* wfr = (bf16_t*)(ws + W::WFR); const float* w_coarse = a.in[12]; const float* w_fine = a.in[14];
      for (int i = blockIdx.x * 512 + tid; i < 64 * 3 * 64 * 8; i += G * 512) { const int e8 = i & 7, ln = (i >> 3) & 63, ob = (i >> 9) % 3, ks = (i >> 9) / 3, o = ob * 16 + (ln & 15), k = 32 * ks + 8 * (ln >> 4) + e8;
          const float wv = o < 4 ? w_coarse[(size_t)k * 4 + o] : (o < 36 ? w_fine[((size_t)((o - 4) >> 3) * 2048 + k) * 8 + ((o - 4) & 7)] : 0.f);
          const unsigned h = f2bf(wv), l = f2bf(wv - __uint_as_float(h << 16));
          wfr[(((size_t)(ks * 3 + ob) * 2 + 0) * 64 + ln) * 8 + e8] = (bf16_t)h; wfr[(((size_t)(ks * 3 + ob) * 2 + 1) * 64 + ln) * 8 + e8] = (bf16_t)l; } }
    LAS float* scr = (LAS float*)(lds + RING_OFF + wave * 12288);
    const float* w_in = a.in[5]; const float* w_out = a.in[10]; const float* w1 = a.in[16]; const float* w3 = a.in[17]; const float* w2 = a.in[18];
    bf16_t* wt_in = (bf16_t*)(ws + W::WT_IN); bf16_t* wt_out = (bf16_t*)(ws + W::WT_OUT); bf16_t* wt_13 = (bf16_t*)(ws + W::WT_13); bf16_t* wt_2 = (bf16_t*)(ws + W::WT_2);
    constexpr int I_IN = 32 * 224, I_OUT = 32 * 64, I_13 = 32 * 1024, I_2 = 32 * 512, NITEMS = I_IN + I_OUT + I_13 + I_2;
    const int gw = blockIdx.x * NWAVES + wave, NGW = G * NWAVES;
    for (int it = gw; it < NITEMS; it += NGW) {
        int r = it;
        if (r < I_IN) { const int kb = r / 224, nb = r % 224; tr_item(w_in + win_src(nb * 32 + (lane & 31)), 7176, wt_in, 2048, kb * 64, nb * 32, scr, lane); continue; } r -= I_IN;
        if (r < I_OUT) { const int kb = r / 64, nb = r % 64; tr_item4(w_out + nb * 32 + (lane & 7) * 4, 2048, wt_out, 2048, kb * 64, nb * 32, scr, lane); continue; } r -= I_OUT;
        if (r < I_13) { const int e = r >> 10, r2 = r & 1023, kb = r2 >> 5, nb = r2 & 31; const int cq = lane & 7, g = (nb * 32 + cq * 4) >> 3;
            const float* colp4 = ((cq & 1) ? w3 : w1) + (size_t)e * 2048 * 512 + 4 * g;
            tr_item4(colp4, 512, wt_13 + (size_t)e * 1024 * 2048, 2048, kb * 64, nb * 32, scr, lane); continue; } r -= I_13;
        { const int e = r >> 9, r2 = r & 511, kb = r2 >> 6, nb = r2 & 63;
          tr_item4(w2 + (size_t)e * 512 * 2048 + nb * 32 + (lane & 7) * 4, 2048, wt_2 + (size_t)e * 2048 * 512, 512, kb * 64, nb * 32, scr, lane); }
    }
}

__device__ __forceinline__ void ph1(const Args& a, LAS unsigned char* lds, int G) {
    const int tid = threadIdx.x, lane = tid & 63, wave = __builtin_amdgcn_readfirstlane(tid >> 6);
    unsigned char* ws = a.ws;
    const float* x = a.in[0]; const float* b_ada = a.in[3]; const float* norm1_w = a.in[4]; const float* w_in = a.in[5]; const float* fbias = a.in[6];
    const float* modp = (const float*)(ws + W::MODP); float* mod = (float*)(ws + W::MOD); bf16_t* xn = (bf16_t*)(ws + W::XN); float* logf_ = (float*)(ws + W::LOGF);
    for (int i = blockIdx.x * 512 + tid; i < 2 * 12288; i += G * 512) { const int b = i / 12288, j = i % 12288; float s = b_ada[j];
        for (int k = 0; k < 16; ++k) s += modp[(k * 2 + b) * 12288 + j];
        mod[i] = s; }
    LAS float* A1 = (LAS float*)(lds + RING_OFF); LAS float* S1 = A1 + 2048; LAS float* WFT = S1 + 2048;
    for (int i = tid; i < 2048 * 2; i += 512) { const int cc = i >> 1, hf = (i & 1) * 4; const pg8::f32x4 w = *(const pg8::f32x4*)(w_in + (size_t)cc * 7176 + 3072 + hf);
        WFT[(hf + 0) * 2048 + cc] = w[0]; WFT[(hf + 1) * 2048 + cc] = w[1]; WFT[(hf + 2) * 2048 + cc] = w[2]; WFT[(hf + 3) * 2048 + cc] = w[3]; }
    int bprev = -1;
    for (int rb = blockIdx.x; rb < 256; rb += G) {
        const int b = rb >> 7;
        if (b != bprev) { __syncthreads();
            for (int cc = tid; cc < 2048; cc += 512) { float sh = b_ada[cc], sc = b_ada[2048 + cc];
                for (int k = 0; k < 16; ++k) { sh += modp[(k * 2 + b) * 12288 + cc]; sc += modp[(k * 2 + b) * 12288 + 2048 + cc]; }
                A1[cc] = norm1_w[cc] * (1.f + sc); S1[cc] = sh; }
            __syncthreads(); bprev = b; }
#pragma unroll 1
        for (int q = 0; q < 8; ++q) {
            const int row = rb * 64 + wave * 8 + q;
            pg8::f32x4 v[8]; float ss = 0.f;
#pragma unroll
            for (int j = 0; j < 8; ++j) { v[j] = *(const pg8::f32x4*)(x + (size_t)row * 2048 + j * 256 + lane * 4); ss += (v[j][0] * v[j][0] + v[j][1] * v[j][1]) + (v[j][2] * v[j][2] + v[j][3] * v[j][3]); }
            const float rstd = rsqrtf(wave_sum(ss) * (1.f / 2048.f) + 1e-6f);
            float fa[8] = {0.f, 0.f, 0.f, 0.f, 0.f, 0.f, 0.f, 0.f};
#pragma unroll
            for (int j = 0; j < 8; ++j) { const int c = j * 256 + lane * 4; const pg8::f32x4 a1 = *(const LAS pg8::f32x4*)(A1 + c), s1 = *(const LAS pg8::f32x4*)(S1 + c);
                const pg8::f32x4 h = v[j] * rstd * a1 + s1;
                uint2 pk; pk.x = pk2(h[0], h[1]); pk.y = pk2(h[2], h[3]); *(uint2*)(xn + (size_t)row * 2048 + c) = pk;
#pragma unroll
                for (int hh = 0; hh < 8; ++hh) { const pg8::f32x4 w = *(const LAS pg8::f32x4*)(WFT + hh * 2048 + c); fa[hh] += (h[0] * w[0] + h[1] * w[1]) + (h[2] * w[2] + h[3] * w[3]); }
                asm volatile("" ::: "memory"); }
            float t = 0.f;
#pragma unroll
            for (int hh = 0; hh < 8; ++hh) { const float sm = wave_sum(fa[hh]); if (lane == hh) t = sm; }
            if (lane < 8) logf_[(size_t)((row >> 13) * 8 + lane) * 8192 + (row & 8191)] = log_sigmoid_f(t + fbias[lane]);
        }
    }
    __syncthreads();
}

__device__ __forceinline__ void cumsum_bh(const Args& a, LAS unsigned char* lds, int bh) {
    const int tid = threadIdx.x; unsigned char* ws = a.ws;
    const float* p = (const float*)(ws + W::LOGF) + (size_t)bh * 8192 + tid * 16; float* cum = (float*)(ws + W::CUM) + (size_t)bh * 8192 + tid * 16; float* bias = (float*)(ws + W::BIAS) + (size_t)bh * 8192 + tid * 16;
    LAS double* sc = (LAS double*)(lds + RING_OFF);
    double run = 0.0;
#pragma unroll
    for (int i = 0; i < 16; ++i) run += (double)p[i];
    sc[tid] = run; __syncthreads();
    int cur = 0;
    for (int o = 1; o < 512; o <<= 1) { const double t = sc[cur * 512 + tid] + (tid >= o ? sc[cur * 512 + tid - o] : 0.0); sc[(cur ^ 1) * 512 + tid] = t; cur ^= 1; __syncthreads(); }
    double acc = sc[cur * 512 + tid] - run;
    LAS float* TE = (LAS float*)(lds + RING_OFF + 16384); LAS float* BS = TE + 128; LAS int* JL = (LAS int*)(BS + 32);
#pragma unroll
    for (int i = 0; i < 16; ++i) { acc += (double)p[i]; cum[i] = (float)acc; bias[i] = (float)(-acc * 11.313708498984761);
        if (i == 0 && (tid & 15) == 0) BS[tid >> 4] = (float)acc;
        if (i == 15 && (tid & 3) == 3) TE[tid >> 2] = (float)acc; }
    if (tid < 32) JL[tid] = 4 * tid;
    __syncthreads();
    float mq = 0.f, mk = 0.f;
    for (int i = 0; i < 128; ++i) { mq = fmaxf(mq, fabsf(a.in[7][i])); mk = fmaxf(mk, fabsf(a.in[8][i])); }
    const float thr = 30.f + 2.f * 11.313708498984761f * mq * mk;
    for (int pr = tid; pr < 32 * 128; pr += 512) { const int qb = pr >> 7, j = pr & 127; if (j <= 4 * qb && TE[j] < BS[qb] + thr) atomicMin((int*)(JL + qb), j); }
    __syncthreads();
    if (tid < 32) ((int*)(ws + W::JLO))[bh * 32 + tid] = JL[tid];
    __syncthreads();
}
struct EpiZ {
    static constexpr bool PERM = true, AFTER_DRAIN = false;
    bf16_t* qkv; const float* q_norm_w; const float* k_norm_w; const float* rope; PG8_LAS float* xch;
    __device__ __forceinline__ void operator()(const pg8::f32x4 (&acc)[2][2][4][2], const pg8::Unit& u, int wr, int wc, int fr, int fq) const {
        using pg8::f32x4; using pg8::u32x4;
        const int tt = u.pn >> 2, hp = (u.pn & 3) * 2;
        const int row0 = u.pm * 256 + wr * 64 + fr, b = row0 >> 13, dcol = wc * 32 + 8 * fq;
        bf16_t* base = qkv + (size_t)tt * QKV_ELEMS + ((size_t)(b * 8 + hp) * 8192) * 128 + dcol;
        if (tt < 2) {
#pragma unroll
            for (int ai = 0; ai < 2; ++ai)
#pragma unroll
                for (int m = 0; m < 4; ++m)
#pragma unroll
                    for (int bj = 0; bj < 2; ++bj) { const f32x4 v0 = acc[ai][bj][m][0], v1 = acc[ai][bj][m][1];
                        float s = (v0[0] * v0[0] + v0[1] * v0[1]) + (v0[2] * v0[2] + v0[3] * v0[3]) + (v1[0] * v1[0] + v1[1] * v1[1]) + (v1[2] * v1[2] + v1[3] * v1[3]);
                        s += __shfl_xor(s, 16); s += __shfl_xor(s, 32);
                        if (fq == 0) xch[((ai * 128 + wr * 64 + m * 16 + fr) * 2 + bj) * 4 + wc] = s; }
            asm volatile("s_waitcnt lgkmcnt(0)" ::: "memory"); __builtin_amdgcn_s_barrier(); asm volatile("" ::: "memory");
            const float* nw = tt == 0 ? q_norm_w : k_norm_w; const f32x4 w0 = *(const f32x4*)(nw + dcol), w1 = *(const f32x4*)(nw + dcol + 4);
#pragma unroll
            for (int ai = 0; ai < 2; ++ai)
#pragma unroll
                for (int m = 0; m < 4; ++m) { const int rl = ai * 128 + wr * 64 + m * 16 + fr; const int s_ = (row0 + ai * 128 + m * 16) & 8191;
#pragma unroll
                    for (int bj = 0; bj < 2; ++bj) { const f32x4 p = *(const PG8_LAS f32x4*)(xch + (rl * 2 + bj) * 4);
                        const float rstd = rsqrtf(((p[0] + p[1]) + (p[2] + p[3])) * (1.f / 128.f) + 1e-6f);
                        const f32x4 v0 = acc[ai][bj][m][0] * rstd * w0, v1 = acc[ai][bj][m][1] * rstd * w1;
                        u32x4 w; w.x = pg8::cvt_pk_bf16(v0[0], v0[1]); w.y = pg8::cvt_pk_bf16(v0[2], v0[3]); w.z = pg8::cvt_pk_bf16(v1[0], v1[1]); w.w = pg8::cvt_pk_bf16(v1[2], v1[3]);
                        *(u32x4*)(base + ((size_t)bj * 8192 + s_) * 128) = w; } }
        } else if (tt == 3 || tt == 4) {
            float l2g[2];
#pragma unroll
            for (int bj = 0; bj < 2; ++bj) l2g[bj] = log2f(1.f - exp2f(-5.f - (float)(hp + bj)));
#pragma unroll
            for (int ai = 0; ai < 2; ++ai)
#pragma unroll
                for (int m = 0; m < 4; ++m) { const int s_ = (row0 + ai * 128 + m * 16) & 8191;
                    const f32x4 c0 = *(const f32x4*)(rope + ((size_t)s_ * 64 + (dcol >> 1)) * 2), c1 = *(const f32x4*)(rope + ((size_t)s_ * 64 + (dcol >> 1) + 2) * 2);
#pragma unroll
                    for (int bj = 0; bj < 2; ++bj) { const f32x4 v0 = acc[ai][bj][m][0], v1 = acc[ai][bj][m][1];
                        const float f = tt == 4 ? 0.08838834764831845f * exp2f(-(float)(s_ & 63) * l2g[bj]) : 1.f;
                        const float o0 = (v0[0] * c0[0] - v0[1] * c0[1]) * f, o1 = (v0[0] * c0[1] + v0[1] * c0[0]) * f, o2 = (v0[2] * c0[2] - v0[3] * c0[3]) * f, o3 = (v0[2] * c0[3] + v0[3] * c0[2]) * f;
                        const float o4 = (v1[0] * c1[0] - v1[1] * c1[1]) * f, o5 = (v1[0] * c1[1] + v1[1] * c1[0]) * f, o6 = (v1[2] * c1[2] - v1[3] * c1[3]) * f, o7 = (v1[2] * c1[3] + v1[3] * c1[2]) * f;
                        u32x4 w; w.x = pg8::cvt_pk_bf16(o0, o1); w.y = pg8::cvt_pk_bf16(o2, o3); w.z = pg8::cvt_pk_bf16(o4, o5); w.w = pg8::cvt_pk_bf16(o6, o7);
                        *(u32x4*)(base + ((size_t)bj * 8192 + s_) * 128) = w; } }
        } else {
#pragma unroll
            for (int ai = 0; ai < 2; ++ai)
#pragma unroll
                for (int m = 0; m < 4; ++m) { const int s_ = (row0 + ai * 128 + m * 16) & 8191;
#pragma unroll
                    for (int bj = 0; bj < 2; ++bj) { f32x4 v0 = acc[ai][bj][m][0], v1 = acc[ai][bj][m][1];
                        if (tt == 6) {
#pragma unroll
                            for (int e = 0; e < 4; ++e) { v0[e] = v0[e] / (1.f + __expf(-v0[e])); v1[e] = v1[e] / (1.f + __expf(-v1[e])); } }
                        u32x4 w; w.x = pg8::cvt_pk_bf16(v0[0], v0[1]); w.y = pg8::cvt_pk_bf16(v0[2], v0[3]); w.z = pg8::cvt_pk_bf16(v1[0], v1[1]); w.w = pg8::cvt_pk_bf16(v1[2], v1[3]);
                        *(u32x4*)(base + ((size_t)bj * 8192 + s_) * 128) = w; } }
        }
    }
};


__device__ __forceinline__ void kv_units(const Args& a, char* lds, int G) {
    using namespace at;
    const int tid = threadIdx.x, wid = __builtin_amdgcn_readfirstlane(tid >> 6), lane = tid & 63, r32 = lane & 31, hi = lane >> 5;
    const int sr = tid >> 4, sc = (tid & 15) * 8, st0 = v_st(sr, sc), st1 = v_st(32 + sr, sc);
    const int dblk = wid >> 1, eb0 = (wid & 1) * 2;
    const int kb_ = (int)(uintptr_t)lds + v_rd_base(lane) + dblk * 512, vb_ = (int)(uintptr_t)lds + 32768 + v_rd_base(lane) + eb0 * 512;
    const bf16* q = (const bf16*)(a.ws + W::QKV); float* kvs = (float*)(a.ws + W::KVS);
#define TRRD(dst, base, off) asm volatile("ds_read_b64_tr_b16 %0, %1 offset:%2" : "=&v"(dst) : "v"(base), "i"(off) : "memory")
#define KV_STEP(BUF, KS) do { s16x4 al, ah, b0l, b0h, b1l, b1h; constexpr int o_ = (BUF) * 16384 + (KS) * 4096; \
        TRRD(al, kb_, o_); TRRD(ah, kb_, o_ + 2048); TRRD(b0l, vb_, o_); TRRD(b0h, vb_, o_ + 2048); TRRD(b1l, vb_, o_ + 512); TRRD(b1h, vb_, o_ + 512 + 2048); \
        asm volatile("s_waitcnt lgkmcnt(0)" ::: "memory"); SBAR(); \
        const bf16x8 A_ = {al[0], al[1], al[2], al[3], ah[0], ah[1], ah[2], ah[3]}; \
        acc0 = __builtin_amdgcn_mfma_f32_32x32x16_bf16(A_, (bf16x8){b0l[0], b0l[1], b0l[2], b0l[3], b0h[0], b0h[1], b0h[2], b0h[3]}, acc0, 0, 0, 0); \
        acc1 = __builtin_amdgcn_mfma_f32_32x32x16_bf16(A_, (bf16x8){b1l[0], b1l[1], b1l[2], b1l[3], b1h[0], b1h[1], b1h[2], b1h[3]}, acc1, 0, 0, 0); } while (0)
#define KV_LOAD(T) do { k0 = *(const bf16x8*)(Kp + (unsigned)((64 * (T) + sr) * 128 + sc)); k1 = *(const bf16x8*)(Kp + (unsigned)((64 * (T) + 32 + sr) * 128 + sc)); \
                        v0 = *(const bf16x8*)(Vp + (unsigned)((64 * (T) + sr) * 128 + sc)); v1 = *(const bf16x8*)(Vp + (unsigned)((64 * (T) + 32 + sr) * 128 + sc)); } while (0)
#define KV_WRITE(BUF) do { *(bf16x8*)(lds + (BUF) * 16384 + st0) = k0; *(bf16x8*)(lds + (BUF) * 16384 + st1) = k1; *(bf16x8*)(lds + 32768 + (BUF) * 16384 + st0) = v0; *(bf16x8*)(lds + 32768 + (BUF) * 16384 + st1) = v1; } while (0)
#define KV_TILE(T, BUF) do { if ((T) < 3) KV_LOAD((T) + 1); if ((T) > 0) { acc0 *= g64; acc1 *= g64; } \
        KV_STEP(BUF, 0); KV_STEP(BUF, 1); KV_STEP(BUF, 2); KV_STEP(BUF, 3); if ((T) < 3) { KV_WRITE(1 - (BUF)); } __syncthreads(); } while (0)
    for (int L = blockIdx.x; L < 512; L += G) {
        const int bh = L >> 5, c = L & 31;
        const float l2g = log2f(1.f - exp2f(-5.f - (float)(bh & 7))), g64 = exp2f(64.f * l2g), g63 = exp2f(63.f * l2g);
        const bf16* Kp = q + 4 * QKV_ELEMS + ((size_t)bh * 8192 + c * 256) * 128; const bf16* Vp = q + 5 * QKV_ELEMS + ((size_t)bh * 8192 + c * 256) * 128;
        f32x16 acc0 = {}, acc1 = {}; bf16x8 k0, k1, v0, v1;
        KV_LOAD(0); KV_WRITE(0); __syncthreads();
        KV_TILE(0, 0); KV_TILE(1, 1); KV_TILE(2, 0); KV_TILE(3, 1);
        float* out = kvs + ((size_t)(bh * 32 + c)) * 16384 + (unsigned)((dblk * 32 + 4 * hi) * 128 + eb0 * 32 + r32);
#pragma unroll
        for (int r = 0; r < 16; ++r) { const int ro = (r & 3) + 8 * (r >> 2); out[ro * 128] = g63 * acc0[r]; out[ro * 128 + 32] = g63 * acc1[r]; }
    }
#undef TRRD
#undef KV_STEP
#undef KV_LOAD
#undef KV_WRITE
#undef KV_TILE
}
__device__ __forceinline__ void scan_units(const Args& a, LAS unsigned char* lds, int G) {
    const int tid = threadIdx.x, dl = tid >> 6, e2 = (tid & 63) * 2;
    const float* kvs = (const float*)(a.ws + W::KVS); bf16_t* st = (bf16_t*)(a.ws + W::ST);
    LAS bf16_t* T = (LAS bf16_t*)(lds + RING_OFF);
    for (int L = blockIdx.x; L < 256; L += G) {
        const int bh = L >> 4, d0 = (L & 15) * 8;
        const float g256 = exp2f(256.f * log2f(1.f - exp2f(-5.f - (float)(bh & 7))));
        float2 kv[32];
#pragma unroll
        for (int c = 0; c < 32; ++c) kv[c] = *(const float2*)(kvs + ((size_t)(bh * 32 + c)) * 16384 + (d0 + dl) * 128 + e2);
        float s0 = 0.f, s1 = 0.f;
#pragma unroll
        for (int c = 0; c < 32; ++c) {
            T[e2 * 8 + dl] = (bf16_t)f2bf(s0); T[(e2 + 1) * 8 + dl] = (bf16_t)f2bf(s1);
            __syncthreads();
            if (tid < 128) *(pg8::u32x4*)(st + (((size_t)(bh * 32 + c)) * 128 + tid) * 128 + d0) = *(const LAS pg8::u32x4*)(T + tid * 8);
            s0 = g256 * s0 + kv[c].x; s1 = g256 * s1 + kv[c].y;
            __syncthreads();
        }
    }
}
typedef at::BlockRef<at::bf16, at::bf16> ARef;
template <int MODE> __device__ __forceinline__ ARef attn_ref(const Args& a, int L, int pass) {
    const int bh = L >> 4, x = L & 15, qb = pass ? 31 - x : x, b = bh >> 3, h = bh & 7;
    const at::bf16* q = (const at::bf16*)(a.ws + W::QKV) + (MODE ? 3 * QKV_ELEMS : 0); ARef r;
    r.Q = q + ((size_t)bh * 8192 + qb * 256) * 128; r.K = q + QKV_ELEMS + (size_t)bh * 8192 * 128; r.V = q + 2 * QKV_ELEMS + (size_t)bh * 8192 * 128;
    r.O = (at::bf16*)(a.ws + W::MIX) + ((size_t)(b * 8192 + qb * 256)) * 2048 + (MODE ? 1024 : 0) + h * 128; r.P0 = qb * 256; r.bh = bh; r.jlo = MODE ? 0 : ((const int*)(a.ws + W::JLO))[bh * 32 + qb];
    if (MODE) r.jlo = 4 * qb;
    return r;
}
template <int MODE> __device__ __forceinline__ void attn_stream(const Args& a, char* lds, int G) {
    int L = blockIdx.x; if (L >= 256) return;
    int pass = 0; ARef cur = attn_ref<MODE>(a, L, 0);
    const at::Extra<at::bf16> X{(const float*)(a.ws + W::BIAS), (const at::bf16*)(a.ws + W::QKV) + 6 * QKV_ELEMS, a.in[9], (const at::bf16*)(a.ws + W::ST)};
    at::Seam<at::bf16> S;
    at::causal_swa_prime<at::bf16, at::bf16>(cur, at::WBIG, lds, S);
    for (;;) {
        const bool more_pass = pass == 0, more_item = L + G < 256, last = !more_pass && !more_item;
        int Ln = L, passn = 1; if (!more_pass) { passn = 0; Ln = more_item ? L + G : L; }
        const ARef nr = last ? cur : attn_ref<MODE>(a, Ln, passn);
        const at::NextRef<at::bf16> nxt{nr.Q, nr.K, nr.V, nr.jlo};
        at::causal_swa_block<MODE, at::bf16, at::bf16>(cur, nxt, X, 8192, at::WBIG, lds, S);
        if (last) break;
        cur = attn_ref<MODE>(a, Ln, passn); L = Ln; pass = passn;
    }
}


struct EpiX1 {
    static constexpr bool PERM = false, AFTER_DRAIN = false;
    const float* x; const float* mod; float* out;
    __device__ __forceinline__ void operator()(const pg8::f32x4 (&acc)[2][2][4][2], const pg8::Unit& u, int wr, int wc, int fr, int fq) const {
        using pg8::f32x4;
        const int row0 = u.pm * 256 + wr * 64 + fr, b = row0 >> 13, col0 = u.pn * 256 + wc * 32 + 4 * fq;
        f32x4 g[2][2];
#pragma unroll
        for (int bj = 0; bj < 2; ++bj)
#pragma unroll
            for (int n = 0; n < 2; ++n) g[bj][n] = *(const f32x4*)(mod + b * 12288 + 4096 + col0 + bj * 128 + n * 16);
#pragma unroll
        for (int ai = 0; ai < 2; ++ai)
#pragma unroll
            for (int m = 0; m < 4; ++m) { const size_t off = (size_t)(row0 + ai * 128 + m * 16) * 2048 + col0;
#pragma unroll
                for (int bj = 0; bj < 2; ++bj)
#pragma unroll
                    for (int n = 0; n < 2; ++n) { const f32x4 xv = *(const f32x4*)(x + off + bj * 128 + n * 16); *(f32x4*)(out + off + bj * 128 + n * 16) = xv + g[bj][n] * acc[ai][bj][m][n]; }
                if (m & 1) asm volatile("" ::: "memory"); }
    }
};

__device__ __forceinline__ void router_tables(const Args& a, LAS unsigned char* lds, int b) {
    const int tid = threadIdx.x, lane = tid & 63, wave = __builtin_amdgcn_readfirstlane(tid >> 6);
    const float* norm2_w = a.in[11]; const float* w_coarse = a.in[12]; const float* b_coarse = a.in[13]; const float* w_fine = a.in[14]; const float* b_fine = a.in[15];
    const float* mod = (const float*)(a.ws + W::MOD) + b * 12288; float* tab = (float*)(a.ws + W::A2S2);
    LAS float* S2 = (LAS float*)(lds + RING_OFF); LAS float* RD = S2 + 2048;
    for (int cc = tid; cc < 2048; cc += 512) { const float sv = mod[6144 + cc]; tab[b * 2048 + cc] = norm2_w[cc] * (1.f + mod[8192 + cc]); tab[4096 + b * 2048 + cc] = sv; S2[cc] = sv; }
    __syncthreads();
    for (int c0 = 0; c0 < 36; c0 += 4) { float part[4] = {0.f, 0.f, 0.f, 0.f};
#pragma unroll
        for (int q = 0; q < 4; ++q) { const int k = tid * 4 + q; const float sv = S2[k];
            const float4 wv = c0 == 0 ? *(const float4*)(w_coarse + (size_t)k * 4) : *(const float4*)(w_fine + ((size_t)((c0 - 4) >> 3) * 2048 + k) * 8 + ((c0 - 4) & 7));
            part[0] += sv * wv.x; part[1] += sv * wv.y; part[2] += sv * wv.z; part[3] += sv * wv.w; }
#pragma unroll
        for (int i = 0; i < 4; ++i) { const float t = wave_sum(part[i]); if (lane == 0) RD[(c0 + i) * 8 + wave] = t; } }
    __syncthreads();
    if (tid < 36) { float t = tid < 4 ? b_coarse[tid] : b_fine[tid - 4];
        for (int w = 0; w < 8; ++w) t += RD[tid * 8 + w];
        tab[8192 + b * 64 + tid] = t; }
    __syncthreads();
}
typedef short bfx8 __attribute__((ext_vector_type(8)));
__device__ __forceinline__ void split8(const float* v, bfx8& h, bfx8& l) {
    unsigned hw[4], lw[4];
#pragma unroll
    for (int i = 0; i < 4; ++i) { const unsigned h0 = f2bf(v[2 * i]), h1 = f2bf(v[2 * i + 1]); hw[i] = h0 | (h1 << 16);
        const float r0 = v[2 * i] - __uint_as_float(h0 << 16), r1 = v[2 * i + 1] - __uint_as_float(h1 << 16); lw[i] = f2bf(r0) | (f2bf(r1) << 16); }
    typedef unsigned u4 __attribute__((ext_vector_type(4)));
    const u4 hv = {hw[0], hw[1], hw[2], hw[3]}, lv = {lw[0], lw[1], lw[2], lw[3]};
    h = __builtin_bit_cast(bfx8, hv); l = __builtin_bit_cast(bfx8, lv);
}
__device__ __forceinline__ void ph5(const Args& a, LAS unsigned char* lds, int G) {
    using pg8::f32x4;
    const int tid = threadIdx.x, lane = tid & 63, wave = __builtin_amdgcn_readfirstlane(tid >> 6), fr = lane & 15, fq = lane >> 4;
    unsigned char* ws = a.ws; const float* x1 = a.out; bf16_t* h2 = (bf16_t*)(ws + W::H2);
    const float* tab = (const float*)(ws + W::A2S2);
    int* r_eid = (int*)(ws + W::ROUTE); float* r_gate = (float*)(ws + W::ROUTE + 128 * 1024); int* r_idx = (int*)(ws + W::ROUTE + 256 * 1024); int* cnt = (int*)(ws + W::CTL) + CW_CNT;
    constexpr int XP = 2052;
    LAS float* XT = (LAS float*)(lds + RING_OFF); LAS float* PART = XT + 16 * XP; LAS float* RS = PART + 8 * 16 * 36; LAS float* LG = RS + 16; LAS int* CH = (LAS int*)(LG + 16 * 36); LAS int* LC = CH + 128; LAS int* LB = LC + 32;
    const bfx8* wfr = (const bfx8*)(ws + W::WFR) + (size_t)(wave * 8) * 6 * 64;
    int T = blockIdx.x * 4; if (T >= 1024) return;
    f32x4 xn[16];
#define RT_LOAD(TT) do { _Pragma("unroll") for (int q = 0; q < 2; ++q) _Pragma("unroll") for (int j = 0; j < 8; ++j) \
        xn[q * 8 + j] = *(const f32x4*)(x1 + (size_t)((TT) * 16 + 2 * wave + q) * 2048 + j * 256 + lane * 4); } while (0)
    RT_LOAD(T);
    for (;;) {
        const int r0 = T * 16, b = r0 >> 13;
#pragma unroll
        for (int q = 0; q < 2; ++q) { const int rl = 2 * wave + q; float ss = 0.f;
#pragma unroll
            for (int j = 0; j < 8; ++j) { const f32x4 v = xn[q * 8 + j]; ss += (v[0] * v[0] + v[1] * v[1]) + (v[2] * v[2] + v[3] * v[3]); *(LAS f32x4*)(XT + rl * XP + j * 256 + lane * 4) = v; }
            ss = wave_sum(ss); if (lane == 0) RS[rl] = rsqrtf(ss * (1.f / 2048.f) + 1e-6f); }
        __syncthreads();
        const int Tn = (T & 3) < 3 ? T + 1 : T - 3 + 4 * G; const bool has_next = Tn < 1024;
        if (has_next) RT_LOAD(Tn);
        f32x4 acc[3] = {{0.f, 0.f, 0.f, 0.f}, {0.f, 0.f, 0.f, 0.f}, {0.f, 0.f, 0.f, 0.f}};
        unsigned ln = lane; asm volatile("" : "+v"(ln));
#pragma unroll 2
        for (int ks = 0; ks < 8; ++ks) { const int k = 256 * wave + 32 * ks + 8 * fq;
            const f32x4 v0 = *(const LAS f32x4*)(XT + fr * XP + k), v1 = *(const LAS f32x4*)(XT + fr * XP + k + 4);
            const f32x4 a0 = *(const f32x4*)(tab + b * 2048 + k), a1 = *(const f32x4*)(tab + b * 2048 + k + 4);
            const float av[8] = {v0[0] * a0[0], v0[1] * a0[1], v0[2] * a0[2], v0[3] * a0[3], v1[0] * a1[0], v1[1] * a1[1], v1[2] * a1[2], v1[3] * a1[3]};
            bfx8 ah, al; split8(av, ah, al);
#pragma unroll
            for (int ob = 0; ob < 3; ++ob) { const bfx8 bh = (wfr + ((ks * 3 + ob) * 2) * 64)[ln], bl = (wfr + ((ks * 3 + ob) * 2 + 1) * 64)[ln];
                acc[ob] = __builtin_amdgcn_mfma_f32_16x16x32_bf16(ah, bh, acc[ob], 0, 0, 0);
                acc[ob] = __builtin_amdgcn_mfma_f32_16x16x32_bf16(al, bh, acc[ob], 0, 0, 0);
                acc[ob] = __builtin_amdgcn_mfma_f32_16x16x32_bf16(ah, bl, acc[ob], 0, 0, 0); } }
#pragma unroll
        for (int ob = 0; ob < 3; ++ob) { const int o = ob * 16 + fr;
            if (o < 36) {
#pragma unroll
                for (int r = 0; r < 4; ++r) PART[(wave * 16 + 4 * fq + r) * 36 + o] = acc[ob][r]; } }
        __syncthreads();
        for (int it = tid; it < 576; it += 512) { const int rl = it / 36, o = it - rl * 36; float t = 0.f;
#pragma unroll
            for (int w = 0; w < 8; ++w) t += PART[(w * 16 + rl) * 36 + o];
            LG[it] = RS[rl] * t + tab[8192 + b * 64 + o]; }
        __syncthreads();
        if (tid < 16) { const int row = r0 + tid; const LAS float* lg = LG + tid * 36;
            int gs = 0; float cmax = lg[0];
#pragma unroll
            for (int g = 1; g < 4; ++g) if (lg[g] > cmax) { cmax = lg[g]; gs = g; }
            float den = 0.f;
#pragma unroll
            for (int g = 0; g < 4; ++g) den += expf(lg[g] - cmax);
            const float pg = 1.f / den;
            float f0 = -3.0e38f, f1 = -3.0e38f; int e0 = 0, e1 = 0;
#pragma unroll
            for (int e = 0; e < 8; ++e) { const float fl = lg[4 + gs * 8 + e];
                if (fl > f0) { f1 = f0; e1 = e0; f0 = fl; e0 = e; } else if (fl > f1) { f1 = fl; e1 = e; } }
            const float t1 = expf(f1 - f0); const float g0 = pg / (1.f + t1), g1 = pg * t1 / (1.f + t1);
            const int E0 = gs * 8 + e0, E1 = gs * 8 + e1;
            r_eid[2 * row] = E0; r_eid[2 * row + 1] = E1; r_gate[2 * row] = g0; r_gate[2 * row + 1] = g1;
            CH[((T & 3) * 16 + tid) * 2] = E0; CH[((T & 3) * 16 + tid) * 2 + 1] = E1; }
#pragma unroll
        for (int q = 0; q < 2; ++q) { const int rl = 2 * wave + q; const float rstd = RS[rl]; bf16_t* hrow = h2 + (size_t)(r0 + rl) * 2048;
#pragma unroll
            for (int j = 0; j < 8; ++j) { const int c = j * 256 + lane * 4; const f32x4 xv = *(const LAS f32x4*)(XT + rl * XP + c);
                const f32x4 aa = *(const f32x4*)(tab + b * 2048 + c), sv = *(const f32x4*)(tab + 4096 + b * 2048 + c);
                uint2 pk; pk.x = pk2(xv[0] * rstd * aa[0] + sv[0], xv[1] * rstd * aa[1] + sv[1]); pk.y = pk2(xv[2] * rstd * aa[2] + sv[2], xv[3] * rstd * aa[3] + sv[3]);
                *(uint2*)(hrow + c) = pk; } }
        __syncthreads();
        if ((T & 3) == 3) {
            if (tid < 32) LC[tid] = 0;
            __syncthreads();
            int rk = 0, ee = 0;
            if (tid < 128) { ee = CH[tid]; rk = atomicAdd((int*)(LC + ee), 1); }
            __syncthreads();
            if (tid < 32) { const int n = LC[tid]; LB[tid] = n ? atomicAdd(cnt + tid * CNT_STRIDE, n) : 0; }
            __syncthreads();
            if (tid < 128) r_idx[(size_t)(T >> 2) * 128 + tid] = LB[ee] + rk;
            __syncthreads();
        }
        if (!has_next) break;
        T = Tn;
    }
#undef RT_LOAD
}
__device__ __forceinline__ void ph6(const Args& a, LAS unsigned char* lds, int G) {
    const int tid = threadIdx.x, lane = tid & 63, wave = __builtin_amdgcn_readfirstlane(tid >> 6);
    unsigned char* ws = a.ws;
    const int* cnt = (const int*)(ws + W::CTL) + CW_CNT; int* pstart_g = (int*)(ws + W::TILE); int* tile_e = pstart_g + 64; int* ntile = pstart_g + 512;
    const int* r_eid = (const int*)(ws + W::ROUTE); const int* r_idx = (const int*)(ws + W::ROUTE + 256 * 1024); int* r_slot = (int*)(ws + W::ROUTE + 384 * 1024);
    LAS int* ps = (LAS int*)(lds + RING_OFF);
    if (tid == 0) { int p = 0, t = 0;
        for (int e = 0; e < 32; ++e) { ps[e] = p; const int n = (cnt[e * CNT_STRIDE] + 255) >> 8; if (blockIdx.x == 0) { pstart_g[e] = p; for (int i = 0; i < n; ++i) tile_e[t + i] = e; } t += n; p += n * 256; }
        ps[32] = p; if (blockIdx.x == 0) { pstart_g[32] = p; *ntile = t; } }
    __syncthreads();
    const bf16_t* h2 = (const bf16_t*)(ws + W::H2); bf16_t* xs = (bf16_t*)(ws + W::XS);
    for (int mk = blockIdx.x * NWAVES + wave; mk < 2 * M_TOK; mk += G * NWAVES) {
        const int slot = ps[r_eid[mk]] + r_idx[mk]; if (lane == 0) r_slot[mk] = slot;
        const uint4* src = (const uint4*)(h2 + (size_t)(mk >> 1) * 2048) + lane; uint4* dst = (uint4*)(xs + (size_t)slot * 2048) + lane;
        uint4 v[4];
#pragma unroll
        for (int j = 0; j < 4; ++j) v[j] = src[64 * j];
#pragma unroll
        for (int j = 0; j < 4; ++j) dst[64 * j] = v[j];
    }
    __syncthreads();
}
template <int LOG2_NN> struct GroupedOrder {
    const int* tile_e; int nunits, G, c;
    __device__ void init(const int* tile_e_, const int* ntile, int G_, int c_) { tile_e = tile_e_; nunits = *ntile << LOG2_NN; G = G_; c = c_; }
    __device__ bool next(int i, pg8::Unit& u) const { const int L = i * G + c; if (L >= nunits) return false; u.pm = L >> LOG2_NN; u.pn = L & ((1 << LOG2_NN) - 1); u.e = tile_e[u.pm]; return true; }
    __device__ __forceinline__ void a_ready(const pg8::Unit&) const {}
    __device__ __forceinline__ void done(const pg8::Unit&) const {}
};
struct EpiUp {
    static constexpr bool PERM = true, AFTER_DRAIN = false;
    bf16_t* act;
    __device__ __forceinline__ void operator()(const pg8::f32x4 (&acc)[2][2][4][2], const pg8::Unit& u, int wr, int wc, int fr, int fq) const {
        using pg8::f32x4;
        const int row0 = u.pm * 256 + wr * 64 + fr, col0 = u.pn * 128 + wc * 16 + 4 * fq;
#pragma unroll
        for (int ai = 0; ai < 2; ++ai)
#pragma unroll
            for (int m = 0; m < 4; ++m) { bf16_t* rowp = act + (size_t)(row0 + ai * 128 + m * 16) * 512 + col0;
#pragma unroll
                for (int bj = 0; bj < 2; ++bj) { const f32x4 av = acc[ai][bj][m][0], bv = acc[ai][bj][m][1]; float o[4];
#pragma unroll
                    for (int e = 0; e < 4; ++e) o[e] = av[e] * __builtin_amdgcn_rcpf(1.f + __expf(-av[e])) * bv[e];
                    uint2 w; w.x = pg8::cvt_pk_bf16(o[0], o[1]); w.y = pg8::cvt_pk_bf16(o[2], o[3]);
                    *(uint2*)(rowp + bj * 64) = w; } }
    }
};
__device__ __forceinline__ void ph9(const Args& a, int G) {
    const int tid = threadIdx.x, lane = tid & 63, wave = __builtin_amdgcn_readfirstlane(tid >> 6);
    unsigned char* ws = a.ws; float* out = a.out;
    const float* mod = (const float*)(ws + W::MOD); const bf16_t* y = (const bf16_t*)(ws + W::Y);
    const float* r_gate = (const float*)(ws + W::ROUTE + 128 * 1024); const int* r_slot = (const int*)(ws + W::ROUTE + 384 * 1024);
    int m = blockIdx.x * NWAVES + wave; if (m >= M_TOK) return;
    int s0 = r_slot[2 * m], s1 = r_slot[2 * m + 1]; float g0 = r_gate[2 * m], g1 = r_gate[2 * m + 1];
    for (;;) {
        const int mn = m + G * NWAVES; const bool more = mn < M_TOK; const int mq = more ? mn : m;
        const int s0n = r_slot[2 * mq], s1n = r_slot[2 * mq + 1]; const float g0n = r_gate[2 * mq], g1n = r_gate[2 * mq + 1];
        const float* g2 = mod + (m >> 13) * 12288 + 10240;
#pragma unroll
        for (int j = 0; j < 4; ++j) { const int c = j * 512 + lane * 8;
            const pg8::u32x4 ya = *(const pg8::u32x4*)(y + (size_t)s0 * 2048 + c), yb = *(const pg8::u32x4*)(y + (size_t)s1 * 2048 + c);
            const pg8::f32x4 x0 = *(const pg8::f32x4*)(out + (size_t)m * 2048 + c), x1v = *(const pg8::f32x4*)(out + (size_t)m * 2048 + c + 4);
            const pg8::f32x4 ga = *(const pg8::f32x4*)(g2 + c), gb = *(const pg8::f32x4*)(g2 + c + 4);
            pg8::f32x4 o0, o1;
#pragma unroll
            for (int e = 0; e < 2; ++e) { o0[2 * e] = x0[2 * e] + ga[2 * e] * (g0 * __uint_as_float(ya[e] << 16) + g1 * __uint_as_float(yb[e] << 16));
                o0[2 * e + 1] = x0[2 * e + 1] + ga[2 * e + 1] * (g0 * __uint_as_float(ya[e] & 0xffff0000u) + g1 * __uint_as_float(yb[e] & 0xffff0000u));
                o1[2 * e] = x1v[2 * e] + gb[2 * e] * (g0 * __uint_as_float(ya[2 + e] << 16) + g1 * __uint_as_float(yb[2 + e] << 16));
                o1[2 * e + 1] = x1v[2 * e + 1] + gb[2 * e + 1] * (g0 * __uint_as_float(ya[2 + e] & 0xffff0000u) + g1 * __uint_as_float(yb[2 + e] & 0xffff0000u)); }
            *(pg8::f32x4*)(out + (size_t)m * 2048 + c) = o0; *(pg8::f32x4*)(out + (size_t)m * 2048 + c + 4) = o1; }
        if (!more) break;
        m = mn; s0 = s0n; s1 = s1n; g0 = g0n; g1 = g1n;
    }
}

__global__ void __launch_bounds__(NWAVES * 64, 2) mk_fwd(Args args) {
    extern __shared__ __attribute__((aligned(16))) unsigned char lds_raw[];
    LAS unsigned char* lds = (LAS unsigned char*)lds_raw;
    volatile LAS unsigned* MISC = (volatile LAS unsigned*)(lds + MISC_OFF);
    const int tid = threadIdx.x, G = gridDim.x;
    unsigned char* ws = args.ws; gu32* ctl = (gu32*)(ws + W::CTL);
    for (int u = tid; u < (LDS_BYTES - MISC_OFF) / 4; u += NWAVES * 64) ((LAS unsigned*)(lds + MISC_OFF))[u] = 0u;
    __syncthreads();
    const int lo = args.ph_lo, hi = args.ph_hi;
    XcdBarrier bar; bar.bar = (unsigned*)(ctl + CW_BAR) + args.li * XCD_BAR_WORDS; bar.x = 0; bar.st = nullptr;
    if (hi - lo > 1) bar = xcd_barrier_post((unsigned*)(ctl + CW_BAR) + args.li * XCD_BAR_WORDS, MISC + 8);
#define IN(k) (lo <= (k) && (k) < hi)
#define BOTH(k) (IN(k) && IN((k) + 1))
    if (IN(0)) { ph0(args, lds, G); if (BOTH(0)) xcd_barrier(bar); }
    if (IN(1)) { ph1(args, lds, G); if (BOTH(1)) xcd_barrier(bar); }
    if (IN(2)) {
        for (int bh = blockIdx.x; bh < 16; bh += G) cumsum_bh(args, lds, bh);
        for (int b = (int)blockIdx.x - 16; b < 2; b += G) if (b >= 0) router_tables(args, lds, b);
        pg8::Gemm g{(const bf16_t*)(ws + W::XN), (const bf16_t*)(ws + W::WT_IN), M_TOK, 7168, 2048, 0};
        pg8::StaticOrder S; S.init(M_TOK, 7168, G, (int)blockIdx.x);
        EpiZ E{(bf16_t*)(ws + W::QKV), args.in[7], args.in[8], (const float*)(ws + W::ROPE), (PG8_LAS float*)(lds + XCH_OFF)};
        pg8::gemm_phase<EpiZ, pg8::StaticOrder, true, true>(lds + RING_OFF, g, S, E);
        if (BOTH(2)) xcd_barrier(bar);
    }
    if (IN(3)) { kv_units(args, (char*)lds_raw + RING_OFF, G); attn_stream<0>(args, (char*)lds_raw + RING_OFF, G); if (BOTH(3)) xcd_barrier(bar); }
    if (IN(4)) { scan_units(args, lds, G); if (BOTH(4)) xcd_barrier(bar); }
    if (IN(5)) { attn_stream<1>(args, (char*)lds_raw + RING_OFF, G); if (BOTH(5)) xcd_barrier(bar); }
    if (IN(6)) {
        pg8::Gemm g{(const bf16_t*)(ws + W::MIX), (const bf16_t*)(ws + W::WT_OUT), M_TOK, 2048, 2048, 0};
        pg8::StaticOrder S; S.init(M_TOK, 2048, G, (int)blockIdx.x);
        EpiX1 E{args.in[0], (const float*)(ws + W::MOD), args.out};
        pg8::gemm_phase<EpiX1, pg8::StaticOrder, true, true>(lds + RING_OFF, g, S, E);
        if (BOTH(6)) xcd_barrier(bar);
    }
    if (IN(7)) { ph5(args, lds, G); if (BOTH(7)) xcd_barrier(bar); }
    if (IN(8)) { ph6(args, lds, G); if (BOTH(8)) xcd_barrier(bar); }
    if (IN(9)) {
        pg8::Gemm g{(const bf16_t*)(ws + W::XS), (const bf16_t*)(ws + W::WT_13), 0, 1024, 2048, (size_t)1024 * 2048 * 2};
        GroupedOrder<2> S; S.init((const int*)(ws + W::TILE) + 64, (const int*)(ws + W::TILE) + 512, G, (int)blockIdx.x);
        EpiUp E{(bf16_t*)(ws + W::ACT)};
        pg8::gemm_phase<EpiUp, GroupedOrder<2>, true, true>(lds + RING_OFF, g, S, E);
        if (BOTH(9)) xcd_barrier(bar);
    }
    if (IN(10)) {
        pg8::Gemm g{(const bf16_t*)(ws + W::ACT), (const bf16_t*)(ws + W::WT_2), 0, 2048, 512, (size_t)2048 * 512 * 2};
        GroupedOrder<3> S; S.init((const int*)(ws + W::TILE) + 64, (const int*)(ws + W::TILE) + 512, G, (int)blockIdx.x);
        pg8::EpiBf16<0> E{(bf16_t*)(ws + W::Y), 2048, nullptr, 0, 0, 1.f};
        pg8::gemm_phase<pg8::EpiBf16<0>, GroupedOrder<3>, true, true>(lds + RING_OFF, g, S, E);
        if (BOTH(10)) xcd_barrier(bar);
    }
    if (IN(11)) ph9(args, G);
#undef IN
#undef BOTH
}
extern "C" void kernel_launch(void* const* d_in, const int* in_sizes, int n_in, void* d_out, int out_size, void* d_ws, size_t ws_size, hipStream_t stream) {
    static int grid = 0;
    if (grid == 0) {
        if (n_in != 19 || out_size != M_TOK * DM || ws_size < W::END) { fprintf(stderr, "kernel_launch: built for 19 inputs, %d outputs, >= %zu bytes of workspace; got %d, %d, %zu\n", M_TOK * DM, (size_t)W::END, n_in, out_size, ws_size); grid = -1; return; }
        int dev = 0, cus = 0, per_cu = 0;
        if (hipGetDevice(&dev) != hipSuccess || hipDeviceGetAttribute(&cus, hipDeviceAttributeMultiprocessorCount, dev) != hipSuccess) { fprintf(stderr, "kernel_launch: device query failed\n"); grid = -1; return; }
        if (hipFuncSetAttribute((const void*)mk_fwd, hipFuncAttributeMaxDynamicSharedMemorySize, LDS_BYTES) != hipSuccess) { fprintf(stderr, "kernel_launch: hipFuncSetAttribute failed\n"); grid = -1; return; }
        if (hipOccupancyMaxActiveBlocksPerMultiprocessor(&per_cu, (const void*)mk_fwd, NWAVES * 64, LDS_BYTES) != hipSuccess || per_cu < 1) { fprintf(stderr, "kernel_launch: occupancy query says %d workgroups per CU\n", per_cu); (void)hipGetLastError(); grid = -1; return; }
        grid = cus;
    }
    if (grid < 0) return;
    (void)hipMemsetAsync((char*)d_ws + W::CTL, 0, W::CTL_ZERO_BYTES, stream);
    Args a{};
    for (int i = 0; i < 19; ++i) a.in[i] = (const float*)d_in[i];
    a.out = (float*)d_out; a.ws = (unsigned char*)d_ws; a.ph_lo = 0; a.ph_hi = 12; a.li = 0;
    hipLaunchKernelGGL(mk_fwd, dim3(grid), dim3(NWAVES * 64), LDS_BYTES, stream, a);
}
```

```cpp
#include <hip/hip_runtime.h>
#include <cstdio>
#include <cstdint>
typedef unsigned short bf16_t;
__device__ __forceinline__ float bf2f(bf16_t v) { return __uint_as_float(((unsigned)v) << 16); }
__device__ __forceinline__ unsigned f2bf(float f) { const unsigned u = __float_as_uint(f); return (u + 0x7fffu + ((u >> 16) & 1u)) >> 16; }

constexpr size_t MiB = 1u << 20;
constexpr int M_TOK = 16384, SEQ = 8192, DM = 2048;
constexpr size_t QKV_ELEMS = (size_t)16 * 8192 * 128;
namespace pg8 {
#define PG8_LAS __attribute__((address_space(3)))
typedef short bf16x8 __attribute__((ext_vector_type(8)));
typedef float f32x4 __attribute__((ext_vector_type(4)));
typedef unsigned u32x4 __attribute__((ext_vector_type(4)));
constexpr int BM = 256, BK = 64, HALF = 128, HTB = HALF * BK * 2  , STAGE_BYTES = 8 * HTB, NXCD = 8, WGM = 8;

__host__ __device__ __forceinline__ int lds_byte(int r, int c) { const int st = (r >> 4) * 2 + (c >> 5), rr = r & 15, cc = c & 31, ob = rr * 64 + cc * 2; return st * 1024 + (ob ^ (((ob >> 9) & 1) << 5)); }
__host__ __device__ __forceinline__ void stage_rc(int b, int& R, int& C) { const int st = b / 1024, sb = b % 1024, swz = sb ^ (((sb >> 9) & 1) << 5); R = (st >> 1) * 16 + swz / 64; C = (st & 1) * 32 + (swz % 64) / 2; }
__host__ __device__ __forceinline__ int perm32(int rho) { const int n = rho >> 4, i = rho & 15; return 8 * (i >> 2) + 4 * n + (i & 3); }

struct Unit { int pm, pn, e; };
struct Gemm { const bf16_t* A; const bf16_t* Bt; int M, N, K; size_t estride; };

struct StaticOrder {
    int nM, nN, nwg, G, c;
    __host__ __device__ void init(int M, int N, int G_, int c_) { nM = M / BM; nN = N / BM; nwg = nM * nN; G = G_; c = c_; }
    __host__ __device__ bool next(int i, Unit& u) const {
        const long L = (long)i * G + c; if (L >= nwg) return false;
        int wgid = (int)L; { const int q = nwg / NXCD, r = nwg % NXCD, xcd = wgid % NXCD, off = wgid / NXCD; wgid = (xcd < r ? xcd * (q + 1) : r * (q + 1) + (xcd - r) * q) + off; }
        const int nig = WGM * nN, gid = wgid / nig, fm = gid * WGM, gsz = (nM - fm) < WGM ? (nM - fm) : WGM;
        u.pm = fm + ((wgid % nig) % gsz); u.pn = (wgid % nig) / gsz; u.e = 0; return true;
    }
    __device__ __forceinline__ void a_ready(const Unit&) const {}
    __device__ __forceinline__ void done(const Unit&) const {}
};

__device__ __forceinline__ unsigned cvt_pk_bf16(float lo, float hi) { unsigned r; asm volatile("v_cvt_pk_bf16_f32 %0, %1, %2" : "=v"(r) : "v"(lo), "v"(hi)); return r; }
typedef float f32x2 __attribute__((ext_vector_type(2)));
__device__ __forceinline__ f32x2 gelu_pk(f32x2 v) {
    const f32x2 av = __builtin_elementwise_abs(v), d = av * 0.2316418882f + 1.0f;
    f32x2 t; t.x = __builtin_amdgcn_rcpf(d.x); t.y = __builtin_amdgcn_rcpf(d.y);
    f32x2 q = t * 0.5307027145f + (-0.7265760135f); q = q * t + 0.7107068705f; q = q * t + (-0.142248368f); q = q * t + 0.127414796f; q = q * t;
    const f32x2 s = (v * v) * (-0.72134752044f);
    f32x2 e; e.x = __builtin_amdgcn_exp2f(s.x); e.y = __builtin_amdgcn_exp2f(s.y);
    const f32x2 m = v * (q * e), r = v - m;
    f32x2 o; o.x = v.x < 0.f ? m.x : r.x; o.y = v.y < 0.f ? m.y : r.y; return o;
}

template <int ACT  > struct EpiBf16 {
    static constexpr bool PERM = true, AFTER_DRAIN = false; static_assert(ACT == 0 || ACT == 1, "EpiBf16: ACT is 0 (none) or 1 (gelu_pk)");
    bf16_t* O; int ldc; const float* bias; int split_cols; size_t split_stride; float scale0;
    __device__ __forceinline__ void operator()(const f32x4 (&acc)[2][2][4][2], const Unit& u, int wr, int wc, int fr, int fq) const {
        const int row0 = u.pm * BM + wr * 64 + fr; int colt = u.pn * BM; bf16_t* base = O;
        float sc = 1.f; if (split_cols) { const int t = colt / split_cols; base += (size_t)t * split_stride; colt -= t * split_cols; if (t == 0) sc = scale0; }
        const int col0 = colt + wc * 32 + 8 * fq, bcol0 = u.pn * BM + wc * 32 + 8 * fq;
        f32x4 bv[2][2];
#pragma unroll
        for (int bj = 0; bj < 2; ++bj)
#pragma unroll
            for (int n = 0; n < 2; ++n) bv[bj][n] = bias ? *(const f32x4*)(bias + bcol0 + bj * HALF + 4 * n) : (f32x4){0.f, 0.f, 0.f, 0.f};
#pragma unroll
        for (int ai = 0; ai < 2; ++ai)
#pragma unroll
            for (int m = 0; m < 4; ++m) { bf16_t* rowp = base + (size_t)(row0 + ai * HALF + m * 16) * ldc + col0;
#pragma unroll
                for (int bj = 0; bj < 2; ++bj) { f32x4 v0 = acc[ai][bj][m][0] + bv[bj][0], v1 = acc[ai][bj][m][1] + bv[bj][1];
                    if (ACT == 1) { f32x2 a = gelu_pk((f32x2){v0[0], v0[1]}), b = gelu_pk((f32x2){v0[2], v0[3]}), c = gelu_pk((f32x2){v1[0], v1[1]}), d = gelu_pk((f32x2){v1[2], v1[3]});
                        v0 = (f32x4){a.x, a.y, b.x, b.y}; v1 = (f32x4){c.x, c.y, d.x, d.y}; }
                    v0 = v0 * sc; v1 = v1 * sc; u32x4 w; w.x = cvt_pk_bf16(v0[0], v0[1]); w.y = cvt_pk_bf16(v0[2], v0[3]); w.z = cvt_pk_bf16(v1[0], v1[1]); w.w = cvt_pk_bf16(v1[2], v1[3]);
                    *(u32x4*)(rowp + bj * HALF) = w; } }
    }
};
template <class Epi, class Sched, bool ALIGN_EPI = false, bool SP2 = false, int ESZ = 2>
__device__ __forceinline__ void gemm_phase(PG8_LAS unsigned char* lds, const Gemm g, const Sched& S, const Epi& E) {
    const int tid = threadIdx.x, wid = __builtin_amdgcn_readfirstlane(tid >> 6), lane = tid & 63, wr = wid >> 2, wc = wid & 3, fr = lane & 15, fq = lane >> 4;
    int Kraw = g.K; asm volatile("" : "+s"(Kraw));
    const int K = ESZ == 1 ? Kraw / 2 : Kraw, nt = K / BK;
    unsigned voffA[2], voffB[2];
#pragma unroll
    for (int i = 0; i < 2; ++i) { int R, C; stage_rc(tid * 16 + i * 8192, R, C); const int Rb = Epi::PERM ? ((R & ~31) + perm32(R & 31)) : R;
        voffA[i] = (unsigned)(R * K + C) * 2u; voffB[i] = (unsigned)(Rb * K + C) * 2u; }
    const size_t kstep = (size_t)(BK * 2);
    const size_t hstep = (size_t)HALF * K * 2;
    const size_t tstep = 2 * hstep;
    const unsigned ldsw = (unsigned)wid * 1024u;
    const int aoff = lds_byte(wr * 64 + fr, fq * 8), boff = lds_byte(wc * 32 + fr, fq * 8);
#define PG8_SA(b, h) (((b) * 2 + (h)) * HTB)
#define PG8_SB(b, h) ((4 + (b) * 2 + (h)) * HTB)
#define PG8_STAGE(bufoff, gbase, voff) do { _Pragma("unroll") for (int _i = 0; _i < 2; ++_i) \
        __builtin_amdgcn_global_load_lds((const unsigned*)((const char*)(gbase) + (voff)[_i]), (PG8_LAS unsigned*)(lds + (bufoff) + ldsw + _i * 8192), 16, 0, 0); } while (0)
#define PG8_LDA(dst, b, h) do { _Pragma("unroll") for (int m = 0; m < 4; ++m) { if constexpr (ESZ == 1) dst##8[m] = __builtin_shufflevector(*(const PG8_LAS i32x4_*)(lds + PG8_SA(b, h) + aoff + m * 2048), *(const PG8_LAS i32x4_*)(lds + PG8_SA(b, h) + aoff + m * 2048 + 1024), 0, 1, 2, 3, 4, 5, 6, 7); \
        else { _Pragma("unroll") for (int k = 0; k < 2; ++k) dst[m][k] = *(const PG8_LAS bf16x8*)(lds + PG8_SA(b, h) + aoff + m * 2048 + k * 1024); } } } while (0)
#define PG8_LDB(dst, b, h) do { _Pragma("unroll") for (int n = 0; n < 2; ++n) { if constexpr (ESZ == 1) dst##8[n] = __builtin_shufflevector(*(const PG8_LAS i32x4_*)(lds + PG8_SB(b, h) + boff + n * 2048), *(const PG8_LAS i32x4_*)(lds + PG8_SB(b, h) + boff + n * 2048 + 1024), 0, 1, 2, 3, 4, 5, 6, 7); \
        else { _Pragma("unroll") for (int k = 0; k < 2; ++k) dst[n][k] = *(const PG8_LAS bf16x8*)(lds + PG8_SB(b, h) + boff + n * 2048 + k * 1024); } } } while (0)
#define PG8_MMA(ai, bj, At, Bt) do { __builtin_amdgcn_s_setprio(1); _Pragma("unroll") for (int m = 0; m < 4; ++m) _Pragma("unroll") for (int n = 0; n < 2; ++n) { \
        if constexpr (ESZ == 1) asm volatile("v_mfma_scale_f32_16x16x128_f8f6f4 %0, %1, %2, %0, %3, %3 op_sel_hi:[0,0,0]" : "+v"(acc[ai][bj][m][n]) : "v"(Bt##8[n]), "v"(At##8[m]), "v"(0x7F7F7F7F)); \
        else { _Pragma("unroll") for (int k = 0; k < 2; ++k) acc[ai][bj][m][n] = __builtin_amdgcn_mfma_f32_16x16x32_bf16(Bt[n][k], At[m][k], acc[ai][bj][m][n], 0, 0, 0); } } __builtin_amdgcn_s_setprio(0); } while (0)
#define PG8_WAIT_V(n) asm volatile("s_waitcnt vmcnt(" #n ")" ::: "memory")
#define PG8_WAIT_L(n) asm volatile("s_waitcnt lgkmcnt(" #n ")" ::: "memory")
#define PG8_BAR __builtin_amdgcn_s_barrier()
#define PG8_SCHED __builtin_amdgcn_sched_barrier(0)
    Unit cur, nxt; int ui = 0;
    if (!S.next(0, cur)) return;
    f32x4 acc[2][2][4][2];
#pragma unroll
    for (int a = 0; a < 2; ++a)
#pragma unroll
        for (int b = 0; b < 2; ++b)
#pragma unroll
            for (int m = 0; m < 4; ++m)
#pragma unroll
                for (int n = 0; n < 2; ++n) acc[a][b][m][n] = (f32x4){0.f, 0.f, 0.f, 0.f};
    typedef int i32x4_ __attribute__((ext_vector_type(4))); typedef int i32x8_ __attribute__((ext_vector_type(8)));
    bf16x8 At[4][2], B0[2][2], B1[2][2]; i32x8_ At8[4], B08[2], B18[2];
    const char* cA = (const char*)g.A + (size_t)cur.pm * tstep; const char* cB = (const char*)g.Bt + (size_t)cur.pn * tstep + (size_t)cur.e * g.estride;
    S.a_ready(cur);
    if constexpr (SP2) {
        PG8_STAGE(PG8_SB(0, 0), cB, voffB); PG8_STAGE(PG8_SB(0, 1), cB + hstep, voffB); PG8_STAGE(PG8_SA(0, 0), cA, voffA); PG8_STAGE(PG8_SA(0, 1), cA + hstep, voffA);
        if (wr == 1) PG8_BAR;
        PG8_WAIT_V(2); PG8_BAR;
        PG8_STAGE(PG8_SB(1, 0), cB + kstep, voffB); PG8_STAGE(PG8_SA(1, 0), cA + kstep, voffA); PG8_STAGE(PG8_SB(1, 1), cB + hstep + kstep, voffB);
        PG8_WAIT_V(6); PG8_BAR;
    } else {
        PG8_STAGE(PG8_SB(0, 0), cB, voffB); PG8_STAGE(PG8_SA(0, 0), cA, voffA); PG8_STAGE(PG8_SB(0, 1), cB + hstep, voffB); PG8_STAGE(PG8_SA(0, 1), cA + hstep, voffA);
        if (wr == 1) PG8_BAR;
        PG8_WAIT_V(4); PG8_BAR;
        PG8_STAGE(PG8_SB(1, 0), cB + kstep, voffB); PG8_STAGE(PG8_SA(1, 0), cA + kstep, voffA); PG8_STAGE(PG8_SB(1, 1), cB + hstep + kstep, voffB);
        PG8_WAIT_V(6); PG8_BAR;
    }
    for (;;) {
        const bool has_next = S.next(ui + 1, nxt);
        const char* nA = has_next ? (const char*)g.A + (size_t)nxt.pm * tstep : cA; const char* nB = has_next ? (const char*)g.Bt + (size_t)nxt.pn * tstep + (size_t)nxt.e * g.estride : cB;
        for (int t = 0; t < nt; t += 2) {
            const bool last = (t == nt - 2);
            const char* a1 = cA + (size_t)(t + 1) * kstep;
            const char* a2 = last ? nA : cA + (size_t)(t + 2) * kstep; const char* b2 = last ? nB : cB + (size_t)(t + 2) * kstep;
            const char* a3 = a2 + kstep; const char* b3 = b2 + kstep;
            if (last && has_next) S.a_ready(nxt);
            if constexpr (SP2) {
            PG8_LDB(B0, 0, 0); PG8_LDB(B1, 0, 1); PG8_SCHED; PG8_LDA(At, 0, 0); PG8_STAGE(PG8_SA(1, 1), a1 + hstep, voffA);
            PG8_WAIT_V(8); PG8_WAIT_L(0); PG8_BAR; PG8_MMA(0, 0, At, B0); PG8_MMA(0, 1, At, B1); PG8_BAR; PG8_SCHED;
            PG8_LDA(At, 0, 1); PG8_STAGE(PG8_SB(0, 0), b2, voffB); PG8_STAGE(PG8_SB(0, 1), b2 + hstep, voffB); PG8_STAGE(PG8_SA(0, 0), a2, voffA);
            PG8_WAIT_V(8); PG8_WAIT_L(0); PG8_BAR; PG8_MMA(1, 0, At, B0); PG8_MMA(1, 1, At, B1); PG8_BAR; PG8_SCHED;
            PG8_LDB(B0, 1, 0); PG8_LDB(B1, 1, 1); PG8_SCHED; PG8_LDA(At, 1, 0); PG8_STAGE(PG8_SA(0, 1), a2 + hstep, voffA);
            PG8_WAIT_V(8); PG8_WAIT_L(0); PG8_BAR; PG8_MMA(0, 0, At, B0); PG8_MMA(0, 1, At, B1); PG8_BAR; PG8_SCHED;
            PG8_LDA(At, 1, 1); PG8_STAGE(PG8_SB(1, 0), b3, voffB); PG8_STAGE(PG8_SB(1, 1), b3 + hstep, voffB); PG8_STAGE(PG8_SA(1, 0), a3, voffA);
            PG8_WAIT_V(8); PG8_WAIT_L(0); PG8_BAR; PG8_MMA(1, 0, At, B0); PG8_MMA(1, 1, At, B1); PG8_BAR; PG8_SCHED;
            } else {
            PG8_LDB(B0, 0, 0); PG8_SCHED; PG8_LDA(At, 0, 0); PG8_STAGE(PG8_SA(1, 1), a1 + hstep, voffA);
            PG8_WAIT_L(8); PG8_BAR; PG8_WAIT_L(0); PG8_MMA(0, 0, At, B0); PG8_BAR; PG8_SCHED;
            PG8_LDB(B1, 0, 1); PG8_STAGE(PG8_SB(0, 0), b2, voffB);
            PG8_BAR; PG8_WAIT_L(0); PG8_MMA(0, 1, At, B1); PG8_BAR;
            PG8_LDA(At, 0, 1); PG8_STAGE(PG8_SA(0, 0), a2, voffA);
            PG8_BAR; PG8_WAIT_L(0); PG8_MMA(1, 0, At, B0); PG8_BAR; PG8_SCHED;
            PG8_STAGE(PG8_SB(0, 1), b2 + hstep, voffB);
            PG8_WAIT_V(6); PG8_BAR; PG8_MMA(1, 1, At, B1); PG8_BAR;
            PG8_LDB(B0, 1, 0); PG8_SCHED; PG8_LDA(At, 1, 0); PG8_STAGE(PG8_SA(0, 1), a2 + hstep, voffA);
            PG8_WAIT_L(8); PG8_BAR; PG8_WAIT_L(0); PG8_MMA(0, 0, At, B0); PG8_BAR; PG8_SCHED;
            PG8_LDB(B1, 1, 1); PG8_STAGE(PG8_SB(1, 0), b3, voffB);
            PG8_BAR; PG8_WAIT_L(0); PG8_MMA(0, 1, At, B1); PG8_BAR;
            PG8_LDA(At, 1, 1); PG8_STAGE(PG8_SA(1, 0), a3, voffA);
            PG8_BAR; PG8_WAIT_L(0); PG8_MMA(1, 0, At, B0); PG8_BAR; PG8_SCHED;
            PG8_STAGE(PG8_SB(1, 1), b3 + hstep, voffB);
            PG8_WAIT_V(6); PG8_BAR; PG8_MMA(1, 1, At, B1); PG8_BAR;
            }
        }
        if constexpr (ALIGN_EPI) { if (wr == 0) PG8_BAR; }
        if constexpr (ESZ == 1) asm volatile("s_nop 15\n\ts_nop 15" ::: "memory");
        if constexpr (!Epi::AFTER_DRAIN) { int t2_ = threadIdx.x; asm volatile("" : "+v"(t2_)); E(acc, cur, wr, wc, t2_ & 15, (t2_ >> 4) & 3); S.done(cur); }
        if (!has_next) break;
#pragma unroll
        for (int a = 0; a < 2; ++a)
#pragma unroll
            for (int b = 0; b < 2; ++b)
#pragma unroll
                for (int m = 0; m < 4; ++m)
#pragma unroll
                    for (int n = 0; n < 2; ++n) acc[a][b][m][n] = (f32x4){0.f, 0.f, 0.f, 0.f};
        cur = nxt; cA = nA; cB = nB; ++ui;
        if constexpr (ALIGN_EPI) { if (wr == 1) PG8_BAR; }
    }
    PG8_WAIT_V(0);
    if constexpr (!ALIGN_EPI) { if (wr == 0) PG8_BAR; }
    PG8_BAR;
    if constexpr (Epi::AFTER_DRAIN) { E.fused(acc, cur, wr, wc, fr, fq, lds, wid, lane); S.done(cur); }
#undef PG8_SA
#undef PG8_SB
#undef PG8_STAGE
#undef PG8_LDA
#undef PG8_LDB
#undef PG8_MMA
#undef PG8_WAIT_V
#undef PG8_WAIT_L
#undef PG8_BAR
#undef PG8_SCHED
}
}
#define GAS __attribute__((address_space(1)))
#define LAS __attribute__((address_space(3)))
typedef GAS unsigned gu32;
typedef GAS unsigned long long gu64;
#define RLX_AGENT __ATOMIC_RELAXED, __HIP_MEMORY_SCOPE_AGENT
#define LDS_WAIT() asm volatile("s_waitcnt lgkmcnt(0)" ::: "memory")
#define VM_WAIT() asm volatile("s_waitcnt vmcnt(0)" ::: "memory")
#define XB_TMO      128
#define XB_XCNT(j)  (256  + 64 * (j))
#define XB_XSUB(j)  (1280 + 64 * (j))
#define XB_XGEN(j)  (2304 + 64 * (j))
#define XB_TOP      3328
#define XB_TOPGEN   3392
#define XCD_BAR_WORDS 3456
#define XB_SPIN_CAP (1u << 18)

__device__ __forceinline__ unsigned xb_ld(unsigned* p)              { return __hip_atomic_load(p, __ATOMIC_RELAXED, __HIP_MEMORY_SCOPE_AGENT); }
__device__ __forceinline__ unsigned xb_add(unsigned* p, unsigned v) { return __hip_atomic_fetch_add(p, v, __ATOMIC_RELAXED, __HIP_MEMORY_SCOPE_AGENT); }
__device__ __forceinline__ unsigned xb_xcc_id() { return (unsigned)__builtin_amdgcn_s_getreg((3 << 11) | 20) & 0xFu; }
#define XB_SPIN(cond, bar) do { unsigned _sp = 0; while (cond) { __builtin_amdgcn_s_sleep(1); \
    if ((++_sp & 255u) == 0u) { if (xb_ld(&(bar)[XB_TMO])) break; if (_sp > XB_SPIN_CAP) { atomicAdd(&(bar)[XB_TMO], 1u); break; } } } } while (0)

struct XcdBarrier {
    unsigned* bar; unsigned x;
    volatile LAS unsigned* st;
};

__device__ __forceinline__ XcdBarrier xcd_barrier_post(unsigned* bar, volatile LAS unsigned* st) {
    XcdBarrier b; b.bar = bar; b.x = xb_xcc_id(); b.st = st;
    if (threadIdx.x == 0) (void)xb_add(&bar[XB_XCNT(b.x)], 1u);
    return b;
}
__device__ __forceinline__ void xcd_barrier_complete(unsigned* bar, unsigned x, unsigned& nloc, unsigned& nx) {
    const unsigned G = gridDim.x * gridDim.y * gridDim.z;
    unsigned sum, cnt, mine, sp = 0u;
    for (;;) {
        sum = 0u; cnt = 0u; mine = 0u;
#pragma unroll
        for (unsigned j = 0; j < 16; ++j) { const unsigned c = xb_ld(&bar[XB_XCNT(j)]); sum += c; cnt += (c > 0u) ? 1u : 0u; mine = (j == x) ? c : mine; }
        if (sum == G) break;
        __builtin_amdgcn_s_sleep(1);
        if ((++sp & 255u) == 0u) { if (xb_ld(&bar[XB_TMO])) break; if (sp > XB_SPIN_CAP) { atomicAdd(&bar[XB_TMO], 1u); break; } }
    }
    nloc = mine > 0u ? mine : 1u; nx = cnt > 0u ? cnt : 1u;
}

__device__ __forceinline__ void xcd_barrier(const XcdBarrier& b) {
    asm volatile("s_waitcnt vmcnt(0)" ::: "memory");
    __syncthreads();
    if (threadIdx.x == 0) {
        unsigned* bar = b.bar;
        __builtin_amdgcn_s_waitcnt(0);
        unsigned nloc = b.st[0], nx = b.st[1];
        if (nloc == 0u) { xcd_barrier_complete(bar, b.x, nloc, nx); b.st[0] = nloc; b.st[1] = nx; }
        const unsigned old = xb_add(&bar[XB_XSUB(b.x)], 1u);
        const unsigned gen = old / nloc;
        if (old + 1u == (gen + 1u) * nloc) {
            __builtin_amdgcn_fence(__ATOMIC_RELEASE, "agent");
            asm volatile("s_waitcnt vmcnt(0)" ::: "memory");
            const unsigned og = xb_add(&bar[XB_TOP], 1u);
            const unsigned tg = og / nx;
            if (og + 1u == (tg + 1u) * nx) xb_add(&bar[XB_TOPGEN], 1u);
            else XB_SPIN(xb_ld(&bar[XB_TOPGEN]) == tg, bar);
            __builtin_amdgcn_fence(__ATOMIC_ACQUIRE, "agent");
            xb_add(&bar[XB_XGEN(b.x)], 1u);
            asm volatile("s_waitcnt vmcnt(0)" ::: "memory");
        } else {
            XB_SPIN(xb_ld(&bar[XB_XGEN(b.x)]) == gen, bar);
            __builtin_amdgcn_fence(__ATOMIC_ACQUIRE, "agent");
            asm volatile("s_waitcnt vmcnt(0)" ::: "memory");
        }
    }
    __syncthreads();
}
namespace at {
constexpr int D = 128; constexpr float THR = 8.f; constexpr bool WSKIP = false; constexpr int WBIG = 1 << 30;
constexpr float SCALE = 0.08838834764831845f;
constexpr int NW = 8, QBLK = 32, KVBLK = 64, QB = NW * QBLK;
constexpr int SHM_V = KVBLK * D * 2, SHM_K = KVBLK * D * 2;
constexpr int LDS_BODY = 2 * SHM_V + 2 * SHM_K + NW * 64 * 4;
constexpr int LDS_BIAS = LDS_BODY, LDS_BYTES = LDS_BODY + 8192 * 4;
using bf16 = unsigned short;
typedef short bf16x8 __attribute__((ext_vector_type(8)));
typedef short s16x4 __attribute__((ext_vector_type(4)));
typedef float f32x16 __attribute__((ext_vector_type(16)));
typedef float f32x4 __attribute__((ext_vector_type(4)));
typedef unsigned u32x4 __attribute__((ext_vector_type(4)));
template <class A, class Bt> struct same_t { static constexpr bool v = false; };
template <class A> struct same_t<A, A> { static constexpr bool v = true; };

#define KSWZ(row, colB) ((row) * 256 + ((colB) ^ (((row) & 7) << 4)))
#define SBAR() __builtin_amdgcn_sched_barrier(0)
__device__ __forceinline__ int v_st(int k, int c) { const int kk = (k & ~0xC) | ((k & 4) << 1) | ((k & 8) >> 1); return ((kk >> 3) * 4 + (c >> 5)) * 512 + ((kk & 7) * 32 + (c & 31)) * 2; }
__device__ __forceinline__ int v_rd_base(int lane) { return ((lane & 3) << 3) | (((lane >> 2) & 3) << 6) | (((lane >> 4) & 1) << 5) | (((lane >> 5) & 1) << 8); }
constexpr int v_rd_off(int d0, int ks, int half) { return d0 * 512 + ks * 4096 + half * 2048; }
__device__ __forceinline__ int crow(int r, int hi) { return (r & 3) + 8 * (r >> 2) + 4 * hi; }
__device__ __forceinline__ unsigned cvtpk(float lo, float hi) {
    unsigned r; asm volatile("v_cvt_pk_bf16_f32 %0, %1, %2" : "=v"(r) : "v"(lo), "v"(hi)); return r;
}
__device__ __forceinline__ bf16x8 pack8(f32x4 a, f32x4 b) {
    u32x4 w = {cvtpk(a[0], a[1]), cvtpk(a[2], a[3]), cvtpk(b[0], b[1]), cvtpk(b[2], b[3])};
    return *reinterpret_cast<bf16x8*>(&w);
}
template <class T> __device__ __forceinline__ bf16x8 load8(const T* p) {
    if constexpr (same_t<T, float>::v) { return pack8(*(const f32x4*)p, *(const f32x4*)(p + 4)); }
    else { return *reinterpret_cast<const bf16x8*>(p); }
}
template <int MODE> __device__ __forceinline__ void mask_tile(f32x16& p0, f32x16& p1, int dq, unsigned W) {
    const float NEG = MODE ? 0.f : -__builtin_inff();
#pragma unroll
    for (int r = 0; r < 16; ++r) {
        const int c = (r & 3) + 8 * (r >> 2);
        if ((unsigned)(dq - c) >= W) p0[r] = NEG;
        if ((unsigned)(dq - c - 32) >= W) p1[r] = NEG;
    }
}
__device__ __forceinline__ void partialRet(f32x16& p0, float rowfac) { for (int r = 0; r < 16; ++r) p0[r] *= rowfac; }
__device__ __forceinline__ void partialSM(f32x16& p0, f32x16& p1, float& m_reg, float& mn, float& alpha) {
    float pmax = p0[0]; for (int r = 1; r < 16; ++r) pmax = fmaxf(pmax, p0[r]); for (int r = 0; r < 16; ++r) pmax = fmaxf(pmax, p1[r]);
    { auto rr = __builtin_amdgcn_permlane32_swap(__float_as_uint(pmax), __float_as_uint(pmax), false, false);
      pmax = fmaxf(__uint_as_float(rr[0]), __uint_as_float(rr[1])); }
    constexpr float C2 = 1.4426950408889634f * SCALE;
    if (__builtin_expect(__all((pmax - m_reg) * SCALE <= THR), 1)) { mn = m_reg; alpha = 1.f; }
    else { mn = fmaxf(m_reg, pmax); alpha = __builtin_amdgcn_exp2f((m_reg - mn) * C2); m_reg = mn; }
    const float mnL = -mn * C2;
    for (int r = 0; r < 16; ++r) p0[r] = fmaf(p0[r], C2, mnL); for (int r = 0; r < 16; ++r) p1[r] = fmaf(p1[r], C2, mnL);
    for (int r = 0; r < 16; ++r) p0[r] = __builtin_amdgcn_exp2f(p0[r]);
}
template <int MODE> __device__ __forceinline__ void finishSM(f32x16& p0, f32x16& p1, float alpha, float& l_reg, bf16x8& pa0, bf16x8& pa1, bf16x8& pa2, bf16x8& pa3) {
    if constexpr (MODE == 0) {
    for (int r = 0; r < 16; ++r) p1[r] = __builtin_amdgcn_exp2f(p1[r]);
    float ps = 0; for (int r = 0; r < 16; ++r) ps += p0[r]; for (int r = 0; r < 16; ++r) ps += p1[r];
    { auto rr = __builtin_amdgcn_permlane32_swap(__float_as_uint(ps), __float_as_uint(ps), false, false);
      ps = __uint_as_float(rr[0]) + __uint_as_float(rr[1]); }
    l_reg = l_reg * alpha + ps;
    } else { for (int r = 0; r < 16; ++r) p1[r] *= alpha; }
#define PK4(P, B_, OUT) do { unsigned a0 = cvtpk(P[B_+0], P[B_+1]), a1 = cvtpk(P[B_+2], P[B_+3]);                          \
        unsigned b0 = cvtpk(P[B_+4], P[B_+5]), b1 = cvtpk(P[B_+6], P[B_+7]);                                             \
        auto r0 = __builtin_amdgcn_permlane32_swap(a0, b0, false, false); auto r1 = __builtin_amdgcn_permlane32_swap(a1, b1, false, false); \
        u32x4 w = {r0[0], r1[0], r0[1], r1[1]}; OUT = *reinterpret_cast<bf16x8*>(&w); } while (0)
    PK4(p0, 0, pa0); PK4(p0, 8, pa1); PK4(p1, 0, pa2); PK4(p1, 8, pa3);
#undef PK4
}
template <int KB, bool SK, int MODE>
__device__ __forceinline__ void qkt(f32x16& p0, f32x16& p1, const char* K_lds, int r32, int hi, const bf16x8* qr, bool act, const float* bt) {
    if (SK && !act) { const float NEG = -__builtin_inff();
#pragma unroll
        for (int r = 0; r < 16; ++r) { p0[r] = NEG; p1[r] = NEG; } return; }
    if constexpr (MODE == 0) {
        const f32x4 b0 = *(const f32x4*)(bt), b1 = *(const f32x4*)(bt + 8), b2 = *(const f32x4*)(bt + 16), b3 = *(const f32x4*)(bt + 24);
        const f32x4 c0 = *(const f32x4*)(bt + 32), c1 = *(const f32x4*)(bt + 40), c2 = *(const f32x4*)(bt + 48), c3 = *(const f32x4*)(bt + 56);
        p0 = f32x16{b0[0], b0[1], b0[2], b0[3], b1[0], b1[1], b1[2], b1[3], b2[0], b2[1], b2[2], b2[3], b3[0], b3[1], b3[2], b3[3]};
        p1 = f32x16{c0[0], c0[1], c0[2], c0[3], c1[0], c1[1], c1[2], c1[3], c2[0], c2[1], c2[2], c2[3], c3[0], c3[1], c3[2], c3[3]};
    } else { p0 = f32x16{}; p1 = f32x16{}; }
    const char* kb[4];
#pragma unroll
    for (int dd = 0; dd < 4; ++dd) kb[dd] = K_lds + KB * SHM_K + KSWZ(r32, (dd * 16 + hi * 8) * 2);
#pragma unroll
    for (int d0 = 0; d0 < 8; ++d0) { const char* a = kb[d0 & 3] + (d0 >> 2) * 128;
        bf16x8 b0 = *reinterpret_cast<const bf16x8*>(a);
        bf16x8 b1 = *reinterpret_cast<const bf16x8*>(a + 32 * 256);
        p0 = __builtin_amdgcn_mfma_f32_32x32x16_bf16(b0, qr[d0], p0, 0, 0, 0);
        p1 = __builtin_amdgcn_mfma_f32_32x32x16_bf16(b1, qr[d0], p1, 0, 0, 0); }
}
template <int VB, bool SK>
__device__ __forceinline__ void pv_tile(f32x16* o, int vb0, bf16x8 pa0, bf16x8 pa1, bf16x8 pa2, bf16x8 pa3, bool act) {
    if (SK && !act) return;
#define TRRD(dst, off) asm volatile("ds_read_b64_tr_b16 %0, %1 offset:%2" : "=&v"(dst) : "v"(vb0), "i"(off) : "memory")
#define PV_D0(d0) do { s16x4 l0, l1, l2, l3, h0, h1, h2, h3; constexpr int b_ = VB * SHM_V + v_rd_off(d0, 0, 0);     \
        TRRD(l0, b_); TRRD(h0, b_ + 2048); TRRD(l1, b_ + 4096); TRRD(h1, b_ + 6144); TRRD(l2, b_ + 8192); TRRD(h2, b_ + 10240); TRRD(l3, b_ + 12288); TRRD(h3, b_ + 14336); \
        asm volatile("s_waitcnt lgkmcnt(0)" ::: "memory"); SBAR();                 \
        o[d0] = __builtin_amdgcn_mfma_f32_32x32x16_bf16(pa0, (bf16x8){l0[0], l0[1], l0[2], l0[3], h0[0], h0[1], h0[2], h0[3]}, o[d0], 0, 0, 0);   \
        o[d0] = __builtin_amdgcn_mfma_f32_32x32x16_bf16(pa1, (bf16x8){l1[0], l1[1], l1[2], l1[3], h1[0], h1[1], h1[2], h1[3]}, o[d0], 0, 0, 0);   \
        o[d0] = __builtin_amdgcn_mfma_f32_32x32x16_bf16(pa2, (bf16x8){l2[0], l2[1], l2[2], l2[3], h2[0], h2[1], h2[2], h2[3]}, o[d0], 0, 0, 0);   \
        o[d0] = __builtin_amdgcn_mfma_f32_32x32x16_bf16(pa3, (bf16x8){l3[0], l3[1], l3[2], l3[3], h3[0], h3[1], h3[2], h3[3]}, o[d0], 0, 0, 0); } while (0)
    PV_D0(0); PV_D0(1); PV_D0(2); PV_D0(3);
#undef PV_D0
#undef TRRD
}

template <class TIn, class TOut> struct BlockRef { const TIn* Q; const TIn* K; const TIn* V; TOut* O; int P0; int jlo; int bh; };
template <class TIn> struct NextRef { const TIn* Q; const TIn* K; const TIn* V; int jlo; };
template <class TIn> struct Extra { const float* bias; const TIn* G; const float* nw; const TIn* S; };
constexpr int LDO = 2048;
template <class TIn> struct Seam {
    bf16x8 qr[8];
    bf16x8 st_v0, st_v1, st_k0, st_k1; f32x4 sf0, sf1, sf2, sf3;
    f32x4 tq[16];
};
#define ROW(p, k0, rr) ((p) + (unsigned)(((k0) + (rr)) * D + sc))
#define VMW() asm volatile("s_waitcnt vmcnt(0)" ::: "memory")
#define VMWN(n) asm volatile("s_waitcnt vmcnt(%0)" :: "i"(n) : "memory")
#define SLOAD_H(Kp, Vp, k0) do { S.st_v0 = load8<TIn>(ROW(Vp, k0, sr)); S.st_v1 = load8<TIn>(ROW(Vp, k0, 32 + sr));              \
                         S.st_k0 = load8<TIn>(ROW(Kp, k0, sr)); S.st_k1 = load8<TIn>(ROW(Kp, k0, 32 + sr)); } while (0)
#define SWRITE_HK(bf) do { *(bf16x8*)(K_lds + (bf) * SHM_K + kws) = S.st_k0; *(bf16x8*)(K_lds + (bf) * SHM_K + kws + 32 * 256) = S.st_k1; } while (0)
#define SWRITE_HV(bf) do { *(bf16x8*)(V_lds + (bf) * SHM_V + vst0) = S.st_v0; *(bf16x8*)(V_lds + (bf) * SHM_V + vst1) = S.st_v1; } while (0)
#define SWRITE_H(bf) do { SWRITE_HV(bf); SWRITE_HK(bf); } while (0)
#define SLOAD_F(p, k0) do { S.sf0 = *(const f32x4*)ROW(p, k0, sr); S.sf1 = *(const f32x4*)(ROW(p, k0, sr) + 4);                \
                            S.sf2 = *(const f32x4*)ROW(p, k0, 32 + sr); S.sf3 = *(const f32x4*)(ROW(p, k0, 32 + sr) + 4); } while (0)
#define SWRITE_KF(bf) do { *(bf16x8*)(K_lds + (bf) * SHM_K + kws) = pack8(S.sf0, S.sf1); *(bf16x8*)(K_lds + (bf) * SHM_K + kws + 32 * 256) = pack8(S.sf2, S.sf3); } while (0)
#define SWRITE_VF(bf) do { *(bf16x8*)(V_lds + (bf) * SHM_V + vst0) = pack8(S.sf0, S.sf1); *(bf16x8*)(V_lds + (bf) * SHM_V + vst1) = pack8(S.sf2, S.sf3); } while (0)
template <class TIn, class TOut>
__device__ __forceinline__ void causal_swa_prime(const BlockRef<TIn, TOut>& cur, int W, char* lds, Seam<TIn>& S) {
    constexpr bool F32 = same_t<TIn, float>::v;
    const int tid = threadIdx.x, wid = __builtin_amdgcn_readfirstlane(tid >> 6), lane = tid & 63, r32 = lane & 31, hi = lane >> 5;
    const int sr = tid >> 4, sc = (tid & 15) * 8, kws = KSWZ(sr, sc * 2); char* K_lds = lds + 2 * SHM_V;
    const int kb0 = cur.jlo * KVBLK;
    for (int d0 = 0; d0 < 8; ++d0) S.qr[d0] = load8<TIn>(cur.Q + (unsigned)((wid * QBLK + r32) * D + d0 * 16 + hi * 8));
    if constexpr (F32) { SLOAD_F((const float*)cur.K, kb0); VMW(); SWRITE_KF(0); SBAR(); SLOAD_F((const float*)cur.V, kb0); }
    else { SLOAD_H(cur.K, cur.V, kb0); VMW(); SWRITE_HK(0); }
    __syncthreads();
}
template <int MODE, class TIn, class TOut>
__device__ __forceinline__ void causal_swa_block(const BlockRef<TIn, TOut>& cur, const NextRef<TIn>& nxt, const Extra<TIn>& X, int skv, int W, char* lds, Seam<TIn>& S) {
    constexpr bool F32 = same_t<TIn, float>::v;
    int tid_ = threadIdx.x; asm volatile("" : "+v"(tid_));
    const int tid = tid_, wid = __builtin_amdgcn_readfirstlane(tid >> 6), lane = tid & 63, r32 = lane & 31, hi = lane >> 5;
    const int j_lo = cur.jlo;
    int j_hi = (cur.P0 + QB - 1) / KVBLK + 1; if (j_hi > skv / KVBLK) j_hi = skv / KVBLK;
    const int NT = j_hi - j_lo;
    const int kbn = nxt.jlo * KVBLK;
    const int qlo = cur.P0 + wid * QBLK, qm = qlo + r32 - 4 * hi;
    char* V_lds = lds; char* K_lds = lds + 2 * SHM_V;
    float* ws = (float*)(lds + 2 * SHM_V + 2 * SHM_K) + wid * 64; float* li_l = ws, * al_l = ws + 32;
    float m_reg = -1e30f, l_reg = 0; f32x16 o[4] = {};
    const int sr = tid >> 4, sc = (tid & 15) * 8, vst0 = v_st(sr, sc), vst1 = v_st(32 + sr, sc), kws = KSWZ(sr, sc * 2);
    const int vb0 = (int)(uintptr_t)V_lds + v_rd_base(lane);
    const TIn* Kh = cur.K; const TIn* Vh = cur.V;
    const float* bl = (const float*)(lds + LDS_BIAS) + 4 * hi;
    if constexpr (MODE == 0) { for (int i = tid; i < NT * 16; i += 64 * NW) *(f32x4*)(lds + LDS_BIAS + i * 16) = *(const f32x4*)(X.bias + (size_t)cur.bh * 8192 + j_lo * KVBLK + i * 4); __syncthreads(); }
    const float l2g = MODE ? log2f(1.f - exp2f(-5.f - (float)(cur.bh & 7))) : 0.f;
    if constexpr (MODE == 1) {
        const TIn* Sg = X.S + ((size_t)(cur.bh * 32 + (cur.P0 >> 8))) * 16384 + (unsigned)(r32 * D + hi * 8);
        const float fq = __builtin_amdgcn_exp2f(l2g * (float)(wid * QBLK + r32 + 1));
#pragma unroll
        for (int d0 = 0; d0 < 8; ++d0) { const u32x4 qw = *reinterpret_cast<const u32x4*>(&S.qr[d0]); u32x4 sw;
#pragma unroll
            for (int i = 0; i < 4; ++i) sw[i] = cvtpk(__uint_as_float(qw[i] << 16) * fq, __uint_as_float(qw[i] & 0xffff0000u) * fq);
            const bf16x8 qs = *reinterpret_cast<const bf16x8*>(&sw);
#pragma unroll
            for (int eb = 0; eb < 4; ++eb) { const bf16x8 sb = *reinterpret_cast<const bf16x8*>(Sg + eb * 32 * D + d0 * 16); o[eb] = __builtin_amdgcn_mfma_f32_32x32x16_bf16(qs, sb, o[eb], 0, 0, 0); }
            if (d0 & 1) asm volatile("" ::: "memory"); }
    }
#define BT(t) (bl + (t) * KVBLK)
#define PSM(P0_, P1_, mnX, alX, t) do { if constexpr (MODE == 0) partialSM(P0_, P1_, m_reg, mnX, alX); else { alX = __builtin_amdgcn_exp2f(l2g * (float)(qlo + r32 - KBASE(t))); partialRet(P0_, alX); } } while (0)
#define RESC(a) do { if (MODE == 0 && __any((a) < 1.f)) { if (hi == 0) al_l[r32] = (a); asm volatile("s_waitcnt lgkmcnt(0)" ::: "memory");              \
                     for (int d_ = 0; d_ < 4; ++d_) for (int r = 0; r < 16; ++r) o[d_][r] *= al_l[crow(r, hi)]; } } while (0)
#define KBASE(t) ((j_lo + (t)) * KVBLK)
#define ACT(t) (KBASE(t) <= qlo + QBLK - 1 && KBASE(t) + KVBLK - 1 >= qlo - W + 1)
#define MASKT(P0_, P1_, t) do { const int kb_ = KBASE(t); if ((!SK || ACT(t)) && (kb_ + KVBLK - 1 > qlo || kb_ <= qlo + QBLK - 1 - W)) mask_tile<MODE>(P0_, P1_, qm - kb_, (unsigned)W); } while (0)
    constexpr int NQL = F32 ? 16 : 8;
    constexpr bool SK = WSKIP && !F32;
#define SEAM_K0() do { VMWN(NQL); if constexpr (F32) { SWRITE_KF(0); SBAR(); SLOAD_F((const float*)nxt.V, kbn); } else { SWRITE_HK(0); } SBAR(); } while (0)
    f32x16 pA0, pA1, pB0, pB1; float mnA, mnB, alA, alB; bf16x8 pa0, pa1, pa2, pa3;
    if constexpr (F32) { VMW(); SWRITE_VF(0); SBAR(); } else { SWRITE_HV(0); SBAR(); }
    if (NT > 1) { if constexpr (F32) SLOAD_F((const float*)Kh, KBASE(1)); else SLOAD_H(Kh, Vh, KBASE(1)); }
    SBAR(); qkt<0, SK, MODE>(pA0, pA1, K_lds, r32, hi, S.qr, ACT(0), BT(0));
    if constexpr (F32) { if (NT > 1) { VMW(); SWRITE_KF(1); SBAR(); SLOAD_F((const float*)Vh, KBASE(1)); } }
    MASKT(pA0, pA1, 0); PSM(pA0, pA1, mnA, alA, 0);
    if (NT > 1) { VMW(); if constexpr (F32) { SWRITE_VF(1); SBAR(); if (NT > 2) SLOAD_F((const float*)Kh, KBASE(2)); } else SWRITE_H(1); }
    __syncthreads();
#define HALF_STEP(PX0, PX1, mnX, alX, PY0, PY1, alY, t, KB, VB, SB) do {                                                      \
        SBAR(); qkt<KB, SK, MODE>(PX0, PX1, K_lds, r32, hi, S.qr, ACT(t), BT(t));                                \
        finishSM<MODE>(PY0, PY1, alY, l_reg, pa0, pa1, pa2, pa3); SBAR();                                                           \
        if ((t) + 1 < NT) { if constexpr (F32) { VMW(); SWRITE_KF(SB); SBAR(); SLOAD_F((const float*)Vh, KBASE((t) + 1)); }  \
                            else { SLOAD_H(Kh, Vh, KBASE((t) + 1)); } SBAR(); }                                               \
        pv_tile<VB, SK>(o, vb0, pa0, pa1, pa2, pa3, ACT((t) - 1)); MASKT(PX0, PX1, (t)); PSM(PX0, PX1, mnX, alX, (t));                                        \
        __syncthreads();                                                                                                      \
        if ((t) + 1 < NT) { VMW(); if constexpr (F32) { SWRITE_VF(SB); SBAR(); if ((t) + 2 < NT) SLOAD_F((const float*)Kh, KBASE((t) + 2)); } \
                            else { SWRITE_H(SB); } }                                                                          \
        RESC(alX); __syncthreads(); } while (0)
    for (int t = 1; t + 1 < NT; t += 2) {
        HALF_STEP(pB0, pB1, mnB, alB, pA0, pA1, alA, t, 1, 0, 0);
        HALF_STEP(pA0, pA1, mnA, alA, pB0, pB1, alB, t + 1, 0, 1, 1);
    }
    const bool even = (NT & 1) == 0;
    if (even) { SBAR(); qkt<1, SK, MODE>(pB0, pB1, K_lds, r32, hi, S.qr, ACT(NT - 1), BT(NT - 1)); SBAR(); }
#define QROW(e) (nxt.Q + (size_t)(wid * QBLK + r32) * D + ((e) >> 1) * 16 + hi * 8 + ((e) & 1) * 4)
    if constexpr (F32) { SLOAD_F((const float*)nxt.K, kbn); SBAR();
#pragma unroll
        for (int e = 0; e < 8; ++e) S.tq[e] = *(const f32x4*)QROW(e); }
    else { SLOAD_H(nxt.K, nxt.V, kbn); SBAR();
#pragma unroll
        for (int d0 = 0; d0 < 8; ++d0) S.qr[d0] = load8<TIn>(nxt.Q + (unsigned)((wid * QBLK + r32) * D + d0 * 16 + hi * 8)); }
    SBAR();
    finishSM<MODE>(pA0, pA1, alA, l_reg, pa0, pa1, pa2, pa3); SBAR();
    if constexpr (F32) {
#pragma unroll
        for (int e = 8; e < 16; ++e) S.tq[e] = *(const f32x4*)QROW(e); SBAR(); }
#undef QROW
    pv_tile<0, SK>(o, vb0, pa0, pa1, pa2, pa3, ACT(even ? NT - 2 : NT - 1));
    if (even) { MASKT(pB0, pB1, NT - 1); PSM(pB0, pB1, mnB, alB, NT - 1); __syncthreads(); RESC(alB);
        finishSM<MODE>(pB0, pB1, alB, l_reg, pa0, pa1, pa2, pa3); SBAR(); pv_tile<1, SK>(o, vb0, pa0, pa1, pa2, pa3, ACT(NT - 1)); }
    SBAR(); SEAM_K0();
    float rli[16];
    if constexpr (MODE == 0) {
        if (hi == 0) li_l[r32] = l_reg; asm volatile("s_waitcnt lgkmcnt(0)" ::: "memory");
#pragma unroll
        for (int r = 0; r < 16; ++r) rli[r] = __builtin_amdgcn_rcpf(li_l[crow(r, hi)]);
    } else {
#pragma unroll
        for (int r = 0; r < 16; ++r) { float sq = (o[0][r] * o[0][r] + o[1][r] * o[1][r]) + (o[2][r] * o[2][r] + o[3][r] * o[3][r]);
            sq += __shfl_xor(sq, 1); sq += __shfl_xor(sq, 2); sq += __shfl_xor(sq, 4); sq += __shfl_xor(sq, 8); sq += __shfl_xor(sq, 16);
            rli[r] = rsqrtf(sq * (1.f / 128.f) + 1e-6f); }
    }
    { int t2 = threadIdx.x; asm volatile("" : "+v"(t2));
      const int w2 = __builtin_amdgcn_readfirstlane(t2 >> 6), c2 = t2 & 31, h2 = (t2 >> 5) & 1;
      TOut* Ow = cur.O + (unsigned)((w2 * QBLK + 4 * h2) * LDO + c2);
      float nwv[4] = {1.f, 1.f, 1.f, 1.f}; const TIn* Gp = nullptr;
      if constexpr (MODE == 1) { Gp = X.G + ((size_t)cur.bh * 8192 + cur.P0) * D + (unsigned)((w2 * QBLK + 4 * h2) * D + c2);
#pragma unroll
          for (int d0 = 0; d0 < 4; ++d0) nwv[d0] = X.nw[(cur.bh & 7) * D + d0 * 32 + c2]; }
#pragma unroll
      for (int r = 0; r < 16; ++r) { const int ro = (r & 3) + 8 * (r >> 2);
          float v[4];
#pragma unroll
          for (int d0 = 0; d0 < 4; ++d0) { v[d0] = o[d0][r] * rli[r];
              if constexpr (MODE == 1) { const unsigned gq = Gp[ro * D + d0 * 32]; v[d0] *= nwv[d0] * __uint_as_float(gq << 16); } }
#pragma unroll
          for (int d0 = 0; d0 < 4; ++d0) { const float vn = __shfl_xor(v[d0], 1);
              if ((c2 & 1) == 0) *(unsigned*)(Ow + ro * LDO + d0 * 32) = cvtpk(v[d0], vn); }
          if ((r & 3) == 3) asm volatile("" ::: "memory"); } }
    if constexpr (F32) {
#pragma unroll
        for (int d0 = 0; d0 < 8; ++d0) S.qr[d0] = pack8(S.tq[2 * d0], S.tq[2 * d0 + 1]); }
    __syncthreads();
#undef RESC
#undef BT
#undef PSM
#undef KBASE
#undef ACT
#undef MASKT
#undef SEAM_K0
#undef HALF_STEP
}
#undef ROW
#undef VMW
#undef VMWN
#undef SLOAD_H
#undef SWRITE_HK
#undef SWRITE_HV
#undef SWRITE_H
#undef SLOAD_F
#undef SWRITE_KF
#undef SWRITE_VF

}
constexpr int NWAVES = 8;
namespace W {
constexpr size_t CTL = 0, CTL_ZERO_BYTES = 1 * MiB;
constexpr size_t MOD = 1 * MiB, MODP = 2 * MiB, ROPE = 4 * MiB, LOGF = 8 * MiB, CUM = 9 * MiB, BIAS = 9 * MiB + 512 * 1024, ROUTE = 10 * MiB, TILE = 11 * MiB, JLO = 12 * MiB, WFR = 13 * MiB, A2S2 = 14 * MiB;
constexpr size_t XN = 16 * MiB, MIX = 80 * MiB, WT_IN = 144 * MiB, WT_OUT = 172 * MiB, WT_13 = 180 * MiB, WT_2 = 308 * MiB, QKV = 372 * MiB, END = 596 * MiB;
constexpr size_t KVS = XN, ST = XN + 32 * MiB;
constexpr size_t H2 = XN, XS = QKV, ACT = QKV + 160 * MiB, Y = 16 * MiB;
constexpr size_t NV_RO = 596 * MiB, NV_UP = 596 * MiB, NV_Z = 144 * MiB, NV_END = 676 * MiB;
}
constexpr int CW_CNT = 0, CNT_STRIDE = 64;
constexpr int CW_QFOX = 2560;
constexpr int CW_BAR = 4096;
constexpr int RING_OFF = 0, RING_BYTES = 131072, XCH_OFF = 131072, XCH_BYTES = 8192, LDS_BYTES = 163840, MISC_OFF = LDS_BYTES - 512;

struct Args { const float* in[19]; float* out; unsigned char* ws; int ph_lo, ph_hi, li, pad; };

__device__ __forceinline__ float wave_sum(float v) {
#define WS_DPP(ctrl, rmask, bc) v += __int_as_float(__builtin_amdgcn_update_dpp(0, __float_as_int(v), ctrl, rmask, 0xF, bc))
    WS_DPP(0x111, 0xF, true); WS_DPP(0x112, 0xF, true); WS_DPP(0x114, 0xF, true); WS_DPP(0x118, 0xF, true);
    WS_DPP(0x142, 0xA, false); WS_DPP(0x143, 0xC, false);
#undef WS_DPP
    return __int_as_float(__builtin_amdgcn_readlane(__float_as_int(v), 63));
}
__device__ __forceinline__ unsigned pk2(float lo, float hi) { return f2bf(lo) | (f2bf(hi) << 16); }
__device__ __forceinline__ float log_sigmoid_f(float x) { return x >= 0.f ? -log1pf(expf(-x)) : x - log1pf(expf(x)); }

__device__ __forceinline__ void tr_item(const float* colp, size_t ldw, bf16_t* WT, int K, int k0, int n0, LAS float* scr, int lane) {
#pragma unroll 8
    for (int i = 0; i < 32; ++i) { const int kk = 2 * i + (lane >> 5); scr[kk * 33 + (lane & 31)] = colp[(size_t)(k0 + kk) * ldw]; }
    LDS_WAIT(); asm volatile("" ::: "memory");
    const int c = lane & 7;
#pragma unroll
    for (int j = 0; j < 4; ++j) { const int n = (lane >> 3) + 8 * j; const LAS float* s = scr + (8 * c) * 33 + n;
        uint4 o; o.x = pk2(s[0 * 33], s[1 * 33]); o.y = pk2(s[2 * 33], s[3 * 33]); o.z = pk2(s[4 * 33], s[5 * 33]); o.w = pk2(s[6 * 33], s[7 * 33]);
        *(uint4*)(WT + (size_t)(n0 + n) * K + k0 + 8 * c) = o; }
    LDS_WAIT(); asm volatile("" ::: "memory");
}
__device__ __forceinline__ void tr_item4(const float* colp4, size_t ldw, bf16_t* WT, int K, int k0, int n0, LAS float* scr, int lane) {
    const int kr = lane >> 3, cq = (lane & 7) * 4;
    pg8::f32x4 v[8];
#pragma unroll
    for (int i = 0; i < 8; ++i) v[i] = *(const pg8::f32x4*)(colp4 + (size_t)(k0 + i * 8 + kr) * ldw);
#pragma unroll
    for (int i = 0; i < 8; ++i) { const int kk = i * 8 + kr;
        scr[kk * 33 + cq] = v[i][0]; scr[kk * 33 + cq + 1] = v[i][1]; scr[kk * 33 + cq + 2] = v[i][2]; scr[kk * 33 + cq + 3] = v[i][3]; }
    LDS_WAIT(); asm volatile("" ::: "memory");
    const int c = lane & 7;
#pragma unroll
    for (int j = 0; j < 4; ++j) { const int n = (lane >> 3) + 8 * j; const LAS float* s = scr + (8 * c) * 33 + n;
        uint4 o; o.x = pk2(s[0 * 33], s[1 * 33]); o.y = pk2(s[2 * 33], s[3 * 33]); o.z = pk2(s[4 * 33], s[5 * 33]); o.w = pk2(s[6 * 33], s[7 * 33]);
        *(uint4*)(WT + (size_t)(n0 + n) * K + k0 + 8 * c) = o; }
    LDS_WAIT(); asm volatile("" ::: "memory");
}
__device__ __forceinline__ unsigned pk4_fp8(float a, float b, float c, float d) { int p = __builtin_amdgcn_cvt_pk_fp8_f32(a, b, 0, false); p = __builtin_amdgcn_cvt_pk_fp8_f32(c, d, p, true); return (unsigned)p; }
__device__ __forceinline__ void tr_item4_f8(const float* colp4, size_t ldw, unsigned char* WT, int K, int k0, int n0, float scale, LAS float* scr, int lane) {
    const int kr = lane >> 3, cq = (lane & 7) * 4;
    pg8::f32x4 v[8];
#pragma unroll
    for (int i = 0; i < 8; ++i) v[i] = *(const pg8::f32x4*)(colp4 + (size_t)(k0 + i * 8 + kr) * ldw);
#pragma unroll
    for (int i = 0; i < 8; ++i) { const int kk = i * 8 + kr;
        scr[kk * 33 + cq] = v[i][0] * scale; scr[kk * 33 + cq + 1] = v[i][1] * scale; scr[kk * 33 + cq + 2] = v[i][2] * scale; scr[kk * 33 + cq + 3] = v[i][3] * scale; }
    LDS_WAIT(); asm volatile("" ::: "memory");
    const int c = lane & 7;
#pragma unroll
    for (int j = 0; j < 4; ++j) { const int n = (lane >> 3) + 8 * j; const LAS float* sp = scr + (8 * c) * 33 + n;
        uint2 o; o.x = pk4_fp8(sp[0 * 33], sp[1 * 33], sp[2 * 33], sp[3 * 33]); o.y = pk4_fp8(sp[4 * 33], sp[5 * 33], sp[6 * 33], sp[7 * 33]);
        *(uint2*)(WT + (size_t)(n0 + n) * K + k0 + 8 * c) = o; }
    LDS_WAIT(); asm volatile("" ::: "memory");
}
constexpr float SC13 = 64.f, SC2 = 32.f;
__device__ __forceinline__ int win_src(int n) {
    const int tt = n >> 10;
    if (tt < 3) return n;
    if (tt < 5) { const int d = n & 127; return 8 + (n & ~127) + (d & 1) * 64 + (d >> 1); }
    return n + 8;
}
__device__ __forceinline__ void ph0(const Args& a, LAS unsigned char* lds, int G) {
    const int tid = threadIdx.x, lane = tid & 63, wave = __builtin_amdgcn_readfirstlane(tid >> 6);
    unsigned char* ws = a.ws;
    LAS float* cact = (LAS float*)(lds + RING_OFF + 98304);
    const float* c = a.in[1]; const float* w_ada = a.in[2];
    for (int i = tid; i < 4096; i += 512) { const float cv = c[i]; cact[i] = cv / (1.f + expf(-cv)); }
    __syncthreads();
    float* modp = (float*)(ws + W::MODP);
    LAS float* red = (LAS float*)(lds + RING_OFF);
    for (int it = blockIdx.x; it < 192; it += G) { const int cb = it % 12, ks = it / 12; const int col = cb * 1024 + lane * 4, k0 = ks * 128 + wave * 16;
        pg8::f32x4 w[16];
#pragma unroll
        for (int i = 0; i < 16; ++i) w[i] = *(const pg8::f32x4*)(w_ada + (size_t)(k0 + i) * 12288 + col);
        pg8::f32x4 a0 = {0.f, 0.f, 0.f, 0.f}, a1 = {0.f, 0.f, 0.f, 0.f}, b0 = a0, b1 = a0, c0 = a0, c1 = a0, d0 = a0, d1 = a0;
        (void)b0; (void)b1; (void)c0; (void)c1; (void)d0; (void)d1;
#pragma unroll
        for (int i = 0; i < 16; ++i) { a0 += w[i] * cact[k0 + i]; a1 += w[i] * cact[2048 + k0 + i]; }
        pg8::f32x4 e0[3], e1[3];
#pragma unroll
        for (int q = 1; q < 4; ++q) { pg8::f32x4 t0 = {0.f, 0.f, 0.f, 0.f}, t1 = t0;
#pragma unroll
            for (int i = 0; i < 16; ++i) w[i] = *(const pg8::f32x4*)(w_ada + (size_t)(k0 + i) * 12288 + col + q * 256);
#pragma unroll
            for (int i = 0; i < 16; ++i) { t0 += w[i] * cact[k0 + i]; t1 += w[i] * cact[2048 + k0 + i]; }
            e0[q - 1] = t0; e1[q - 1] = t1; }
        __syncthreads();
        *(LAS pg8::f32x4*)(red + (wave * 2 + 0) * 1024 + lane * 4) = a0; *(LAS pg8::f32x4*)(red + (wave * 2 + 1) * 1024 + lane * 4) = a1;
#pragma unroll
        for (int q = 1; q < 4; ++q) { *(LAS pg8::f32x4*)(red + (wave * 2 + 0) * 1024 + q * 256 + lane * 4) = e0[q - 1]; *(LAS pg8::f32x4*)(red + (wave * 2 + 1) * 1024 + q * 256 + lane * 4) = e1[q - 1]; }
        __syncthreads();
        for (int i = tid; i < 2048; i += 512) { const int bb = i >> 10, cc = i & 1023; float t = 0.f;
#pragma unroll
            for (int wv = 0; wv < 8; ++wv) t += red[(wv * 2 + bb) * 1024 + cc];
            modp[(ks * 2 + bb) * 12288 + cb * 1024 + cc] = t; }
    }
    __syncthreads();
    float2* rope = (float2*)(ws + W::ROPE);
    for (int i = blockIdx.x * 512 + tid; i < 8192 * 64; i += G * 512) { const int s = i >> 6, j = i & 63;
        const float theta = powf(10000.f, -(float)j / 64.f); const float ang = (float)s * theta;
        const double ad = (double)ang, TWO_PI = 6.283185307179586; const double kq = rint(ad / TWO_PI); const float r = (float)(ad - kq * TWO_PI);
        rope[i] = make_float2(cosf(r), sinf(r)); }
    { bf16_t* wfr = (bf16_t*)(ws + W::WFR); const float* w_coarse = a.in[12]; const float* w_fine = a.in[14];
      for (int i = blockIdx.x * 512 + tid; i < 64 * 3 * 64 * 8; i += G * 512) { const int e8 = i & 7, ln = (i >> 3) & 63, ob = (i >> 9) % 3, ks = (i >> 9) / 3, o = ob * 16 + (ln & 15), k = 32 * ks + 8 * (ln >> 4) + e8;
          const float wv = o < 4 ? w_coarse[(size_t)k * 4 + o] : (o < 36 ? w_fine[((size_t)((o - 4) >> 3) * 2048 + k) * 8 + ((o - 4) & 7)] : 0.f);
          const unsigned h = f2bf(wv), l = f2bf(wv - __uint_as_float(h << 16));
          wfr[(((size_t)(ks * 3 + ob) * 2 + 0) * 64 + ln) * 8 + e8] = (bf16_t)h; wfr[(((size_t)(ks * 3 + ob) * 2 + 1) * 64 + ln) * 8 + e8] = (bf16_t)l; } }
    LAS float* scr = (LAS float*)(lds + RING_OFF + wave * 12288);
    const float* w_in = a.in[5]; const float* w_out = a.in[10]; const float* w1 = a.in[16]; const float* w3 = a.in[17]; const float* w2 = a.in[18];
    bf16_t* wt_in = (bf16_t*)(ws + W::WT_IN); bf16_t* wt_out = (bf16_t*)(ws + W::WT_OUT); bf16_t* wt_13 = (bf16_t*)(ws + W::WT_13); bf16_t* wt_2 = (bf16_t*)(ws + W::WT_2);
    constexpr int I_IN = 32 * 224, I_OUT = 32 * 64, I_13 = 32 * 1024, I_2 = 32 * 512, NITEMS = I_IN + I_OUT + I_13 + I_2;
    const int gw = blockIdx.x * NWAVES + wave, NGW = G * NWAVES;
    for (int it = gw; it < NITEMS; it += NGW) {
        int r = it;
        if (r < I_IN) { const int kb = r / 224, nb = r % 224; tr_item(w_in + win_src(nb * 32 + (lane & 31)), 7176, wt_in, 2048, kb * 64, nb * 32, scr, lane); continue; } r -= I_IN;
        if (r < I_OUT) { const int kb = r / 64, nb = r % 64; tr_item4(w_out + nb * 32 + (lane & 7) * 4, 2048, wt_out, 2048, kb * 64, nb * 32, scr, lane); continue; } r -= I_OUT;
        if (r < I_13) { const int e = r >> 10, r2 = r & 1023, kb = r2 >> 5, nb = r2 & 31; const int cq = lane & 7, g = (nb * 32 + cq * 4) >> 3;
            const float* colp4 = ((cq & 1) ? w3 : w1) + (size_t)e * 2048 * 512 + 4 * g;
            tr_item4_f8(colp4, 512, (unsigned char*)wt_13 + (size_t)e * 1024 * 2048, 2048, kb * 64, nb * 32, SC13, scr, lane); continue; } r -= I_13;
        { const int e = r >> 9, r2 = r & 511, kb = r2 >> 6, nb = r2 & 63;
          tr_item4(w2 + (size_t)e * 512 * 2048 + nb * 32 + (lane & 7) * 4, 2048, wt_2 + (size_t)e * 2048 * 512, 512, kb * 64, nb * 32, scr, lane); }
    }
}

__device__ __forceinline__ void ph1(const Args& a, LAS unsigned char* lds, int G) {
    const int tid = threadIdx.x, lane = tid & 63, wave = __builtin_amdgcn_readfirstlane(tid >> 6);
    unsigned char* ws = a.ws;
    const float* x = a.in[0]; const float* b_ada = a.in[3]; const float* norm1_w = a.in[4]; const float* w_in = a.in[5]; const float* fbias = a.in[6];
    const float* modp = (const float*)(ws + W::MODP); float* mod = (float*)(ws + W::MOD); bf16_t* xn = (bf16_t*)(ws + W::XN); float* logf_ = (float*)(ws + W::LOGF);
    for (int i = blockIdx.x * 512 + tid; i < 2 * 12288; i += G * 512) { const int b = i / 12288, j = i % 12288; float s = b_ada[j];
        for (int k = 0; k < 16; ++k) s += modp[(k * 2 + b) * 12288 + j];
        mod[i] = s; }
    LAS float* A1 = (LAS float*)(lds + RING_OFF); LAS float* S1 = A1 + 2048; LAS float* WFT = S1 + 2048;
    for (int i = tid; i < 2048 * 2; i += 512) { const int cc = i >> 1, hf = (i & 1) * 4; const pg8::f32x4 w = *(const pg8::f32x4*)(w_in + (size_t)cc * 7176 + 3072 + hf);
        WFT[(hf + 0) * 2048 + cc] = w[0]; WFT[(hf + 1) * 2048 + cc] = w[1]; WFT[(hf + 2) * 2048 + cc] = w[2]; WFT[(hf + 3) * 2048 + cc] = w[3]; }
    int bprev = -1;
    for (int rb = blockIdx.x; rb < 256; rb += G) {
        const int b = rb >> 7;
        if (b != bprev) { __syncthreads();
            for (int cc = tid; cc < 2048; cc += 512) { float sh = b_ada[cc], sc = b_ada[2048 + cc];
                for (int k = 0; k < 16; ++k) { sh += modp[(k * 2 + b) * 12288 + cc]; sc += modp[(k * 2 + b) * 12288 + 2048 + cc]; }
                A1[cc] = norm1_w[cc] * (1.f + sc); S1[cc] = sh; }
            __syncthreads(); bprev = b; }
#pragma unroll 1
        for (int q = 0; q < 8; ++q) {
            const int row = rb * 64 + wave * 8 + q;
            pg8::f32x4 v[8]; float ss = 0.f;
#pragma unroll
            for (int j = 0; j < 8; ++j) { v[j] = *(const pg8::f32x4*)(x + (size_t)row * 2048 + j * 256 + lane * 4); ss += (v[j][0] * v[j][0] + v[j][1] * v[j][1]) + (v[j][2] * v[j][2] + v[j][3] * v[j][3]); }
            const float rstd = rsqrtf(wave_sum(ss) * (1.f / 2048.f) + 1e-6f);
            float fa[8] = {0.f, 0.f, 0.f, 0.f, 0.f, 0.f, 0.f, 0.f};
#pragma unroll
            for (int j = 0; j < 8; ++j) { const int c = j * 256 + lane * 4; const pg8::f32x4 a1 = *(const LAS pg8::f32x4*)(A1 + c), s1 = *(const LAS pg8::f32x4*)(S1 + c);
                const pg8::f32x4 h = v[j] * rstd * a1 + s1;
                uint2 pk; pk.x = pk2(h[0], h[1]); pk.y = pk2(h[2], h[3]); *(uint2*)(xn + (size_t)row * 2048 + c) = pk;
#pragma unroll
                for (int hh = 0; hh < 8; ++hh) { const pg8::f32x4 w = *(const LAS pg8::f32x4*)(WFT + hh * 2048 + c); fa[hh] += (h[0] * w[0] + h[1] * w[1]) + (h[2] * w[2] + h[3] * w[3]); }
                asm volatile("" ::: "memory"); }
            float t = 0.f;
#pragma unroll
            for (int hh = 0; hh < 8; ++hh) { const float sm = wave_sum(fa[hh]); if (lane == hh) t = sm; }
            if (lane < 8) logf_[(size_t)((row >> 13) * 8 + lane) * 8192 + (row & 8191)] = log_sigmoid_f(t + fbias[lane]);
        }
    }
    __syncthreads();
}

__device__ __forceinline__ void cumsum_bh(const Args& a, LAS unsigned char* lds, int bh) {
    const int tid = threadIdx.x; unsigned char* ws = a.ws;
    const float* p = (const float*)(ws + W::LOGF) + (size_t)bh * 8192 + tid * 16; float* cum = (float*)(ws + W::CUM) + (size_t)bh * 8192 + tid * 16; float* bias = (float*)(ws + W::BIAS) + (size_t)bh * 8192 + tid * 16;
    LAS double* sc = (LAS double*)(lds + RING_OFF);
    double run = 0.0;
#pragma unroll
    for (int i = 0; i < 16; ++i) run += (double)p[i];
    sc[tid] = run; __syncthreads();
    int cur = 0;
    for (int o = 1; o < 512; o <<= 1) { const double t = sc[cur * 512 + tid] + (tid >= o ? sc[cur * 512 + tid - o] : 0.0); sc[(cur ^ 1) * 512 + tid] = t; cur ^= 1; __syncthreads(); }
    double acc = sc[cur * 512 + tid] - run;
    LAS float* TE = (LAS float*)(lds + RING_OFF + 16384); LAS float* BS = TE + 128; LAS int* JL = (LAS int*)(BS + 32);
#pragma unroll
    for (int i = 0; i < 16; ++i) { acc += (double)p[i]; cum[i] = (float)acc; bias[i] = (float)(-acc * 11.313708498984761);
        if (i == 0 && (tid & 15) == 0) BS[tid >> 4] = (float)acc;
        if (i == 15 && (tid & 3) == 3) TE[tid >> 2] = (float)acc; }
    if (tid < 32) JL[tid] = 4 * tid;
    __syncthreads();
    float mq = 0.f, mk = 0.f;
    for (int i = 0; i < 128; ++i) { mq = fmaxf(mq, fabsf(a.in[7][i])); mk = fmaxf(mk, fabsf(a.in[8][i])); }
    const float thr = 30.f + 2.f * 11.313708498984761f * mq * mk;
    for (int pr = tid; pr < 32 * 128; pr += 512) { const int qb = pr >> 7, j = pr & 127; if (j <= 4 * qb && TE[j] < BS[qb] + thr) atomicMin((int*)(JL + qb), j); }
    __syncthreads();
    if (tid < 32) ((int*)(ws + W::JLO))[bh * 32 + tid] = JL[tid];
    __syncthreads();
}
struct EpiZ {
    static constexpr bool PERM = true, AFTER_DRAIN = false;
    bf16_t* qkv; const float* q_norm_w; const float* k_norm_w; const float* rope; PG8_LAS float* xch;
    __device__ __forceinline__ void operator()(const pg8::f32x4 (&acc)[2][2][4][2], const pg8::Unit& u, int wr, int wc, int fr, int fq) const {
        using pg8::f32x4; using pg8::u32x4;
        const int tt = u.pn >> 2, hp = (u.pn & 3) * 2;
        const int row0 = u.pm * 256 + wr * 64 + fr, b = row0 >> 13, dcol = wc * 32 + 8 * fq;
        bf16_t* base = qkv + (size_t)tt * QKV_ELEMS + ((size_t)(b * 8 + hp) * 8192) * 128 + dcol;
        if (tt < 2) {
#pragma unroll
            for (int ai = 0; ai < 2; ++ai)
#pragma unroll
                for (int m = 0; m < 4; ++m)
#pragma unroll
                    for (int bj = 0; bj < 2; ++bj) { const f32x4 v0 = acc[ai][bj][m][0], v1 = acc[ai][bj][m][1];
                        float s = (v0[0] * v0[0] + v0[1] * v0[1]) + (v0[2] * v0[2] + v0[3] * v0[3]) + (v1[0] * v1[0] + v1[1] * v1[1]) + (v1[2] * v1[2] + v1[3] * v1[3]);
                        s += __shfl_xor(s, 16); s += __shfl_xor(s, 32);
                        if (fq == 0) xch[((ai * 128 + wr * 64 + m * 16 + fr) * 2 + bj) * 4 + wc] = s; }
            asm volatile("s_waitcnt lgkmcnt(0)" ::: "memory"); __builtin_amdgcn_s_barrier(); asm volatile("" ::: "memory");
            const float* nw = tt == 0 ? q_norm_w : k_norm_w; const f32x4 w0 = *(const f32x4*)(nw + dcol), w1 = *(const f32x4*)(nw + dcol + 4);
#pragma unroll
            for (int ai = 0; ai < 2; ++ai)
#pragma unroll
                for (int m = 0; m < 4; ++m) { const int rl = ai * 128 + wr * 64 + m * 16 + fr; const int s_ = (row0 + ai * 128 + m * 16) & 8191;
#pragma unroll
                    for (int bj = 0; bj < 2; ++bj) { const f32x4 p = *(const PG8_LAS f32x4*)(xch + (rl * 2 + bj) * 4);
                        const float rstd = rsqrtf(((p[0] + p[1]) + (p[2] + p[3])) * (1.f / 128.f) + 1e-6f);
                        const f32x4 v0 = acc[ai][bj][m][0] * rstd * w0, v1 = acc[ai][bj][m][1] * rstd * w1;
                        u32x4 w; w.x = pg8::cvt_pk_bf16(v0[0], v0[1]); w.y = pg8::cvt_pk_bf16(v0[2], v0[3]); w.z = pg8::cvt_pk_bf16(v1[0], v1[1]); w.w = pg8::cvt_pk_bf16(v1[2], v1[3]);
                        *(u32x4*)(base + ((size_t)bj * 8192 + s_) * 128) = w; } }
        } else if (tt == 3 || tt == 4) {
            float l2g[2];
#pragma unroll
            for (int bj = 0; bj < 2; ++bj) l2g[bj] = log2f(1.f - exp2f(-5.f - (float)(hp + bj)));
#pragma unroll
            for (int ai = 0; ai < 2; ++ai)
#pragma unroll
                for (int m = 0; m < 4; ++m) { const int s_ = (row0 + ai * 128 + m * 16) & 8191;
                    const f32x4 c0 = *(const f32x4*)(rope + ((size_t)s_ * 64 + (dcol >> 1)) * 2), c1 = *(const f32x4*)(rope + ((size_t)s_ * 64 + (dcol >> 1) + 2) * 2);
#pragma unroll
                    for (int bj = 0; bj < 2; ++bj) { const f32x4 v0 = acc[ai][bj][m][0], v1 = acc[ai][bj][m][1];
                        const float f = tt == 4 ? 0.08838834764831845f * exp2f(-(float)(s_ & 63) * l2g[bj]) : 1.f;
                        const float o0 = (v0[0] * c0[0] - v0[1] * c0[1]) * f, o1 = (v0[0] * c0[1] + v0[1] * c0[0]) * f, o2 = (v0[2] * c0[2] - v0[3] * c0[3]) * f, o3 = (v0[2] * c0[3] + v0[3] * c0[2]) * f;
                        const float o4 = (v1[0] * c1[0] - v1[1] * c1[1]) * f, o5 = (v1[0] * c1[1] + v1[1] * c1[0]) * f, o6 = (v1[2] * c1[2] - v1[3] * c1[3]) * f, o7 = (v1[2] * c1[3] + v1[3] * c1[2]) * f;
                        u32x4 w; w.x = pg8::cvt_pk_bf16(o0, o1); w.y = pg8::cvt_pk_bf16(o2, o3); w.z = pg8::cvt_pk_bf16(o4, o5); w.w = pg8::cvt_pk_bf16(o6, o7);
                        *(u32x4*)(base + ((size_t)bj * 8192 + s_) * 128) = w; } }
        } else {
#pragma unroll
            for (int ai = 0; ai < 2; ++ai)
#pragma unroll
                for (int m = 0; m < 4; ++m) { const int s_ = (row0 + ai * 128 + m * 16) & 8191;
#pragma unroll
                    for (int bj = 0; bj < 2; ++bj) { f32x4 v0 = acc[ai][bj][m][0], v1 = acc[ai][bj][m][1];
                        if (tt == 6) {
#pragma unroll
                            for (int e = 0; e < 4; ++e) { v0[e] = v0[e] / (1.f + __expf(-v0[e])); v1[e] = v1[e] / (1.f + __expf(-v1[e])); } }
                        u32x4 w; w.x = pg8::cvt_pk_bf16(v0[0], v0[1]); w.y = pg8::cvt_pk_bf16(v0[2], v0[3]); w.z = pg8::cvt_pk_bf16(v1[0], v1[1]); w.w = pg8::cvt_pk_bf16(v1[2], v1[3]);
                        *(u32x4*)(base + ((size_t)bj * 8192 + s_) * 128) = w; } }
        }
    }
};


__device__ __forceinline__ void kv_units(const Args& a, char* lds, int G) {
    using namespace at;
    const int tid = threadIdx.x, wid = __builtin_amdgcn_readfirstlane(tid >> 6), lane = tid & 63, r32 = lane & 31, hi = lane >> 5;
    const int sr = tid >> 4, sc = (tid & 15) * 8, st0 = v_st(sr, sc), st1 = v_st(32 + sr, sc);
    const int dblk = wid >> 1, eb0 = (wid & 1) * 2;
    const int kb_ = (int)(uintptr_t)lds + v_rd_base(lane) + dblk * 512, vb_ = (int)(uintptr_t)lds + 32768 + v_rd_base(lane) + eb0 * 512;
    const bf16* q = (const bf16*)(a.ws + W::QKV); float* kvs = (float*)(a.ws + W::KVS);
#define TRRD(dst, base, off) asm volatile("ds_read_b64_tr_b16 %0, %1 offset:%2" : "=&v"(dst) : "v"(base), "i"(off) : "memory")
#define KV_STEP(BUF, KS) do { s16x4 al, ah, b0l, b0h, b1l, b1h; constexpr int o_ = (BUF) * 16384 + (KS) * 4096; \
        TRRD(al, kb_, o_); TRRD(ah, kb_, o_ + 2048); TRRD(b0l, vb_, o_); TRRD(b0h, vb_, o_ + 2048); TRRD(b1l, vb_, o_ + 512); TRRD(b1h, vb_, o_ + 512 + 2048); \
        asm volatile("s_waitcnt lgkmcnt(0)" ::: "memory"); SBAR(); \
        const bf16x8 A_ = {al[0], al[1], al[2], al[3], ah[0], ah[1], ah[2], ah[3]}; \
        acc0 = __builtin_amdgcn_mfma_f32_32x32x16_bf16(A_, (bf16x8){b0l[0], b0l[1], b0l[2], b0l[3], b0h[0], b0h[1], b0h[2], b0h[3]}, acc0, 0, 0, 0); \
        acc1 = __builtin_amdgcn_mfma_f32_32x32x16_bf16(A_, (bf16x8){b1l[0], b1l[1], b1l[2], b1l[3], b1h[0], b1h[1], b1h[2], b1h[3]}, acc1, 0, 0, 0); } while (0)
#define KV_LOAD(T) do { k0 = *(const bf16x8*)(Kp + (unsigned)((64 * (T) + sr) * 128 + sc)); k1 = *(const bf16x8*)(Kp + (unsigned)((64 * (T) + 32 + sr) * 128 + sc)); \
                        v0 = *(const bf16x8*)(Vp + (unsigned)((64 * (T) + sr) * 128 + sc)); v1 = *(const bf16x8*)(Vp + (unsigned)((64 * (T) + 32 + sr) * 128 + sc)); } while (0)
#define KV_WRITE(BUF) do { *(bf16x8*)(lds + (BUF) * 16384 + st0) = k0; *(bf16x8*)(lds + (BUF) * 16384 + st1) = k1; *(bf16x8*)(lds + 32768 + (BUF) * 16384 + st0) = v0; *(bf16x8*)(lds + 32768 + (BUF) * 16384 + st1) = v1; } while (0)
#define KV_TILE(T, BUF) do { if ((T) < 3) KV_LOAD((T) + 1); if ((T) > 0) { acc0 *= g64; acc1 *= g64; } \
        KV_STEP(BUF, 0); KV_STEP(BUF, 1); KV_STEP(BUF, 2); KV_STEP(BUF, 3); if ((T) < 3) { KV_WRITE(1 - (BUF)); } __syncthreads(); } while (0)
    for (int L = blockIdx.x; L < 512; L += G) {
        const int bh = L >> 5, c = L & 31;
        const float l2g = log2f(1.f - exp2f(-5.f - (float)(bh & 7))), g64 = exp2f(64.f * l2g), g63 = exp2f(63.f * l2g);
        const bf16* Kp = q + 4 * QKV_ELEMS + ((size_t)bh * 8192 + c * 256) * 128; const bf16* Vp = q + 5 * QKV_ELEMS + ((size_t)bh * 8192 + c * 256) * 128;
        f32x16 acc0 = {}, acc1 = {}; bf16x8 k0, k1, v0, v1;
        KV_LOAD(0); KV_WRITE(0); __syncthreads();
        KV_TILE(0, 0); KV_TILE(1, 1); KV_TILE(2, 0); KV_TILE(3, 1);
        float* out = kvs + ((size_t)(bh * 32 + c)) * 16384 + (unsigned)((dblk * 32 + 4 * hi) * 128 + eb0 * 32 + r32);
#pragma unroll
        for (int r = 0; r < 16; ++r) { const int ro = (r & 3) + 8 * (r >> 2); out[ro * 128] = g63 * acc0[r]; out[ro * 128 + 32] = g63 * acc1[r]; }
    }
#undef TRRD
#undef KV_STEP
#undef KV_LOAD
#undef KV_WRITE
#undef KV_TILE
}
__device__ __forceinline__ void scan_units(const Args& a, LAS unsigned char* lds, int G) {
    const int tid = threadIdx.x, dl = tid >> 6, e2 = (tid & 63) * 2;
    const float* kvs = (const float*)(a.ws + W::KVS); bf16_t* st = (bf16_t*)(a.ws + W::ST);
    LAS bf16_t* T = (LAS bf16_t*)(lds + RING_OFF);
    for (int L = blockIdx.x; L < 256; L += G) {
        const int bh = L >> 4, d0 = (L & 15) * 8;
        const float g256 = exp2f(256.f * log2f(1.f - exp2f(-5.f - (float)(bh & 7))));
        float2 kv[32];
#pragma unroll
        for (int c = 0; c < 32; ++c) kv[c] = *(const float2*)(kvs + ((size_t)(bh * 32 + c)) * 16384 + (d0 + dl) * 128 + e2);
        float s0 = 0.f, s1 = 0.f;
#pragma unroll
        for (int c = 0; c < 32; ++c) {
            T[e2 * 8 + dl] = (bf16_t)f2bf(s0); T[(e2 + 1) * 8 + dl] = (bf16_t)f2bf(s1);
            __syncthreads();
            if (tid < 128) *(pg8::u32x4*)(st + (((size_t)(bh * 32 + c)) * 128 + tid) * 128 + d0) = *(const LAS pg8::u32x4*)(T + tid * 8);
            s0 = g256 * s0 + kv[c].x; s1 = g256 * s1 + kv[c].y;
            __syncthreads();
        }
    }
}
typedef at::BlockRef<at::bf16, at::bf16> ARef;
template <int MODE> __device__ __forceinline__ ARef attn_ref_bq(const Args& a, int bh, int qb) {
    const int b = bh >> 3, h = bh & 7;
    const at::bf16* q = (const at::bf16*)(a.ws + W::QKV) + (MODE ? 3 * QKV_ELEMS : 0); ARef r;
    r.Q = q + ((size_t)bh * 8192 + qb * 256) * 128; r.K = q + QKV_ELEMS + (size_t)bh * 8192 * 128; r.V = q + 2 * QKV_ELEMS + (size_t)bh * 8192 * 128;
    r.O = (at::bf16*)(a.ws + W::MIX) + ((size_t)(b * 8192 + qb * 256)) * 2048 + (MODE ? 1024 : 0) + h * 128; r.P0 = qb * 256; r.bh = bh; r.jlo = MODE ? 0 : ((const int*)(a.ws + W::JLO))[bh * 32 + qb];
    if (MODE) r.jlo = 4 * qb;
    return r;
}
template <int MODE> __device__ __forceinline__ ARef attn_ref(const Args& a, int L, int pass) { const int bh = L >> 4, x = L & 15; return attn_ref_bq<MODE>(a, bh, pass ? 31 - x : x); }
__device__ __forceinline__ void fox_stream(const Args& a, char* lds) {
    const int tid = threadIdx.x;
    gu32* q = (gu32*)(a.ws + W::CTL) + CW_QFOX; volatile int* tk = (volatile int*)(lds + 100352);
    if (tid == 0) { tk[0] = (int)__hip_atomic_fetch_add(q, 1u, RLX_AGENT); tk[1] = (int)__hip_atomic_fetch_add(q, 1u, RLX_AGENT); }
    __syncthreads();
    int i0 = __builtin_amdgcn_readfirstlane(tk[0]), i1 = __builtin_amdgcn_readfirstlane(tk[1]);
    __syncthreads();
    if (i0 >= 512) return;
    const at::Extra<at::bf16> X{(const float*)(a.ws + W::BIAS), nullptr, nullptr, nullptr};
    ARef cur = attn_ref_bq<0>(a, i0 & 15, 31 - (i0 >> 4));
    at::Seam<at::bf16> S;
    at::causal_swa_prime<at::bf16, at::bf16>(cur, at::WBIG, lds, S);
    for (;;) {
        if (tid == 0) tk[0] = (int)__hip_atomic_fetch_add(q, 1u, RLX_AGENT);
        const bool last = i1 >= 512;
        const ARef nr = last ? cur : attn_ref_bq<0>(a, i1 & 15, 31 - (i1 >> 4));
        const at::NextRef<at::bf16> nxt{nr.Q, nr.K, nr.V, nr.jlo};
        at::causal_swa_block<0, at::bf16, at::bf16>(cur, nxt, X, 8192, at::WBIG, lds, S);
        if (last) break;
        const int i2 = __builtin_amdgcn_readfirstlane(tk[0]);
        __syncthreads();
        cur = attn_ref_bq<0>(a, i1 & 15, 31 - (i1 >> 4)); i0 = i1; i1 = i2;
    }
}
template <int MODE> __device__ __forceinline__ void attn_stream(const Args& a, char* lds, int G) {
    int L = blockIdx.x; if (L >= 256) return;
    int pass = 0; ARef cur = attn_ref<MODE>(a, L, 0);
    const at::Extra<at::bf16> X{(const float*)(a.ws + W::BIAS), (const at::bf16*)(a.ws + W::QKV) + 6 * QKV_ELEMS, a.in[9], (const at::bf16*)(a.ws + W::ST)};
    at::Seam<at::bf16> S;
    at::causal_swa_prime<at::bf16, at::bf16>(cur, at::WBIG, lds, S);
    for (;;) {
        const bool more_pass = pass == 0, more_item = L + G < 256, last = !more_pass && !more_item;
        int Ln = L, passn = 1; if (!more_pass) { passn = 0; Ln = more_item ? L + G : L; }
        const ARef nr = last ? cur : attn_ref<MODE>(a, Ln, passn);
        const at::NextRef<at::bf16> nxt{nr.Q, nr.K, nr.V, nr.jlo};
        at::causal_swa_block<MODE, at::bf16, at::bf16>(cur, nxt, X, 8192, at::WBIG, lds, S);
        if (last) break;
        cur = attn_ref<MODE>(a, Ln, passn); L = Ln; pass = passn;
    }
}


struct EpiX1 {
    static constexpr bool PERM = false, AFTER_DRAIN = false;
    const float* x; const float* mod; float* out;
    __device__ __forceinline__ void operator()(const pg8::f32x4 (&acc)[2][2][4][2], const pg8::Unit& u, int wr, int wc, int fr, int fq) const {
        using pg8::f32x4;
        const int row0 = u.pm * 256 + wr * 64 + fr, b = row0 >> 13, col0 = u.pn * 256 + wc * 32 + 4 * fq;
        f32x4 g[2][2];
#pragma unroll
        for (int bj = 0; bj < 2; ++bj)
#pragma unroll
            for (int n = 0; n < 2; ++n) g[bj][n] = *(const f32x4*)(mod + b * 12288 + 4096 + col0 + bj * 128 + n * 16);
#pragma unroll
        for (int ai = 0; ai < 2; ++ai)
#pragma unroll
            for (int m = 0; m < 4; ++m) { const size_t off = (size_t)(row0 + ai * 128 + m * 16) * 2048 + col0;
#pragma unroll
                for (int bj = 0; bj < 2; ++bj)
#pragma unroll
                    for (int n = 0; n < 2; ++n) { const f32x4 xv = *(const f32x4*)(x + off + bj * 128 + n * 16); *(f32x4*)(out + off + bj * 128 + n * 16) = xv + g[bj][n] * acc[ai][bj][m][n]; }
                if (m & 1) asm volatile("" ::: "memory"); }
    }
};

__device__ __forceinline__ void router_tables(const Args& a, LAS unsigned char* lds, int b) {
    const int tid = threadIdx.x, lane = tid & 63, wave = __builtin_amdgcn_readfirstlane(tid >> 6);
    const float* norm2_w = a.in[11]; const float* w_coarse = a.in[12]; const float* b_coarse = a.in[13]; const float* w_fine = a.in[14]; const float* b_fine = a.in[15];
    const float* mod = (const float*)(a.ws + W::MOD) + b * 12288; float* tab = (float*)(a.ws + W::A2S2);
    LAS float* S2 = (LAS float*)(lds + RING_OFF); LAS float* RD = S2 + 2048;
    for (int cc = tid; cc < 2048; cc += 512) { const float sv = mod[6144 + cc]; tab[b * 2048 + cc] = norm2_w[cc] * (1.f + mod[8192 + cc]); tab[4096 + b * 2048 + cc] = sv; S2[cc] = sv; }
    __syncthreads();
    for (int c0 = 0; c0 < 36; c0 += 4) { float part[4] = {0.f, 0.f, 0.f, 0.f};
#pragma unroll
        for (int q = 0; q < 4; ++q) { const int k = tid * 4 + q; const float sv = S2[k];
            const float4 wv = c0 == 0 ? *(const float4*)(w_coarse + (size_t)k * 4) : *(const float4*)(w_fine + ((size_t)((c0 - 4) >> 3) * 2048 + k) * 8 + ((c0 - 4) & 7));
            part[0] += sv * wv.x; part[1] += sv * wv.y; part[2] += sv * wv.z; part[3] += sv * wv.w; }
#pragma unroll
        for (int i = 0; i < 4; ++i) { const float t = wave_sum(part[i]); if (lane == 0) RD[(c0 + i) * 8 + wave] = t; } }
    __syncthreads();
    if (tid < 36) { float t = tid < 4 ? b_coarse[tid] : b_fine[tid - 4];
        for (int w = 0; w < 8; ++w) t += RD[tid * 8 + w];
        tab[8192 + b * 64 + tid] = t; }
    __syncthreads();
}
typedef short bfx8 __attribute__((ext_vector_type(8)));
__device__ __forceinline__ void split8(const float* v, bfx8& h, bfx8& l) {
    unsigned hw[4], lw[4];
#pragma unroll
    for (int i = 0; i < 4; ++i) { const unsigned h0 = f2bf(v[2 * i]), h1 = f2bf(v[2 * i + 1]); hw[i] = h0 | (h1 << 16);
        const float r0 = v[2 * i] - __uint_as_float(h0 << 16), r1 = v[2 * i + 1] - __uint_as_float(h1 << 16); lw[i] = f2bf(r0) | (f2bf(r1) << 16); }
    typedef unsigned u4 __attribute__((ext_vector_type(4)));
    const u4 hv = {hw[0], hw[1], hw[2], hw[3]}, lv = {lw[0], lw[1], lw[2], lw[3]};
    h = __builtin_bit_cast(bfx8, hv); l = __builtin_bit_cast(bfx8, lv);
}
__device__ __forceinline__ void ph5(const Args& a, LAS unsigned char* lds, int G) {
    using pg8::f32x4;
    const int tid = threadIdx.x, lane = tid & 63, wave = __builtin_amdgcn_readfirstlane(tid >> 6), fr = lane & 15, fq = lane >> 4;
    unsigned char* ws = a.ws; const float* x1 = a.out; bf16_t* h2 = (bf16_t*)(ws + W::H2);
    const float* tab = (const float*)(ws + W::A2S2);
    int* r_eid = (int*)(ws + W::ROUTE); float* r_gate = (float*)(ws + W::ROUTE + 128 * 1024); int* r_idx = (int*)(ws + W::ROUTE + 256 * 1024); int* cnt = (int*)(ws + W::CTL) + CW_CNT;
    constexpr int XP = 2052;
    LAS float* XT = (LAS float*)(lds + RING_OFF); LAS float* PART = XT + 16 * XP; LAS float* RS = PART + 8 * 16 * 36; LAS float* LG = RS + 16; LAS int* CH = (LAS int*)(LG + 16 * 36); LAS int* LC = CH + 128; LAS int* LB = LC + 32;
    const bfx8* wfr = (const bfx8*)(ws + W::WFR) + (size_t)(wave * 8) * 6 * 64;
    int T = blockIdx.x * 4; if (T >= 1024) return;
    f32x4 xn[16];
#define RT_LOAD(TT) do { _Pragma("unroll") for (int q = 0; q < 2; ++q) _Pragma("unroll") for (int j = 0; j < 8; ++j) \
        xn[q * 8 + j] = *(const f32x4*)(x1 + (size_t)((TT) * 16 + 2 * wave + q) * 2048 + j * 256 + lane * 4); } while (0)
    RT_LOAD(T);
    for (;;) {
        const int r0 = T * 16, b = r0 >> 13;
#pragma unroll
        for (int q = 0; q < 2; ++q) { const int rl = 2 * wave + q; float ss = 0.f;
#pragma unroll
            for (int j = 0; j < 8; ++j) { const f32x4 v = xn[q * 8 + j]; ss += (v[0] * v[0] + v[1] * v[1]) + (v[2] * v[2] + v[3] * v[3]); *(LAS f32x4*)(XT + rl * XP + j * 256 + lane * 4) = v; }
            ss = wave_sum(ss); if (lane == 0) RS[rl] = rsqrtf(ss * (1.f / 2048.f) + 1e-6f); }
        __syncthreads();
        const int Tn = (T & 3) < 3 ? T + 1 : T - 3 + 4 * G; const bool has_next = Tn < 1024;
        if (has_next) RT_LOAD(Tn);
        f32x4 acc[3] = {{0.f, 0.f, 0.f, 0.f}, {0.f, 0.f, 0.f, 0.f}, {0.f, 0.f, 0.f, 0.f}};
        unsigned ln = lane; asm volatile("" : "+v"(ln));
#pragma unroll 2
        for (int ks = 0; ks < 8; ++ks) { const int k = 256 * wave + 32 * ks + 8 * fq;
            const f32x4 v0 = *(const LAS f32x4*)(XT + fr * XP + k), v1 = *(const LAS f32x4*)(XT + fr * XP + k + 4);
            const f32x4 a0 = *(const f32x4*)(tab + b * 2048 + k), a1 = *(const f32x4*)(tab + b * 2048 + k + 4);
            const float av[8] = {v0[0] * a0[0], v0[1] * a0[1], v0[2] * a0[2], v0[3] * a0[3], v1[0] * a1[0], v1[1] * a1[1], v1[2] * a1[2], v1[3] * a1[3]};
            bfx8 ah, al; split8(av, ah, al);
#pragma unroll
            for (int ob = 0; ob < 3; ++ob) { const bfx8 bh = (wfr + ((ks * 3 + ob) * 2) * 64)[ln], bl = (wfr + ((ks * 3 + ob) * 2 + 1) * 64)[ln];
                acc[ob] = __builtin_amdgcn_mfma_f32_16x16x32_bf16(ah, bh, acc[ob], 0, 0, 0);
                acc[ob] = __builtin_amdgcn_mfma_f32_16x16x32_bf16(al, bh, acc[ob], 0, 0, 0);
                acc[ob] = __builtin_amdgcn_mfma_f32_16x16x32_bf16(ah, bl, acc[ob], 0, 0, 0); } }
#pragma unroll
        for (int ob = 0; ob < 3; ++ob) { const int o = ob * 16 + fr;
            if (o < 36) {
#pragma unroll
                for (int r = 0; r < 4; ++r) PART[(wave * 16 + 4 * fq + r) * 36 + o] = acc[ob][r]; } }
        __syncthreads();
        for (int it = tid; it < 576; it += 512) { const int rl = it / 36, o = it - rl * 36; float t = 0.f;
#pragma unroll
            for (int w = 0; w < 8; ++w) t += PART[(w * 16 + rl) * 36 + o];
            LG[it] = RS[rl] * t + tab[8192 + b * 64 + o]; }
        __syncthreads();
        if (tid < 16) { const int row = r0 + tid; const LAS float* lg = LG + tid * 36;
            int gs = 0; float cmax = lg[0];
#pragma unroll
            for (int g = 1; g < 4; ++g) if (lg[g] > cmax) { cmax = lg[g]; gs = g; }
            float den = 0.f;
#pragma unroll
            for (int g = 0; g < 4; ++g) den += expf(lg[g] - cmax);
            const float pg = 1.f / den;
            float f0 = -3.0e38f, f1 = -3.0e38f; int e0 = 0, e1 = 0;
#pragma unroll
            for (int e = 0; e < 8; ++e) { const float fl = lg[4 + gs * 8 + e];
                if (fl > f0) { f1 = f0; e1 = e0; f0 = fl; e0 = e; } else if (fl > f1) { f1 = fl; e1 = e; } }
            const float t1 = expf(f1 - f0); const float g0 = pg / (1.f + t1), g1 = pg * t1 / (1.f + t1);
            const int E0 = gs * 8 + e0, E1 = gs * 8 + e1;
            r_eid[2 * row] = E0; r_eid[2 * row + 1] = E1; r_gate[2 * row] = g0; r_gate[2 * row + 1] = g1;
            CH[((T & 3) * 16 + tid) * 2] = E0; CH[((T & 3) * 16 + tid) * 2 + 1] = E1; }
#pragma unroll
        for (int q = 0; q < 2; ++q) { const int rl = 2 * wave + q; const float rstd = RS[rl]; unsigned char* hrow = (unsigned char*)h2 + (size_t)(r0 + rl) * 2048;
#pragma unroll
            for (int j = 0; j < 8; ++j) { const int c = j * 256 + lane * 4; const f32x4 xv = *(const LAS f32x4*)(XT + rl * XP + c);
                const f32x4 aa = *(const f32x4*)(tab + b * 2048 + c), sv = *(const f32x4*)(tab + 4096 + b * 2048 + c);
                *(unsigned*)(hrow + c) = pk4_fp8(xv[0] * rstd * aa[0] + sv[0], xv[1] * rstd * aa[1] + sv[1], xv[2] * rstd * aa[2] + sv[2], xv[3] * rstd * aa[3] + sv[3]); } }
        __syncthreads();
        if ((T & 3) == 3) {
            if (tid < 32) LC[tid] = 0;
            __syncthreads();
            int rk = 0, ee = 0;
            if (tid < 128) { ee = CH[tid]; rk = atomicAdd((int*)(LC + ee), 1); }
            __syncthreads();
            if (tid < 32) { const int n = LC[tid]; LB[tid] = n ? atomicAdd(cnt + tid * CNT_STRIDE, n) : 0; }
            __syncthreads();
            if (tid < 128) r_idx[(size_t)(T >> 2) * 128 + tid] = LB[ee] + rk;
            __syncthreads();
        }
        if (!has_next) break;
        T = Tn;
    }
#undef RT_LOAD
}
__device__ __forceinline__ void ph6(const Args& a, LAS unsigned char* lds, int G) {
    const int tid = threadIdx.x, lane = tid & 63, wave = __builtin_amdgcn_readfirstlane(tid >> 6);
    unsigned char* ws = a.ws;
    const int* cnt = (const int*)(ws + W::CTL) + CW_CNT; int* pstart_g = (int*)(ws + W::TILE); int* tile_e = pstart_g + 64; int* ntile = pstart_g + 512;
    const int* r_eid = (const int*)(ws + W::ROUTE); const int* r_idx = (const int*)(ws + W::ROUTE + 256 * 1024); int* r_slot = (int*)(ws + W::ROUTE + 384 * 1024);
    LAS int* ps = (LAS int*)(lds + RING_OFF);
    if (tid == 0) { int p = 0, t = 0;
        for (int e = 0; e < 32; ++e) { ps[e] = p; const int n = (cnt[e * CNT_STRIDE] + 255) >> 8; if (blockIdx.x == 0) { pstart_g[e] = p; for (int i = 0; i < n; ++i) tile_e[t + i] = e; } t += n; p += n * 256; }
        ps[32] = p; if (blockIdx.x == 0) { pstart_g[32] = p; *ntile = t; } }
    __syncthreads();
    const bf16_t* h2 = (const bf16_t*)(ws + W::H2); bf16_t* xs = (bf16_t*)(ws + W::XS);
    for (int mk = blockIdx.x * NWAVES + wave; mk < 2 * M_TOK; mk += G * NWAVES) {
        const int slot = ps[r_eid[mk]] + r_idx[mk]; if (lane == 0) r_slot[mk] = slot;
        const uint4* src = (const uint4*)((const unsigned char*)h2 + (size_t)(mk >> 1) * 2048) + lane; uint4* dst = (uint4*)((unsigned char*)xs + (size_t)slot * 2048) + lane;
        uint4 v[2];
#pragma unroll
        for (int j = 0; j < 2; ++j) v[j] = src[64 * j];
#pragma unroll
        for (int j = 0; j < 2; ++j) dst[64 * j] = v[j];
    }
    __syncthreads();
}
template <int LOG2_NN> struct GroupedOrder {
    const int* tile_e; int nunits, G, c;
    __device__ void init(const int* tile_e_, const int* ntile, int G_, int c_) { tile_e = tile_e_; nunits = *ntile << LOG2_NN; G = G_; c = c_; }
    __device__ bool next(int i, pg8::Unit& u) const { const int L = i * G + c; if (L >= nunits) return false; u.pm = L >> LOG2_NN; u.pn = L & ((1 << LOG2_NN) - 1); u.e = tile_e[u.pm]; return true; }
    __device__ __forceinline__ void a_ready(const pg8::Unit&) const {}
    __device__ __forceinline__ void done(const pg8::Unit&) const {}
};
struct EpiUp {
    static constexpr bool PERM = true, AFTER_DRAIN = false;
    bf16_t* act;
    __device__ __forceinline__ void operator()(const pg8::f32x4 (&acc)[2][2][4][2], const pg8::Unit& u, int wr, int wc, int fr, int fq) const {
        using pg8::f32x4;
        const int row0 = u.pm * 256 + wr * 64 + fr, col0 = u.pn * 128 + wc * 16 + 4 * fq;
#pragma unroll
        for (int ai = 0; ai < 2; ++ai)
#pragma unroll
            for (int m = 0; m < 4; ++m) { bf16_t* rowp = act + (size_t)(row0 + ai * 128 + m * 16) * 512 + col0;
#pragma unroll
                for (int bj = 0; bj < 2; ++bj) { const f32x4 av = acc[ai][bj][m][0] * (1.f / SC13), bv = acc[ai][bj][m][1] * (1.f / SC13); float o[4];
#pragma unroll
                    for (int e = 0; e < 4; ++e) o[e] = av[e] * __builtin_amdgcn_rcpf(1.f + __expf(-av[e])) * bv[e];
                    uint2 w; w.x = pg8::cvt_pk_bf16(o[0], o[1]); w.y = pg8::cvt_pk_bf16(o[2], o[3]);
                    *(uint2*)(rowp + bj * 64) = w; } }
    }
};
__device__ __forceinline__ void ph9(const Args& a, int G) {
    const int tid = threadIdx.x, lane = tid & 63, wave = __builtin_amdgcn_readfirstlane(tid >> 6);
    unsigned char* ws = a.ws; float* out = a.out;
    const float* mod = (const float*)(ws + W::MOD); const bf16_t* y = (const bf16_t*)(ws + W::Y);
    const float* r_gate = (const float*)(ws + W::ROUTE + 128 * 1024); const int* r_slot = (const int*)(ws + W::ROUTE + 384 * 1024);
    int m = blockIdx.x * NWAVES + wave; if (m >= M_TOK) return;
    int s0 = r_slot[2 * m], s1 = r_slot[2 * m + 1]; float g0 = r_gate[2 * m], g1 = r_gate[2 * m + 1];
    for (;;) {
        const int mn = m + G * NWAVES; const bool more = mn < M_TOK; const int mq = more ? mn : m;
        const int s0n = r_slot[2 * mq], s1n = r_slot[2 * mq + 1]; const float g0n = r_gate[2 * mq], g1n = r_gate[2 * mq + 1];
        const float* g2 = mod + (m >> 13) * 12288 + 10240;
#pragma unroll
        for (int j = 0; j < 4; ++j) { const int c = j * 512 + lane * 8;
            const pg8::u32x4 ya = *(const pg8::u32x4*)(y + (size_t)s0 * 2048 + c), yb = *(const pg8::u32x4*)(y + (size_t)s1 * 2048 + c);
            const pg8::f32x4 x0 = *(const pg8::f32x4*)(out + (size_t)m * 2048 + c), x1v = *(const pg8::f32x4*)(out + (size_t)m * 2048 + c + 4);
            const pg8::f32x4 ga = *(const pg8::f32x4*)(g2 + c), gb = *(const pg8::f32x4*)(g2 + c + 4);
            pg8::f32x4 o0, o1;
#pragma unroll
            for (int e = 0; e < 2; ++e) { o0[2 * e] = x0[2 * e] + ga[2 * e] * (g0 * __uint_as_float(ya[e] << 16) + g1 * __uint_as_float(yb[e] << 16));
                o0[2 * e + 1] = x0[2 * e + 1] + ga[2 * e + 1] * (g0 * __uint_as_float(ya[e] & 0xffff0000u) + g1 * __uint_as_float(yb[e] & 0xffff0000u));
                o1[2 * e] = x1v[2 * e] + gb[2 * e] * (g0 * __uint_as_float(ya[2 + e] << 16) + g1 * __uint_as_float(yb[2 + e] << 16));
                o1[2 * e + 1] = x1v[2 * e + 1] + gb[2 * e + 1] * (g0 * __uint_as_float(ya[2 + e] & 0xffff0000u) + g1 * __uint_as_float(yb[2 + e] & 0xffff0000u)); }
            *(pg8::f32x4*)(out + (size_t)m * 2048 + c) = o0; *(pg8::f32x4*)(out + (size_t)m * 2048 + c + 4) = o1; }
        if (!more) break;
        m = mn; s0 = s0n; s1 = s1n; g0 = g0n; g1 = g1n;
    }
}

__global__ void __launch_bounds__(NWAVES * 64, 2) mk_fwd(Args args) {
    extern __shared__ __attribute__((aligned(16))) unsigned char lds_raw[];
    LAS unsigned char* lds = (LAS unsigned char*)lds_raw;
    volatile LAS unsigned* MISC = (volatile LAS unsigned*)(lds + MISC_OFF);
    const int tid = threadIdx.x, G = gridDim.x;
    unsigned char* ws = args.ws; gu32* ctl = (gu32*)(ws + W::CTL);
    for (int u = tid; u < (LDS_BYTES - MISC_OFF) / 4; u += NWAVES * 64) ((LAS unsigned*)(lds + MISC_OFF))[u] = 0u;
    __syncthreads();
    const int lo = args.ph_lo, hi = args.ph_hi;
    XcdBarrier bar; bar.bar = (unsigned*)(ctl + CW_BAR) + args.li * XCD_BAR_WORDS; bar.x = 0; bar.st = nullptr;
    if (hi - lo > 1) bar = xcd_barrier_post((unsigned*)(ctl + CW_BAR) + args.li * XCD_BAR_WORDS, MISC + 8);
#define IN(k) (lo <= (k) && (k) < hi)
#define BOTH(k) (IN(k) && IN((k) + 1))
    if (IN(0)) { ph0(args, lds, G); if (BOTH(0)) xcd_barrier(bar); }
    if (IN(1)) { ph1(args, lds, G); if (BOTH(1)) xcd_barrier(bar); }
    if (IN(2)) {
        for (int bh = blockIdx.x; bh < 16; bh += G) cumsum_bh(args, lds, bh);
        for (int b = (int)blockIdx.x - 16; b < 2; b += G) if (b >= 0) router_tables(args, lds, b);
        pg8::Gemm g{(const bf16_t*)(ws + W::XN), (const bf16_t*)(ws + W::WT_IN), M_TOK, 7168, 2048, 0};
        pg8::StaticOrder S; S.init(M_TOK, 7168, G, (int)blockIdx.x);
        EpiZ E{(bf16_t*)(ws + W::QKV), args.in[7], args.in[8], (const float*)(ws + W::ROPE), (PG8_LAS float*)(lds + XCH_OFF)};
        pg8::gemm_phase<EpiZ, pg8::StaticOrder, true, true>(lds + RING_OFF, g, S, E);
        if (BOTH(2)) xcd_barrier(bar);
    }
    if (IN(3)) { kv_units(args, (char*)lds_raw + RING_OFF, G); fox_stream(args, (char*)lds_raw + RING_OFF); if (BOTH(3)) xcd_barrier(bar); }
    if (IN(4)) { scan_units(args, lds, G); if (BOTH(4)) xcd_barrier(bar); }
    if (IN(5)) { attn_stream<1>(args, (char*)lds_raw + RING_OFF, G); if (BOTH(5)) xcd_barrier(bar); }
    if (IN(6)) {
        pg8::Gemm g{(const bf16_t*)(ws + W::MIX), (const bf16_t*)(ws + W::WT_OUT), M_TOK, 2048, 2048, 0};
        pg8::StaticOrder S; S.init(M_TOK, 2048, G, (int)blockIdx.x);
        EpiX1 E{args.in[0], (const float*)(ws + W::MOD), args.out};
        pg8::gemm_phase<EpiX1, pg8::StaticOrder, true, true>(lds + RING_OFF, g, S, E);
        if (BOTH(6)) xcd_barrier(bar);
    }
    if (IN(7)) { ph5(args, lds, G); if (BOTH(7)) xcd_barrier(bar); }
    if (IN(8)) { ph6(args, lds, G); if (BOTH(8)) xcd_barrier(bar); }
    if (IN(9)) {
        pg8::Gemm g{(const bf16_t*)(ws + W::XS), (const bf16_t*)(ws + W::WT_13), 0, 1024, 2048, (size_t)1024 * 2048};
        GroupedOrder<2> S; S.init((const int*)(ws + W::TILE) + 64, (const int*)(ws + W::TILE) + 512, G, (int)blockIdx.x);
        EpiUp E{(bf16_t*)(ws + W::ACT)};
        pg8::gemm_phase<EpiUp, GroupedOrder<2>, true, true, 1>(lds + RING_OFF, g, S, E);
        if (BOTH(9)) xcd_barrier(bar);
    }
    if (IN(10)) {
        pg8::Gemm g{(const bf16_t*)(ws + W::ACT), (const bf16_t*)(ws + W::WT_2), 0, 2048, 512, (size_t)2048 * 512 * 2};
        GroupedOrder<3> S; S.init((const int*)(ws + W::TILE) + 64, (const int*)(ws + W::TILE) + 512, G, (int)blockIdx.x);
        pg8::EpiBf16<0> E{(bf16_t*)(ws + W::Y), 2048, nullptr, 0, 0, 1.f};
        pg8::gemm_phase<pg8::EpiBf16<0>, GroupedOrder<3>, true, true>(lds + RING_OFF, g, S, E);
        if (BOTH(10)) xcd_barrier(bar);
    }
    if (IN(11)) ph9(args, G);
#undef IN
#undef BOTH
}
extern "C" void kernel_launch(void* const* d_in, const int* in_sizes, int n_in, void* d_out, int out_size, void* d_ws, size_t ws_size, hipStream_t stream) {
    static int grid = 0;
    if (grid == 0) {
        if (n_in != 19 || out_size != M_TOK * DM || ws_size < W::END) { fprintf(stderr, "kernel_launch: built for 19 inputs, %d outputs, >= %zu bytes of workspace; got %d, %d, %zu\n", M_TOK * DM, (size_t)W::END, n_in, out_size, ws_size); grid = -1; return; }
        int dev = 0, cus = 0, per_cu = 0;
        if (hipGetDevice(&dev) != hipSuccess || hipDeviceGetAttribute(&cus, hipDeviceAttributeMultiprocessorCount, dev) != hipSuccess) { fprintf(stderr, "kernel_launch: device query failed\n"); grid = -1; return; }
        if (hipFuncSetAttribute((const void*)mk_fwd, hipFuncAttributeMaxDynamicSharedMemorySize, LDS_BYTES) != hipSuccess) { fprintf(stderr, "kernel_launch: hipFuncSetAttribute failed\n"); grid = -1; return; }
        if (hipOccupancyMaxActiveBlocksPerMultiprocessor(&per_cu, (const void*)mk_fwd, NWAVES * 64, LDS_BYTES) != hipSuccess || per_cu < 1) { fprintf(stderr, "kernel_launch: occupancy query says %d workgroups per CU\n", per_cu); (void)hipGetLastError(); grid = -1; return; }
        grid = cus;
    }
    if (grid < 0) return;
    (void)hipMemsetAsync((char*)d_ws + W::CTL, 0, W::CTL_ZERO_BYTES, stream);
    Args a{};
    for (int i = 0; i < 19; ++i) a.in[i] = (const float*)d_in[i];
    a.out = (float*)d_out; a.ws = (unsigned char*)d_ws; a.ph_lo = 0; a.ph_hi = 12; a.li = 0;
    hipLaunchKernelGGL(mk_fwd, dim3(grid), dim3(NWAVES * 64), LDS_BYTES, stream, a);
}
```

```cpp
#include <hip/hip_runtime.h>
#include <cstdio>
#include <cstdint>
typedef unsigned short bf16_t;
__device__ __forceinline__ float bf2f(bf16_t v) { return __uint_as_float(((unsigned)v) << 16); }
__device__ __forceinline__ unsigned f2bf(float f) { const unsigned u = __float_as_uint(f); return (u + 0x7fffu + ((u >> 16) & 1u)) >> 16; }

constexpr size_t MiB = 1u << 20;
constexpr int M_TOK = 16384, SEQ = 8192, DM = 2048;
constexpr size_t QKV_ELEMS = (size_t)16 * 8192 * 128;
namespace pg8 {
#define PG8_LAS __attribute__((address_space(3)))
typedef short bf16x8 __attribute__((ext_vector_type(8)));
typedef float f32x4 __attribute__((ext_vector_type(4)));
typedef unsigned u32x4 __attribute__((ext_vector_type(4)));
constexpr int BM = 256, BK = 64, HALF = 128, HTB = HALF * BK * 2  , STAGE_BYTES = 8 * HTB, NXCD = 8, WGM = 8;

__host__ __device__ __forceinline__ int lds_byte(int r, int c) { const int st = (r >> 4) * 2 + (c >> 5), rr = r & 15, cc = c & 31, ob = rr * 64 + cc * 2; return st * 1024 + (ob ^ (((ob >> 9) & 1) << 5)); }
__host__ __device__ __forceinline__ void stage_rc(int b, int& R, int& C) { const int st = b / 1024, sb = b % 1024, swz = sb ^ (((sb >> 9) & 1) << 5); R = (st >> 1) * 16 + swz / 64; C = (st & 1) * 32 + (swz % 64) / 2; }
__host__ __device__ __forceinline__ int perm32(int rho) { const int n = rho >> 4, i = rho & 15; return 8 * (i >> 2) + 4 * n + (i & 3); }

struct Unit { int pm, pn, e; };
struct Gemm { const bf16_t* A; const bf16_t* Bt; int M, N, K; size_t estride; };

struct StaticOrder {
    int nM, nN, nwg, G, c;
    __host__ __device__ void init(int M, int N, int G_, int c_) { nM = M / BM; nN = N / BM; nwg = nM * nN; G = G_; c = c_; }
    __host__ __device__ bool next(int i, Unit& u) const {
        const long L = (long)i * G + c; if (L >= nwg) return false;
        int wgid = (int)L; { const int q = nwg / NXCD, r = nwg % NXCD, xcd = wgid % NXCD, off = wgid / NXCD; wgid = (xcd < r ? xcd * (q + 1) : r * (q + 1) + (xcd - r) * q) + off; }
        const int nig = WGM * nN, gid = wgid / nig, fm = gid * WGM, gsz = (nM - fm) < WGM ? (nM - fm) : WGM;
        u.pm = fm + ((wgid % nig) % gsz); u.pn = (wgid % nig) / gsz; u.e = 0; return true;
    }
    __device__ __forceinline__ void a_ready(const Unit&) const {}
    __device__ __forceinline__ void done(const Unit&) const {}
};

__device__ __forceinline__ unsigned cvt_pk_bf16(float lo, float hi) { unsigned r; asm volatile("v_cvt_pk_bf16_f32 %0, %1, %2" : "=v"(r) : "v"(lo), "v"(hi)); return r; }
typedef float f32x2 __attribute__((ext_vector_type(2)));
__device__ __forceinline__ f32x2 gelu_pk(f32x2 v) {
    const f32x2 av = __builtin_elementwise_abs(v), d = av * 0.2316418882f + 1.0f;
    f32x2 t; t.x = __builtin_amdgcn_rcpf(d.x); t.y = __builtin_amdgcn_rcpf(d.y);
    f32x2 q = t * 0.5307027145f + (-0.7265760135f); q = q * t + 0.7107068705f; q = q * t + (-0.142248368f); q = q * t + 0.127414796f; q = q * t;
    const f32x2 s = (v * v) * (-0.72134752044f);
    f32x2 e; e.x = __builtin_amdgcn_exp2f(s.x); e.y = __builtin_amdgcn_exp2f(s.y);
    const f32x2 m = v * (q * e), r = v - m;
    f32x2 o; o.x = v.x < 0.f ? m.x : r.x; o.y = v.y < 0.f ? m.y : r.y; return o;
}

template <int ACT  > struct EpiBf16 {
    static constexpr bool PERM = true, AFTER_DRAIN = false; static_assert(ACT == 0 || ACT == 1, "EpiBf16: ACT is 0 (none) or 1 (gelu_pk)");
    bf16_t* O; int ldc; const float* bias; int split_cols; size_t split_stride; float scale0;
    __device__ __forceinline__ void operator()(const f32x4 (&acc)[2][2][4][2], const Unit& u, int wr, int wc, int fr, int fq) const {
        const int row0 = u.pm * BM + wr * 64 + fr; int colt = u.pn * BM; bf16_t* base = O;
        float sc = 1.f; if (split_cols) { const int t = colt / split_cols; base += (size_t)t * split_stride; colt -= t * split_cols; if (t == 0) sc = scale0; }
        const int col0 = colt + wc * 32 + 8 * fq, bcol0 = u.pn * BM + wc * 32 + 8 * fq;
        f32x4 bv[2][2];
#pragma unroll
        for (int bj = 0; bj < 2; ++bj)
#pragma unroll
            for (int n = 0; n < 2; ++n) bv[bj][n] = bias ? *(const f32x4*)(bias + bcol0 + bj * HALF + 4 * n) : (f32x4){0.f, 0.f, 0.f, 0.f};
#pragma unroll
        for (int ai = 0; ai < 2; ++ai)
#pragma unroll
            for (int m = 0; m < 4; ++m) { bf16_t* rowp = base + (size_t)(row0 + ai * HALF + m * 16) * ldc + col0;
#pragma unroll
                for (int bj = 0; bj < 2; ++bj) { f32x4 v0 = acc[ai][bj][m][0] + bv[bj][0], v1 = acc[ai][bj][m][1] + bv[bj][1];
                    if (ACT == 1) { f32x2 a = gelu_pk((f32x2){v0[0], v0[1]}), b = gelu_pk((f32x2){v0[2], v0[3]}), c = gelu_pk((f32x2){v1[0], v1[1]}), d = gelu_pk((f32x2){v1[2], v1[3]});
                        v0 = (f32x4){a.x, a.y, b.x, b.y}; v1 = (f32x4){c.x, c.y, d.x, d.y}; }
                    v0 = v0 * sc; v1 = v1 * sc; u32x4 w; w.x = cvt_pk_bf16(v0[0], v0[1]); w.y = cvt_pk_bf16(v0[2], v0[3]); w.z = cvt_pk_bf16(v1[0], v1[1]); w.w = cvt_pk_bf16(v1[2], v1[3]);
                    *(u32x4*)(rowp + bj * HALF) = w; } }
    }
};
template <class Epi, class Sched, bool ALIGN_EPI = false, bool SP2 = false, int ESZ = 2>
__device__ __forceinline__ void gemm_phase(PG8_LAS unsigned char* lds, const Gemm g, const Sched& S, const Epi& E) {
    const int tid = threadIdx.x, wid = __builtin_amdgcn_readfirstlane(tid >> 6), lane = tid & 63, wr = wid >> 2, wc = wid & 3, fr = lane & 15, fq = lane >> 4;
    int Kraw = g.K; asm volatile("" : "+s"(Kraw));
    const int K = ESZ == 1 ? Kraw / 2 : Kraw, nt = K / BK;
    unsigned voffA[2], voffB[2];
#pragma unroll
    for (int i = 0; i < 2; ++i) { int R, C; stage_rc(tid * 16 + i * 8192, R, C); const int Rb = Epi::PERM ? ((R & ~31) + perm32(R & 31)) : R;
        voffA[i] = (unsigned)(R * K + C) * 2u; voffB[i] = (unsigned)(Rb * K + C) * 2u; }
    const size_t kstep = (size_t)(BK * 2);
    const size_t hstep = (size_t)HALF * K * 2;
    const size_t tstep = 2 * hstep;
    const unsigned ldsw = (unsigned)wid * 1024u;
    const int aoff = lds_byte(wr * 64 + fr, fq * 8), boff = lds_byte(wc * 32 + fr, fq * 8);
#define PG8_SA(b, h) (((b) * 2 + (h)) * HTB)
#define PG8_SB(b, h) ((4 + (b) * 2 + (h)) * HTB)
#define PG8_STAGE(bufoff, gbase, voff) do { _Pragma("unroll") for (int _i = 0; _i < 2; ++_i) \
        __builtin_amdgcn_global_load_lds((const unsigned*)((const char*)(gbase) + (voff)[_i]), (PG8_LAS unsigned*)(lds + (bufoff) + ldsw + _i * 8192), 16, 0, 0); } while (0)
#define PG8_LDA(dst, b, h) do { _Pragma("unroll") for (int m = 0; m < 4; ++m) { if constexpr (ESZ == 1) dst##8[m] = __builtin_shufflevector(*(const PG8_LAS i32x4_*)(lds + PG8_SA(b, h) + aoff + m * 2048), *(const PG8_LAS i32x4_*)(lds + PG8_SA(b, h) + aoff + m * 2048 + 1024), 0, 1, 2, 3, 4, 5, 6, 7); \
        else { _Pragma("unroll") for (int k = 0; k < 2; ++k) dst[m][k] = *(const PG8_LAS bf16x8*)(lds + PG8_SA(b, h) + aoff + m * 2048 + k * 1024); } } } while (0)
#define PG8_LDB(dst, b, h) do { _Pragma("unroll") for (int n = 0; n < 2; ++n) { if constexpr (ESZ == 1) dst##8[n] = __builtin_shufflevector(*(const PG8_LAS i32x4_*)(lds + PG8_SB(b, h) + boff + n * 2048), *(const PG8_LAS i32x4_*)(lds + PG8_SB(b, h) + boff + n * 2048 + 1024), 0, 1, 2, 3, 4, 5, 6, 7); \
        else { _Pragma("unroll") for (int k = 0; k < 2; ++k) dst[n][k] = *(const PG8_LAS bf16x8*)(lds + PG8_SB(b, h) + boff + n * 2048 + k * 1024); } } } while (0)
#define PG8_MMA(ai, bj, At, Bt) do { __builtin_amdgcn_s_setprio(1); _Pragma("unroll") for (int m = 0; m < 4; ++m) _Pragma("unroll") for (int n = 0; n < 2; ++n) { \
        if constexpr (ESZ == 1) asm volatile("v_mfma_scale_f32_16x16x128_f8f6f4 %0, %1, %2, %0, %3, %3 op_sel_hi:[0,0,0]" : "+v"(acc[ai][bj][m][n]) : "v"(Bt##8[n]), "v"(At##8[m]), "v"(0x7F7F7F7F)); \
        else { _Pragma("unroll") for (int k = 0; k < 2; ++k) acc[ai][bj][m][n] = __builtin_amdgcn_mfma_f32_16x16x32_bf16(Bt[n][k], At[m][k], acc[ai][bj][m][n], 0, 0, 0); } } __builtin_amdgcn_s_setprio(0); } while (0)
#define PG8_WAIT_V(n) asm volatile("s_waitcnt vmcnt(" #n ")" ::: "memory")
#define PG8_WAIT_L(n) asm volatile("s_waitcnt lgkmcnt(" #n ")" ::: "memory")
#define PG8_BAR __builtin_amdgcn_s_barrier()
#define PG8_SCHED __builtin_amdgcn_sched_barrier(0)
    Unit cur, nxt; int ui = 0;
    if (!S.next(0, cur)) return;
    f32x4 acc[2][2][4][2];
#pragma unroll
    for (int a = 0; a < 2; ++a)
#pragma unroll
        for (int b = 0; b < 2; ++b)
#pragma unroll
            for (int m = 0; m < 4; ++m)
#pragma unroll
                for (int n = 0; n < 2; ++n) acc[a][b][m][n] = (f32x4){0.f, 0.f, 0.f, 0.f};
    typedef int i32x4_ __attribute__((ext_vector_type(4))); typedef int i32x8_ __attribute__((ext_vector_type(8)));
    bf16x8 At[4][2], B0[2][2], B1[2][2]; i32x8_ At8[4], B08[2], B18[2];
    const char* cA = (const char*)g.A + (size_t)cur.pm * tstep; const char* cB = (const char*)g.Bt + (size_t)cur.pn * tstep + (size_t)cur.e * g.estride;
    S.a_ready(cur);
    if constexpr (SP2) {
        PG8_STAGE(PG8_SB(0, 0), cB, voffB); PG8_STAGE(PG8_SB(0, 1), cB + hstep, voffB); PG8_STAGE(PG8_SA(0, 0), cA, voffA); PG8_STAGE(PG8_SA(0, 1), cA + hstep, voffA);
        if (wr == 1) PG8_BAR;
        PG8_WAIT_V(2); PG8_BAR;
        PG8_STAGE(PG8_SB(1, 0), cB + kstep, voffB); PG8_STAGE(PG8_SA(1, 0), cA + kstep, voffA); PG8_STAGE(PG8_SB(1, 1), cB + hstep + kstep, voffB);
        PG8_WAIT_V(6); PG8_BAR;
    } else {
        PG8_STAGE(PG8_SB(0, 0), cB, voffB); PG8_STAGE(PG8_SA(0, 0), cA, voffA); PG8_STAGE(PG8_SB(0, 1), cB + hstep, voffB); PG8_STAGE(PG8_SA(0, 1), cA + hstep, voffA);
        if (wr == 1) PG8_BAR;
        PG8_WAIT_V(4); PG8_BAR;
        PG8_STAGE(PG8_SB(1, 0), cB + kstep, voffB); PG8_STAGE(PG8_SA(1, 0), cA + kstep, voffA); PG8_STAGE(PG8_SB(1, 1), cB + hstep + kstep, voffB);
        PG8_WAIT_V(6); PG8_BAR;
    }
    for (;;) {
        const bool has_next = S.next(ui + 1, nxt);
        const char* nA = has_next ? (const char*)g.A + (size_t)nxt.pm * tstep : cA; const char* nB = has_next ? (const char*)g.Bt + (size_t)nxt.pn * tstep + (size_t)nxt.e * g.estride : cB;
        for (int t = 0; t < nt; t += 2) {
            const bool last = (t == nt - 2);
            const char* a1 = cA + (size_t)(t + 1) * kstep;
            const char* a2 = last ? nA : cA + (size_t)(t + 2) * kstep; const char* b2 = last ? nB : cB + (size_t)(t + 2) * kstep;
            const char* a3 = a2 + kstep; const char* b3 = b2 + kstep;
            if (last && has_next) S.a_ready(nxt);
            if constexpr (SP2) {
            PG8_LDB(B0, 0, 0); PG8_LDB(B1, 0, 1); PG8_SCHED; PG8_LDA(At, 0, 0); PG8_STAGE(PG8_SA(1, 1), a1 + hstep, voffA);
            PG8_WAIT_V(8); PG8_WAIT_L(0); PG8_BAR; PG8_MMA(0, 0, At, B0); PG8_MMA(0, 1, At, B1); PG8_BAR; PG8_SCHED;
            PG8_LDA(At, 0, 1); PG8_STAGE(PG8_SB(0, 0), b2, voffB); PG8_STAGE(PG8_SB(0, 1), b2 + hstep, voffB); PG8_STAGE(PG8_SA(0, 0), a2, voffA);
            PG8_WAIT_V(8); PG8_WAIT_L(0); PG8_BAR; PG8_MMA(1, 0, At, B0); PG8_MMA(1, 1, At, B1); PG8_BAR; PG8_SCHED;
            PG8_LDB(B0, 1, 0); PG8_LDB(B1, 1, 1); PG8_SCHED; PG8_LDA(At, 1, 0); PG8_STAGE(PG8_SA(0, 1), a2 + hstep, voffA);
            PG8_WAIT_V(8); PG8_WAIT_L(0); PG8_BAR; PG8_MMA(0, 0, At, B0); PG8_MMA(0, 1, At, B1); PG8_BAR; PG8_SCHED;
            PG8_LDA(At, 1, 1); PG8_STAGE(PG8_SB(1, 0), b3, voffB); PG8_STAGE(PG8_SB(1, 1), b3 + hstep, voffB); PG8_STAGE(PG8_SA(1, 0), a3, voffA);
            PG8_WAIT_V(8); PG8_WAIT_L(0); PG8_BAR; PG8_MMA(1, 0, At, B0); PG8_MMA(1, 1, At, B1); PG8_BAR; PG8_SCHED;
            } else {
            PG8_LDB(B0, 0, 0); PG8_SCHED; PG8_LDA(At, 0, 0); PG8_STAGE(PG8_SA(1, 1), a1 + hstep, voffA);
            PG8_WAIT_L(8); PG8_BAR; PG8_WAIT_L(0); PG8_MMA(0, 0, At, B0); PG8_BAR; PG8_SCHED;
            PG8_LDB(B1, 0, 1); PG8_STAGE(PG8_SB(0, 0), b2, voffB);
            PG8_BAR; PG8_WAIT_L(0); PG8_MMA(0, 1, At, B1); PG8_BAR;
            PG8_LDA(At, 0, 1); PG8_STAGE(PG8_SA(0, 0), a2, voffA);
            PG8_BAR; PG8_WAIT_L(0); PG8_MMA(1, 0, At, B0); PG8_BAR; PG8_SCHED;
            PG8_STAGE(PG8_SB(0, 1), b2 + hstep, voffB);
            PG8_WAIT_V(6); PG8_BAR; PG8_MMA(1, 1, At, B1); PG8_BAR;
            PG8_LDB(B0, 1, 0); PG8_SCHED; PG8_LDA(At, 1, 0); PG8_STAGE(PG8_SA(0, 1), a2 + hstep, voffA);
            PG8_WAIT_L(8); PG8_BAR; PG8_WAIT_L(0); PG8_MMA(0, 0, At, B0); PG8_BAR; PG8_SCHED;
            PG8_LDB(B1, 1, 1); PG8_STAGE(PG8_SB(1, 0), b3, voffB);
            PG8_BAR; PG8_WAIT_L(0); PG8_MMA(0, 1, At, B1); PG8_BAR;
            PG8_LDA(At, 1, 1); PG8_STAGE(PG8_SA(1, 0), a3, voffA);
            PG8_BAR; PG8_WAIT_L(0); PG8_MMA(1, 0, At, B0); PG8_BAR; PG8_SCHED;
            PG8_STAGE(PG8_SB(1, 1), b3 + hstep, voffB);
            PG8_WAIT_V(6); PG8_BAR; PG8_MMA(1, 1, At, B1); PG8_BAR;
            }
        }
        if constexpr (ALIGN_EPI) { if (wr == 0) PG8_BAR; }
        if constexpr (ESZ == 1) asm volatile("s_nop 15\n\ts_nop 15" ::: "memory");
        if constexpr (!Epi::AFTER_DRAIN) { int t2_ = threadIdx.x; asm volatile("" : "+v"(t2_)); E(acc, cur, wr, wc, t2_ & 15, (t2_ >> 4) & 3); S.done(cur); }
        if (!has_next) break;
#pragma unroll
        for (int a = 0; a < 2; ++a)
#pragma unroll
            for (int b = 0; b < 2; ++b)
#pragma unroll
                for (int m = 0; m < 4; ++m)
#pragma unroll
                    for (int n = 0; n < 2; ++n) acc[a][b][m][n] = (f32x4){0.f, 0.f, 0.f, 0.f};
        cur = nxt; cA = nA; cB = nB; ++ui;
        if constexpr (ALIGN_EPI) { if (wr == 1) PG8_BAR; }
    }
    PG8_WAIT_V(0);
    if constexpr (!ALIGN_EPI) { if (wr == 0) PG8_BAR; }
    PG8_BAR;
    if constexpr (Epi::AFTER_DRAIN) { E.fused(acc, cur, wr, wc, fr, fq, lds, wid, lane); S.done(cur); }
#undef PG8_SA
#undef PG8_SB
#undef PG8_STAGE
#undef PG8_LDA
#undef PG8_LDB
#undef PG8_MMA
#undef PG8_WAIT_V
#undef PG8_WAIT_L
#undef PG8_BAR
#undef PG8_SCHED
}
}
#define GAS __attribute__((address_space(1)))
#define LAS __attribute__((address_space(3)))
typedef GAS unsigned gu32;
typedef GAS unsigned long long gu64;
#define RLX_AGENT __ATOMIC_RELAXED, __HIP_MEMORY_SCOPE_AGENT
#define LDS_WAIT() asm volatile("s_waitcnt lgkmcnt(0)" ::: "memory")
#define VM_WAIT() asm volatile("s_waitcnt vmcnt(0)" ::: "memory")
#define XB_TMO      128
#define XB_XCNT(j)  (256  + 64 * (j))
#define XB_XSUB(j)  (1280 + 64 * (j))
#define XB_XGEN(j)  (2304 + 64 * (j))
#define XB_TOP      3328
#define XB_TOPGEN   3392
#define XCD_BAR_WORDS 3456
#define XB_SPIN_CAP (1u << 18)

__device__ __forceinline__ unsigned xb_ld(unsigned* p)              { return __hip_atomic_load(p, __ATOMIC_RELAXED, __HIP_MEMORY_SCOPE_AGENT); }
__device__ __forceinline__ unsigned xb_add(unsigned* p, unsigned v) { return __hip_atomic_fetch_add(p, v, __ATOMIC_RELAXED, __HIP_MEMORY_SCOPE_AGENT); }
__device__ __forceinline__ unsigned xb_xcc_id() { return (unsigned)__builtin_amdgcn_s_getreg((3 << 11) | 20) & 0xFu; }
#define XB_SPIN(cond, bar) do { unsigned _sp = 0; while (cond) { __builtin_amdgcn_s_sleep(1); \
    if ((++_sp & 255u) == 0u) { if (xb_ld(&(bar)[XB_TMO])) break; if (_sp > XB_SPIN_CAP) { atomicAdd(&(bar)[XB_TMO], 1u); break; } } } } while (0)

struct XcdBarrier {
    unsigned* bar; unsigned x;
    volatile LAS unsigned* st;
};

__device__ __forceinline__ XcdBarrier xcd_barrier_post(unsigned* bar, volatile LAS unsigned* st) {
    XcdBarrier b; b.bar = bar; b.x = xb_xcc_id(); b.st = st;
    if (threadIdx.x == 0) (void)xb_add(&bar[XB_XCNT(b.x)], 1u);
    return b;
}
__device__ __forceinline__ void xcd_barrier_complete(unsigned* bar, unsigned x, unsigned& nloc, unsigned& nx) {
    const unsigned G = gridDim.x * gridDim.y * gridDim.z;
    unsigned sum, cnt, mine, sp = 0u;
    for (;;) {
        sum = 0u; cnt = 0u; mine = 0u;
#pragma unroll
        for (unsigned j = 0; j < 16; ++j) { const unsigned c = xb_ld(&bar[XB_XCNT(j)]); sum += c; cnt += (c > 0u) ? 1u : 0u; mine = (j == x) ? c : mine; }
        if (sum == G) break;
        __builtin_amdgcn_s_sleep(1);
        if ((++sp & 255u) == 0u) { if (xb_ld(&bar[XB_TMO])) break; if (sp > XB_SPIN_CAP) { atomicAdd(&bar[XB_TMO], 1u); break; } }
    }
    nloc = mine > 0u ? mine : 1u; nx = cnt > 0u ? cnt : 1u;
}

__device__ __forceinline__ void xcd_barrier(const XcdBarrier& b) {
    asm volatile("s_waitcnt vmcnt(0)" ::: "memory");
    __syncthreads();
    if (threadIdx.x == 0) {
        unsigned* bar = b.bar;
        __builtin_amdgcn_s_waitcnt(0);
        unsigned nloc = b.st[0], nx = b.st[1];
        if (nloc == 0u) { xcd_barrier_complete(bar, b.x, nloc, nx); b.st[0] = nloc; b.st[1] = nx; }
        const unsigned old = xb_add(&bar[XB_XSUB(b.x)], 1u);
        const unsigned gen = old / nloc;
        if (old + 1u == (gen + 1u) * nloc) {
            __builtin_amdgcn_fence(__ATOMIC_RELEASE, "agent");
            asm volatile("s_waitcnt vmcnt(0)" ::: "memory");
            const unsigned og = xb_add(&bar[XB_TOP], 1u);
            const unsigned tg = og / nx;
            if (og + 1u == (tg + 1u) * nx) xb_add(&bar[XB_TOPGEN], 1u);
            else XB_SPIN(xb_ld(&bar[XB_TOPGEN]) == tg, bar);
            __builtin_amdgcn_fence(__ATOMIC_ACQUIRE, "agent");
            xb_add(&bar[XB_XGEN(b.x)], 1u);
            asm volatile("s_waitcnt vmcnt(0)" ::: "memory");
        } else {
            XB_SPIN(xb_ld(&bar[XB_XGEN(b.x)]) == gen, bar);
            __builtin_amdgcn_fence(__ATOMIC_ACQUIRE, "agent");
            asm volatile("s_waitcnt vmcnt(0)" ::: "memory");
        }
    }
    __syncthreads();
}
namespace at {
constexpr int D = 128; constexpr float THR = 8.f; constexpr bool WSKIP = false; constexpr int WBIG = 1 << 30;
constexpr float SCALE = 0.08838834764831845f;
constexpr int NW = 8, QBLK = 32, KVBLK = 64, QB = NW * QBLK;
constexpr int SHM_V = KVBLK * D * 2, SHM_K = KVBLK * D * 2;
constexpr int LDS_BODY = 2 * SHM_V + 2 * SHM_K + NW * 64 * 4;
constexpr int LDS_BIAS = LDS_BODY, LDS_BYTES = LDS_BODY + 8192 * 4;
using bf16 = unsigned short;
typedef short bf16x8 __attribute__((ext_vector_type(8)));
typedef short s16x4 __attribute__((ext_vector_type(4)));
typedef float f32x16 __attribute__((ext_vector_type(16)));
typedef float f32x4 __attribute__((ext_vector_type(4)));
typedef unsigned u32x4 __attribute__((ext_vector_type(4)));
template <class A, class Bt> struct same_t { static constexpr bool v = false; };
template <class A> struct same_t<A, A> { static constexpr bool v = true; };

#define KSWZ(row, colB) ((row) * 256 + ((colB) ^ (((row) & 7) << 4)))
#define SBAR() __builtin_amdgcn_sched_barrier(0)
__device__ __forceinline__ int v_st(int k, int c) { const int kk = (k & ~0xC) | ((k & 4) << 1) | ((k & 8) >> 1); return ((kk >> 3) * 4 + (c >> 5)) * 512 + ((kk & 7) * 32 + (c & 31)) * 2; }
__device__ __forceinline__ int v_rd_base(int lane) { return ((lane & 3) << 3) | (((lane >> 2) & 3) << 6) | (((lane >> 4) & 1) << 5) | (((lane >> 5) & 1) << 8); }
constexpr int v_rd_off(int d0, int ks, int half) { return d0 * 512 + ks * 4096 + half * 2048; }
__device__ __forceinline__ int crow(int r, int hi) { return (r & 3) + 8 * (r >> 2) + 4 * hi; }
__device__ __forceinline__ unsigned cvtpk(float lo, float hi) {
    unsigned r; asm volatile("v_cvt_pk_bf16_f32 %0, %1, %2" : "=v"(r) : "v"(lo), "v"(hi)); return r;
}
__device__ __forceinline__ bf16x8 pack8(f32x4 a, f32x4 b) {
    u32x4 w = {cvtpk(a[0], a[1]), cvtpk(a[2], a[3]), cvtpk(b[0], b[1]), cvtpk(b[2], b[3])};
    return *reinterpret_cast<bf16x8*>(&w);
}
template <class T> __device__ __forceinline__ bf16x8 load8(const T* p) {
    if constexpr (same_t<T, float>::v) { return pack8(*(const f32x4*)p, *(const f32x4*)(p + 4)); }
    else { return *reinterpret_cast<const bf16x8*>(p); }
}
template <int MODE> __device__ __forceinline__ void mask_tile(f32x16& p0, f32x16& p1, int dq, unsigned W) {
    const float NEG = MODE ? 0.f : -__builtin_inff();
#pragma unroll
    for (int r = 0; r < 16; ++r) {
        const int c = (r & 3) + 8 * (r >> 2);
        if ((unsigned)(dq - c) >= W) p0[r] = NEG;
        if ((unsigned)(dq - c - 32) >= W) p1[r] = NEG;
    }
}
__device__ __forceinline__ void partialRet(f32x16& p0, float rowfac) { for (int r = 0; r < 16; ++r) p0[r] *= rowfac; }
__device__ __forceinline__ void partialSM(f32x16& p0, f32x16& p1, float& m_reg, float& mn, float& alpha) {
    float pmax = p0[0]; for (int r = 1; r < 16; ++r) pmax = fmaxf(pmax, p0[r]); for (int r = 0; r < 16; ++r) pmax = fmaxf(pmax, p1[r]);
    { auto rr = __builtin_amdgcn_permlane32_swap(__float_as_uint(pmax), __float_as_uint(pmax), false, false);
      pmax = fmaxf(__uint_as_float(rr[0]), __uint_as_float(rr[1])); }
    constexpr float C2 = 1.4426950408889634f * SCALE;
    if (__builtin_expect(__all((pmax - m_reg) * SCALE <= THR), 1)) { mn = m_reg; alpha = 1.f; }
    else { mn = fmaxf(m_reg, pmax); alpha = __builtin_amdgcn_exp2f((m_reg - mn) * C2); m_reg = mn; }
    const float mnL = -mn * C2;
    for (int r = 0; r < 16; ++r) p0[r] = fmaf(p0[r], C2, mnL); for (int r = 0; r < 16; ++r) p1[r] = fmaf(p1[r], C2, mnL);
    for (int r = 0; r < 16; ++r) p0[r] = __builtin_amdgcn_exp2f(p0[r]);
}
template <int MODE> __device__ __forceinline__ void finishSM(f32x16& p0, f32x16& p1, float alpha, float& l_reg, bf16x8& pa0, bf16x8& pa1, bf16x8& pa2, bf16x8& pa3) {
    if constexpr (MODE == 0) {
    for (int r = 0; r < 16; ++r) p1[r] = __builtin_amdgcn_exp2f(p1[r]);
    float ps = 0; for (int r = 0; r < 16; ++r) ps += p0[r]; for (int r = 0; r < 16; ++r) ps += p1[r];
    { auto rr = __builtin_amdgcn_permlane32_swap(__float_as_uint(ps), __float_as_uint(ps), false, false);
      ps = __uint_as_float(rr[0]) + __uint_as_float(rr[1]); }
    l_reg = l_reg * alpha + ps;
    } else { for (int r = 0; r < 16; ++r) p1[r] *= alpha; }
#define PK4(P, B_, OUT) do { unsigned a0 = cvtpk(P[B_+0], P[B_+1]), a1 = cvtpk(P[B_+2], P[B_+3]);                          \
        unsigned b0 = cvtpk(P[B_+4], P[B_+5]), b1 = cvtpk(P[B_+6], P[B_+7]);                                             \
        auto r0 = __builtin_amdgcn_permlane32_swap(a0, b0, false, false); auto r1 = __builtin_amdgcn_permlane32_swap(a1, b1, false, false); \
        u32x4 w = {r0[0], r1[0], r0[1], r1[1]}; OUT = *reinterpret_cast<bf16x8*>(&w); } while (0)
    PK4(p0, 0, pa0); PK4(p0, 8, pa1); PK4(p1, 0, pa2); PK4(p1, 8, pa3);
#undef PK4
}
template <int KB, bool SK, int MODE>
__device__ __forceinline__ void qkt(f32x16& p0, f32x16& p1, const char* K_lds, int r32, int hi, const bf16x8* qr, bool act, const float* bt) {
    if (SK && !act) { const float NEG = -__builtin_inff();
#pragma unroll
        for (int r = 0; r < 16; ++r) { p0[r] = NEG; p1[r] = NEG; } return; }
    if constexpr (MODE == 0) {
        const f32x4 b0 = *(const f32x4*)(bt), b1 = *(const f32x4*)(bt + 8), b2 = *(const f32x4*)(bt + 16), b3 = *(const f32x4*)(bt + 24);
        const f32x4 c0 = *(const f32x4*)(bt + 32), c1 = *(const f32x4*)(bt + 40), c2 = *(const f32x4*)(bt + 48), c3 = *(const f32x4*)(bt + 56);
        p0 = f32x16{b0[0], b0[1], b0[2], b0[3], b1[0], b1[1], b1[2], b1[3], b2[0], b2[1], b2[2], b2[3], b3[0], b3[1], b3[2], b3[3]};
        p1 = f32x16{c0[0], c0[1], c0[2], c0[3], c1[0], c1[1], c1[2], c1[3], c2[0], c2[1], c2[2], c2[3], c3[0], c3[1], c3[2], c3[3]};
    } else { p0 = f32x16{}; p1 = f32x16{}; }
    const char* kb[4];
#pragma unroll
    for (int dd = 0; dd < 4; ++dd) kb[dd] = K_lds + KB * SHM_K + KSWZ(r32, (dd * 16 + hi * 8) * 2);
#pragma unroll
    for (int d0 = 0; d0 < 8; ++d0) { const char* a = kb[d0 & 3] + (d0 >> 2) * 128;
        bf16x8 b0 = *reinterpret_cast<const bf16x8*>(a);
        bf16x8 b1 = *reinterpret_cast<const bf16x8*>(a + 32 * 256);
        p0 = __builtin_amdgcn_mfma_f32_32x32x16_bf16(b0, qr[d0], p0, 0, 0, 0);
        p1 = __builtin_amdgcn_mfma_f32_32x32x16_bf16(b1, qr[d0], p1, 0, 0, 0); }
}
template <int VB, bool SK>
__device__ __forceinline__ void pv_tile(f32x16* o, int vb0, bf16x8 pa0, bf16x8 pa1, bf16x8 pa2, bf16x8 pa3, bool act) {
    if (SK && !act) return;
#define TRRD(dst, off) asm volatile("ds_read_b64_tr_b16 %0, %1 offset:%2" : "=&v"(dst) : "v"(vb0), "i"(off) : "memory")
#define PV_D0(d0) do { s16x4 l0, l1, l2, l3, h0, h1, h2, h3; constexpr int b_ = VB * SHM_V + v_rd_off(d0, 0, 0);     \
        TRRD(l0, b_); TRRD(h0, b_ + 2048); TRRD(l1, b_ + 4096); TRRD(h1, b_ + 6144); TRRD(l2, b_ + 8192); TRRD(h2, b_ + 10240); TRRD(l3, b_ + 12288); TRRD(h3, b_ + 14336); \
        asm volatile("s_waitcnt lgkmcnt(0)" ::: "memory"); SBAR();                 \
        o[d0] = __builtin_amdgcn_mfma_f32_32x32x16_bf16(pa0, (bf16x8){l0[0], l0[1], l0[2], l0[3], h0[0], h0[1], h0[2], h0[3]}, o[d0], 0, 0, 0);   \
        o[d0] = __builtin_amdgcn_mfma_f32_32x32x16_bf16(pa1, (bf16x8){l1[0], l1[1], l1[2], l1[3], h1[0], h1[1], h1[2], h1[3]}, o[d0], 0, 0, 0);   \
        o[d0] = __builtin_amdgcn_mfma_f32_32x32x16_bf16(pa2, (bf16x8){l2[0], l2[1], l2[2], l2[3], h2[0], h2[1], h2[2], h2[3]}, o[d0], 0, 0, 0);   \
        o[d0] = __builtin_amdgcn_mfma_f32_32x32x16_bf16(pa3, (bf16x8){l3[0], l3[1], l3[2], l3[3], h3[0], h3[1], h3[2], h3[3]}, o[d0], 0, 0, 0); } while (0)
    PV_D0(0); PV_D0(1); PV_D0(2); PV_D0(3);
#undef PV_D0
#undef TRRD
}

template <class TIn, class TOut> struct BlockRef { const TIn* Q; const TIn* K; const TIn* V; TOut* O; int P0; int jlo; int bh; };
template <class TIn> struct NextRef { const TIn* Q; const TIn* K; const TIn* V; int jlo; };
template <class TIn> struct Extra { const float* bias; const TIn* G; const float* nw; const TIn* S; };
constexpr int LDO = 2048;
template <class TIn> struct Seam {
    bf16x8 qr[8];
    bf16x8 st_v0, st_v1, st_k0, st_k1; f32x4 sf0, sf1, sf2, sf3;
    f32x4 tq[16];
};
#define ROW(p, k0, rr) ((p) + (unsigned)(((k0) + (rr)) * D + sc))
#define VMW() asm volatile("s_waitcnt vmcnt(0)" ::: "memory")
#define VMWN(n) asm volatile("s_waitcnt vmcnt(%0)" :: "i"(n) : "memory")
#define SLOAD_H(Kp, Vp, k0) do { S.st_v0 = load8<TIn>(ROW(Vp, k0, sr)); S.st_v1 = load8<TIn>(ROW(Vp, k0, 32 + sr));              \
                         S.st_k0 = load8<TIn>(ROW(Kp, k0, sr)); S.st_k1 = load8<TIn>(ROW(Kp, k0, 32 + sr)); } while (0)
#define SWRITE_HK(bf) do { *(bf16x8*)(K_lds + (bf) * SHM_K + kws) = S.st_k0; *(bf16x8*)(K_lds + (bf) * SHM_K + kws + 32 * 256) = S.st_k1; } while (0)
#define SWRITE_HV(bf) do { *(bf16x8*)(V_lds + (bf) * SHM_V + vst0) = S.st_v0; *(bf16x8*)(V_lds + (bf) * SHM_V + vst1) = S.st_v1; } while (0)
#define SWRITE_H(bf) do { SWRITE_HV(bf); SWRITE_HK(bf); } while (0)
#define SLOAD_F(p, k0) do { S.sf0 = *(const f32x4*)ROW(p, k0, sr); S.sf1 = *(const f32x4*)(ROW(p, k0, sr) + 4);                \
                            S.sf2 = *(const f32x4*)ROW(p, k0, 32 + sr); S.sf3 = *(const f32x4*)(ROW(p, k0, 32 + sr) + 4); } while (0)
#define SWRITE_KF(bf) do { *(bf16x8*)(K_lds + (bf) * SHM_K + kws) = pack8(S.sf0, S.sf1); *(bf16x8*)(K_lds + (bf) * SHM_K + kws + 32 * 256) = pack8(S.sf2, S.sf3); } while (0)
#define SWRITE_VF(bf) do { *(bf16x8*)(V_lds + (bf) * SHM_V + vst0) = pack8(S.sf0, S.sf1); *(bf16x8*)(V_lds + (bf) * SHM_V + vst1) = pack8(S.sf2, S.sf3); } while (0)
template <class TIn, class TOut>
__device__ __forceinline__ void causal_swa_prime(const BlockRef<TIn, TOut>& cur, int W, char* lds, Seam<TIn>& S) {
    constexpr bool F32 = same_t<TIn, float>::v;
    const int tid = threadIdx.x, wid = __builtin_amdgcn_readfirstlane(tid >> 6), lane = tid & 63, r32 = lane & 31, hi = lane >> 5;
    const int sr = tid >> 4, sc = (tid & 15) * 8, kws = KSWZ(sr, sc * 2); char* K_lds = lds + 2 * SHM_V;
    const int kb0 = cur.jlo * KVBLK;
    for (int d0 = 0; d0 < 8; ++d0) S.qr[d0] = load8<TIn>(cur.Q + (unsigned)((wid * QBLK + r32) * D + d0 * 16 + hi * 8));
    if constexpr (F32) { SLOAD_F((const float*)cur.K, kb0); VMW(); SWRITE_KF(0); SBAR(); SLOAD_F((const float*)cur.V, kb0); }
    else { SLOAD_H(cur.K, cur.V, kb0); VMW(); SWRITE_HK(0); }
    __syncthreads();
}
template <int MODE, class TIn, class TOut>
__device__ __forceinline__ void causal_swa_block(const BlockRef<TIn, TOut>& cur, const NextRef<TIn>& nxt, const Extra<TIn>& X, int skv, int W, char* lds, Seam<TIn>& S) {
    constexpr bool F32 = same_t<TIn, float>::v;
    int tid_ = threadIdx.x; asm volatile("" : "+v"(tid_));
    const int tid = tid_, wid = __builtin_amdgcn_readfirstlane(tid >> 6), lane = tid & 63, r32 = lane & 31, hi = lane >> 5;
    const int j_lo = cur.jlo;
    int j_hi = (cur.P0 + QB - 1) / KVBLK + 1; if (j_hi > skv / KVBLK) j_hi = skv / KVBLK;
    const int NT = j_hi - j_lo;
    const int kbn = nxt.jlo * KVBLK;
    const int qlo = cur.P0 + wid * QBLK, qm = qlo + r32 - 4 * hi;
    char* V_lds = lds; char* K_lds = lds + 2 * SHM_V;
    float* ws = (float*)(lds + 2 * SHM_V + 2 * SHM_K) + wid * 64; float* li_l = ws, * al_l = ws + 32;
    float m_reg = -1e30f, l_reg = 0; f32x16 o[4] = {};
    const int sr = tid >> 4, sc = (tid & 15) * 8, vst0 = v_st(sr, sc), vst1 = v_st(32 + sr, sc), kws = KSWZ(sr, sc * 2);
    const int vb0 = (int)(uintptr_t)V_lds + v_rd_base(lane);
    const TIn* Kh = cur.K; const TIn* Vh = cur.V;
    const float* bl = (const float*)(lds + LDS_BIAS) + 4 * hi;
    if constexpr (MODE == 0) { for (int i = tid; i < NT * 16; i += 64 * NW) *(f32x4*)(lds + LDS_BIAS + i * 16) = *(const f32x4*)(X.bias + (size_t)cur.bh * 8192 + j_lo * KVBLK + i * 4); __syncthreads(); }
    const float l2g = MODE ? log2f(1.f - exp2f(-5.f - (float)(cur.bh & 7))) : 0.f;
    if constexpr (MODE == 1) {
        const TIn* Sg = X.S + ((size_t)(cur.bh * 32 + (cur.P0 >> 8))) * 16384 + (unsigned)(r32 * D + hi * 8);
        const float fq = __builtin_amdgcn_exp2f(l2g * (float)(wid * QBLK + r32 + 1));
#pragma unroll
        for (int d0 = 0; d0 < 8; ++d0) { const u32x4 qw = *reinterpret_cast<const u32x4*>(&S.qr[d0]); u32x4 sw;
#pragma unroll
            for (int i = 0; i < 4; ++i) sw[i] = cvtpk(__uint_as_float(qw[i] << 16) * fq, __uint_as_float(qw[i] & 0xffff0000u) * fq);
            const bf16x8 qs = *reinterpret_cast<const bf16x8*>(&sw);
#pragma unroll
            for (int eb = 0; eb < 4; ++eb) { const bf16x8 sb = *reinterpret_cast<const bf16x8*>(Sg + eb * 32 * D + d0 * 16); o[eb] = __builtin_amdgcn_mfma_f32_32x32x16_bf16(qs, sb, o[eb], 0, 0, 0); }
            if (d0 & 1) asm volatile("" ::: "memory"); }
    }
#define BT(t) (bl + (t) * KVBLK)
#define PSM(P0_, P1_, mnX, alX, t) do { if constexpr (MODE == 0) partialSM(P0_, P1_, m_reg, mnX, alX); else { alX = __builtin_amdgcn_exp2f(l2g * (float)(qlo + r32 - KBASE(t))); partialRet(P0_, alX); } } while (0)
#define RESC(a) do { if (MODE == 0 && __any((a) < 1.f)) { if (hi == 0) al_l[r32] = (a); asm volatile("s_waitcnt lgkmcnt(0)" ::: "memory");              \
                     for (int d_ = 0; d_ < 4; ++d_) for (int r = 0; r < 16; ++r) o[d_][r] *= al_l[crow(r, hi)]; } } while (0)
#define KBASE(t) ((j_lo + (t)) * KVBLK)
#define ACT(t) (KBASE(t) <= qlo + QBLK - 1 && KBASE(t) + KVBLK - 1 >= qlo - W + 1)
#define MASKT(P0_, P1_, t) do { const int kb_ = KBASE(t); if ((!SK || ACT(t)) && (kb_ + KVBLK - 1 > qlo || kb_ <= qlo + QBLK - 1 - W)) mask_tile<MODE>(P0_, P1_, qm - kb_, (unsigned)W); } while (0)
    constexpr int NQL = F32 ? 16 : 8;
    constexpr bool SK = WSKIP && !F32;
#define SEAM_K0() do { VMWN(NQL); if constexpr (F32) { SWRITE_KF(0); SBAR(); SLOAD_F((const float*)nxt.V, kbn); } else { SWRITE_HK(0); } SBAR(); } while (0)
    f32x16 pA0, pA1, pB0, pB1; float mnA, mnB, alA, alB; bf16x8 pa0, pa1, pa2, pa3;
    if constexpr (F32) { VMW(); SWRITE_VF(0); SBAR(); } else { SWRITE_HV(0); SBAR(); }
    if (NT > 1) { if constexpr (F32) SLOAD_F((const float*)Kh, KBASE(1)); else SLOAD_H(Kh, Vh, KBASE(1)); }
    SBAR(); qkt<0, SK, MODE>(pA0, pA1, K_lds, r32, hi, S.qr, ACT(0), BT(0));
    if constexpr (F32) { if (NT > 1) { VMW(); SWRITE_KF(1); SBAR(); SLOAD_F((const float*)Vh, KBASE(1)); } }
    MASKT(pA0, pA1, 0); PSM(pA0, pA1, mnA, alA, 0);
    if (NT > 1) { VMW(); if constexpr (F32) { SWRITE_VF(1); SBAR(); if (NT > 2) SLOAD_F((const float*)Kh, KBASE(2)); } else SWRITE_H(1); }
    __syncthreads();
#define HALF_STEP(PX0, PX1, mnX, alX, PY0, PY1, alY, t, KB, VB, SB) do {                                                      \
        SBAR(); qkt<KB, SK, MODE>(PX0, PX1, K_lds, r32, hi, S.qr, ACT(t), BT(t));                                \
        finishSM<MODE>(PY0, PY1, alY, l_reg, pa0, pa1, pa2, pa3); SBAR();                                                           \
        if ((t) + 1 < NT) { if constexpr (F32) { VMW(); SWRITE_KF(SB); SBAR(); SLOAD_F((const float*)Vh, KBASE((t) + 1)); }  \
                            else { SLOAD_H(Kh, Vh, KBASE((t) + 1)); } SBAR(); }                                               \
        pv_tile<VB, SK>(o, vb0, pa0, pa1, pa2, pa3, ACT((t) - 1)); MASKT(PX0, PX1, (t)); PSM(PX0, PX1, mnX, alX, (t));                                        \
        __syncthreads();                                                                                                      \
        if ((t) + 1 < NT) { VMW(); if constexpr (F32) { SWRITE_VF(SB); SBAR(); if ((t) + 2 < NT) SLOAD_F((const float*)Kh, KBASE((t) + 2)); } \
                            else { SWRITE_H(SB); } }                                                                          \
        RESC(alX); __syncthreads(); } while (0)
    for (int t = 1; t + 1 < NT; t += 2) {
        HALF_STEP(pB0, pB1, mnB, alB, pA0, pA1, alA, t, 1, 0, 0);
        HALF_STEP(pA0, pA1, mnA, alA, pB0, pB1, alB, t + 1, 0, 1, 1);
    }
    const bool even = (NT & 1) == 0;
    if (even) { SBAR(); qkt<1, SK, MODE>(pB0, pB1, K_lds, r32, hi, S.qr, ACT(NT - 1), BT(NT - 1)); SBAR(); }
#define QROW(e) (nxt.Q + (size_t)(wid * QBLK + r32) * D + ((e) >> 1) * 16 + hi * 8 + ((e) & 1) * 4)
    if constexpr (F32) { SLOAD_F((const float*)nxt.K, kbn); SBAR();
#pragma unroll
        for (int e = 0; e < 8; ++e) S.tq[e] = *(const f32x4*)QROW(e); }
    else { SLOAD_H(nxt.K, nxt.V, kbn); SBAR();
#pragma unroll
        for (int d0 = 0; d0 < 8; ++d0) S.qr[d0] = load8<TIn>(nxt.Q + (unsigned)((wid * QBLK + r32) * D + d0 * 16 + hi * 8)); }
    SBAR();
    finishSM<MODE>(pA0, pA1, alA, l_reg, pa0, pa1, pa2, pa3); SBAR();
    if constexpr (F32) {
#pragma unroll
        for (int e = 8; e < 16; ++e) S.tq[e] = *(const f32x4*)QROW(e); SBAR(); }
#undef QROW
    pv_tile<0, SK>(o, vb0, pa0, pa1, pa2, pa3, ACT(even ? NT - 2 : NT - 1));
    if (even) { MASKT(pB0, pB1, NT - 1); PSM(pB0, pB1, mnB, alB, NT - 1); __syncthreads(); RESC(alB);
        finishSM<MODE>(pB0, pB1, alB, l_reg, pa0, pa1, pa2, pa3); SBAR(); pv_tile<1, SK>(o, vb0, pa0, pa1, pa2, pa3, ACT(NT - 1)); }
    SBAR(); SEAM_K0();
    float rli[16];
    if constexpr (MODE == 0) {
        if (hi == 0) li_l[r32] = l_reg; asm volatile("s_waitcnt lgkmcnt(0)" ::: "memory");
#pragma unroll
        for (int r = 0; r < 16; ++r) rli[r] = __builtin_amdgcn_rcpf(li_l[crow(r, hi)]);
    } else {
#pragma unroll
        for (int r = 0; r < 16; ++r) { float sq = (o[0][r] * o[0][r] + o[1][r] * o[1][r]) + (o[2][r] * o[2][r] + o[3][r] * o[3][r]);
            sq += __shfl_xor(sq, 1); sq += __shfl_xor(sq, 2); sq += __shfl_xor(sq, 4); sq += __shfl_xor(sq, 8); sq += __shfl_xor(sq, 16);
            rli[r] = rsqrtf(sq * (1.f / 128.f) + 1e-6f); }
    }
    { int t2 = threadIdx.x; asm volatile("" : "+v"(t2));
      const int w2 = __builtin_amdgcn_readfirstlane(t2 >> 6), c2 = t2 & 31, h2 = (t2 >> 5) & 1;
      TOut* Ow = cur.O + (unsigned)((w2 * QBLK + 4 * h2) * LDO + c2);
      float nwv[4] = {1.f, 1.f, 1.f, 1.f}; const TIn* Gp = nullptr;
      if constexpr (MODE == 1) { Gp = X.G + ((size_t)cur.bh * 8192 + cur.P0) * D + (unsigned)((w2 * QBLK + 4 * h2) * D + c2);
#pragma unroll
          for (int d0 = 0; d0 < 4; ++d0) nwv[d0] = X.nw[(cur.bh & 7) * D + d0 * 32 + c2]; }
#pragma unroll
      for (int r = 0; r < 16; ++r) { const int ro = (r & 3) + 8 * (r >> 2);
          float v[4];
#pragma unroll
          for (int d0 = 0; d0 < 4; ++d0) { v[d0] = o[d0][r] * rli[r];
              if constexpr (MODE == 1) { const unsigned gq = Gp[ro * D + d0 * 32]; v[d0] *= nwv[d0] * __uint_as_float(gq << 16); } }
#pragma unroll
          for (int d0 = 0; d0 < 4; ++d0) { const float vn = __shfl_xor(v[d0], 1);
              if ((c2 & 1) == 0) *(unsigned*)(Ow + ro * LDO + d0 * 32) = cvtpk(v[d0], vn); }
          if ((r & 3) == 3) asm volatile("" ::: "memory"); } }
    if constexpr (F32) {
#pragma unroll
        for (int d0 = 0; d0 < 8; ++d0) S.qr[d0] = pack8(S.tq[2 * d0], S.tq[2 * d0 + 1]); }
    __syncthreads();
#undef RESC
#undef BT
#undef PSM
#undef KBASE
#undef ACT
#undef MASKT
#undef SEAM_K0
#undef HALF_STEP
}
#undef ROW
#undef VMW
#undef VMWN
#undef SLOAD_H
#undef SWRITE_HK
#undef SWRITE_HV
#undef SWRITE_H
#undef SLOAD_F
#undef SWRITE_KF
#undef SWRITE_VF

}
constexpr int NWAVES = 8;
namespace W {
constexpr size_t CTL = 0, CTL_ZERO_BYTES = 1 * MiB;
constexpr size_t MOD = 1 * MiB, MODP = 2 * MiB, ROPE = 4 * MiB, LOGF = 8 * MiB, CUM = 9 * MiB, BIAS = 9 * MiB + 512 * 1024, ROUTE = 10 * MiB, TILE = 11 * MiB, JLO = 12 * MiB, WFR = 13 * MiB, A2S2 = 14 * MiB;
constexpr size_t XN = 16 * MiB, MIX = 80 * MiB, WT_IN = 144 * MiB, WT_OUT = 172 * MiB, WT_13 = 180 * MiB, WT_2 = 308 * MiB, QKV = 372 * MiB, END = 596 * MiB;
constexpr size_t KVS = XN, ST = XN + 32 * MiB;
constexpr size_t H2 = XN, XS = QKV, ACT = QKV + 160 * MiB, Y = 16 * MiB;
constexpr size_t NV_RO = 596 * MiB, NV_UP = 596 * MiB, NV_Z = 144 * MiB, NV_END = 676 * MiB;
}
constexpr int CW_CNT = 0, CNT_STRIDE = 64;
constexpr int CW_QFOX = 2560;
constexpr int CW_BAR = 4096;
constexpr int RING_OFF = 0, RING_BYTES = 131072, XCH_OFF = 131072, XCH_BYTES = 8192, LDS_BYTES = 163840, MISC_OFF = LDS_BYTES - 512;

struct Args { const float* in[19]; float* out; unsigned char* ws; int ph_lo, ph_hi, li, pad; };

__device__ __forceinline__ float wave_sum(float v) {
#define WS_DPP(ctrl, rmask, bc) v += __int_as_float(__builtin_amdgcn_update_dpp(0, __float_as_int(v), ctrl, rmask, 0xF, bc))
    WS_DPP(0x111, 0xF, true); WS_DPP(0x112, 0xF, true); WS_DPP(0x114, 0xF, true); WS_DPP(0x118, 0xF, true);
    WS_DPP(0x142, 0xA, false); WS_DPP(0x143, 0xC, false);
#undef WS_DPP
    return __int_as_float(__builtin_amdgcn_readlane(__float_as_int(v), 63));
}
__device__ __forceinline__ unsigned pk2(float lo, float hi) { return f2bf(lo) | (f2bf(hi) << 16); }
__device__ __forceinline__ float log_sigmoid_f(float x) { return x >= 0.f ? -log1pf(expf(-x)) : x - log1pf(expf(x)); }

__device__ __forceinline__ void tr_item(const float* colp, size_t ldw, bf16_t* WT, int K, int k0, int n0, LAS float* scr, int lane) {
#pragma unroll 8
    for (int i = 0; i < 32; ++i) { const int kk = 2 * i + (lane >> 5); scr[kk * 33 + (lane & 31)] = colp[(size_t)(k0 + kk) * ldw]; }
    LDS_WAIT(); asm volatile("" ::: "memory");
    const int c = lane & 7;
#pragma unroll
    for (int j = 0; j < 4; ++j) { const int n = (lane >> 3) + 8 * j; const LAS float* s = scr + (8 * c) * 33 + n;
        uint4 o; o.x = pk2(s[0 * 33], s[1 * 33]); o.y = pk2(s[2 * 33], s[3 * 33]); o.z = pk2(s[4 * 33], s[5 * 33]); o.w = pk2(s[6 * 33], s[7 * 33]);
        *(uint4*)(WT + (size_t)(n0 + n) * K + k0 + 8 * c) = o; }
    LDS_WAIT(); asm volatile("" ::: "memory");
}
__device__ __forceinline__ void tr_item4(const float* colp4, size_t ldw, bf16_t* WT, int K, int k0, int n0, LAS float* scr, int lane) {
    const int kr = lane >> 3, cq = (lane & 7) * 4;
    pg8::f32x4 v[8];
#pragma unroll
    for (int i = 0; i < 8; ++i) v[i] = *(const pg8::f32x4*)(colp4 + (size_t)(k0 + i * 8 + kr) * ldw);
#pragma unroll
    for (int i = 0; i < 8; ++i) { const int kk = i * 8 + kr;
        scr[kk * 33 + cq] = v[i][0]; scr[kk * 33 + cq + 1] = v[i][1]; scr[kk * 33 + cq + 2] = v[i][2]; scr[kk * 33 + cq + 3] = v[i][3]; }
    LDS_WAIT(); asm volatile("" ::: "memory");
    const int c = lane & 7;
#pragma unroll
    for (int j = 0; j < 4; ++j) { const int n = (lane >> 3) + 8 * j; const LAS float* s = scr + (8 * c) * 33 + n;
        uint4 o; o.x = pk2(s[0 * 33], s[1 * 33]); o.y = pk2(s[2 * 33], s[3 * 33]); o.z = pk2(s[4 * 33], s[5 * 33]); o.w = pk2(s[6 * 33], s[7 * 33]);
        *(uint4*)(WT + (size_t)(n0 + n) * K + k0 + 8 * c) = o; }
    LDS_WAIT(); asm volatile("" ::: "memory");
}
__device__ __forceinline__ unsigned pk4_fp8(float a, float b, float c, float d) { int p = __builtin_amdgcn_cvt_pk_fp8_f32(a, b, 0, false); p = __builtin_amdgcn_cvt_pk_fp8_f32(c, d, p, true); return (unsigned)p; }
__device__ __forceinline__ void tr_item4_f8(const float* colp4, size_t ldw, unsigned char* WT, int K, int k0, int n0, float scale, LAS float* scr, int lane) {
    const int kr = lane >> 3, cq = (lane & 7) * 4;
    pg8::f32x4 v[8];
#pragma unroll
    for (int i = 0; i < 8; ++i) v[i] = *(const pg8::f32x4*)(colp4 + (size_t)(k0 + i * 8 + kr) * ldw);
#pragma unroll
    for (int i = 0; i < 8; ++i) { const int kk = i * 8 + kr;
        scr[kk * 33 + cq] = v[i][0] * scale; scr[kk * 33 + cq + 1] = v[i][1] * scale; scr[kk * 33 + cq + 2] = v[i][2] * scale; scr[kk * 33 + cq + 3] = v[i][3] * scale; }
    LDS_WAIT(); asm volatile("" ::: "memory");
    const int c = lane & 7;
#pragma unroll
    for (int j = 0; j < 4; ++j) { const int n = (lane >> 3) + 8 * j; const LAS float* sp = scr + (8 * c) * 33 + n;
        uint2 o; o.x = pk4_fp8(sp[0 * 33], sp[1 * 33], sp[2 * 33], sp[3 * 33]); o.y = pk4_fp8(sp[4 * 33], sp[5 * 33], sp[6 * 33], sp[7 * 33]);
        *(uint2*)(WT + (size_t)(n0 + n) * K + k0 + 8 * c) = o; }
    LDS_WAIT(); asm volatile("" ::: "memory");
}
constexpr float SC13 = 64.f, SC2 = 32.f;
__device__ __forceinline__ int win_src(int n) {
    const int tt = n >> 10;
    if (tt < 3) return n;
    if (tt < 5) { const int d = n & 127; return 8 + (n & ~127) + (d & 1) * 64 + (d >> 1); }
    return n + 8;
}
__device__ __forceinline__ void ph0(const Args& a, LAS unsigned char* lds, int G) {
    const int tid = threadIdx.x, lane = tid & 63, wave = __builtin_amdgcn_readfirstlane(tid >> 6);
    unsigned char* ws = a.ws;
    LAS float* cact = (LAS float*)(lds + RING_OFF + 98304);
    const float* c = a.in[1]; const float* w_ada = a.in[2];
    for (int i = tid; i < 4096; i += 512) { const float cv = c[i]; cact[i] = cv / (1.f + expf(-cv)); }
    __syncthreads();
    float* modp = (float*)(ws + W::MODP);
    LAS float* red = (LAS float*)(lds + RING_OFF);
    for (int it = blockIdx.x; it < 192; it += G) { const int cb = it % 12, ks = it / 12; const int col = cb * 1024 + lane * 4, k0 = ks * 128 + wave * 16;
        pg8::f32x4 w[16];
#pragma unroll
        for (int i = 0; i < 16; ++i) w[i] = *(const pg8::f32x4*)(w_ada + (size_t)(k0 + i) * 12288 + col);
        pg8::f32x4 a0 = {0.f, 0.f, 0.f, 0.f}, a1 = {0.f, 0.f, 0.f, 0.f}, b0 = a0, b1 = a0, c0 = a0, c1 = a0, d0 = a0, d1 = a0;
        (void)b0; (void)b1; (void)c0; (void)c1; (void)d0; (void)d1;
#pragma unroll
        for (int i = 0; i < 16; ++i) { a0 += w[i] * cact[k0 + i]; a1 += w[i] * cact[2048 + k0 + i]; }
        pg8::f32x4 e0[3], e1[3];
#pragma unroll
        for (int q = 1; q < 4; ++q) { pg8::f32x4 t0 = {0.f, 0.f, 0.f, 0.f}, t1 = t0;
#pragma unroll
            for (int i = 0; i < 16; ++i) w[i] = *(const pg8::f32x4*)(w_ada + (size_t)(k0 + i) * 12288 + col + q * 256);
#pragma unroll
            for (int i = 0; i < 16; ++i) { t0 += w[i] * cact[k0 + i]; t1 += w[i] * cact[2048 + k0 + i]; }
            e0[q - 1] = t0; e1[q - 1] = t1; }
        __syncthreads();
        *(LAS pg8::f32x4*)(red + (wave * 2 + 0) * 1024 + lane * 4) = a0; *(LAS pg8::f32x4*)(red + (wave * 2 + 1) * 1024 + lane * 4) = a1;
#pragma unroll
        for (int q = 1; q < 4; ++q) { *(LAS pg8::f32x4*)(red + (wave * 2 + 0) * 1024 + q * 256 + lane * 4) = e0[q - 1]; *(LAS pg8::f32x4*)(red + (wave * 2 + 1) * 1024 + q * 256 + lane * 4) = e1[q - 1]; }
        __syncthreads();
        for (int i = tid; i < 2048; i += 512) { const int bb = i >> 10, cc = i & 1023; float t = 0.f;
#pragma unroll
            for (int wv = 0; wv < 8; ++wv) t += red[(wv * 2 + bb) * 1024 + cc];
            modp[(ks * 2 + bb) * 12288 + cb * 1024 + cc] = t; }
    }
    __syncthreads();
    float2* rope = (float2*)(ws + W::ROPE);
    for (int i = blockIdx.x * 512 + tid; i < 8192 * 64; i += G * 512) { const int s = i >> 6, j = i & 63;
        const float theta = powf(10000.f, -(float)j / 64.f); const float ang = (float)s * theta;
        const double ad = (double)ang, TWO_PI = 6.283185307179586; const double kq = rint(ad / TWO_PI); const float r = (float)(ad - kq * TWO_PI);
        rope[i] = make_float2(cosf(r), sinf(r)); }
    { bf16_t* wfr = (bf16_t*)(ws + W::WFR); const float* w_coarse = a.in[12]; const float* w_fine = a.in[14];
      for (int i = blockIdx.x * 512 + tid; i < 64 * 3 * 64 * 8; i += G * 512) { const int e8 = i & 7, ln = (i >> 3) & 63, ob = (i >> 9) % 3, ks = (i >> 9) / 3, o = ob * 16 + (ln & 15), k = 32 * ks + 8 * (ln >> 4) + e8;
          const float wv = o < 4 ? w_coarse[(size_t)k * 4 + o] : (o < 36 ? w_fine[((size_t)((o - 4) >> 3) * 2048 + k) * 8 + ((o - 4) & 7)] : 0.f);
          const unsigned h = f2bf(wv), l = f2bf(wv - __uint_as_float(h << 16));
          wfr[(((size_t)(ks * 3 + ob) * 2 + 0) * 64 + ln) * 8 + e8] = (bf16_t)h; wfr[(((size_t)(ks * 3 + ob) * 2 + 1) * 64 + ln) * 8 + e8] = (bf16_t)l; } }
    LAS float* scr = (LAS float*)(lds + RING_OFF + wave * 12288);
    const float* w_in = a.in[5]; const float* w_out = a.in[10]; const float* w1 = a.in[16]; const float* w3 = a.in[17]; const float* w2 = a.in[18];
    bf16_t* wt_in = (bf16_t*)(ws + W::WT_IN); bf16_t* wt_out = (bf16_t*)(ws + W::WT_OUT); bf16_t* wt_13 = (bf16_t*)(ws + W::WT_13); bf16_t* wt_2 = (bf16_t*)(ws + W::WT_2);
    constexpr int I_IN = 32 * 224, I_OUT = 32 * 64, I_13 = 32 * 1024, I_2 = 32 * 512, NITEMS = I_IN + I_OUT + I_13 + I_2;
    const int gw = blockIdx.x * NWAVES + wave, NGW = G * NWAVES;
    for (int it = gw; it < NITEMS; it += NGW) {
        int r = it;
        if (r < I_IN) { const int kb = r / 224, nb = r % 224; tr_item(w_in + win_src(nb * 32 + (lane & 31)), 7176, wt_in, 2048, kb * 64, nb * 32, scr, lane); continue; } r -= I_IN;
        if (r < I_OUT) { const int kb = r / 64, nb = r % 64; tr_item4(w_out + nb * 32 + (lane & 7) * 4, 2048, wt_out, 2048, kb * 64, nb * 32, scr, lane); continue; } r -= I_OUT;
        if (r < I_13) { const int e = r >> 10, r2 = r & 1023, kb = r2 >> 5, nb = r2 & 31; const int cq = lane & 7, g = (nb * 32 + cq * 4) >> 3;
            const float* colp4 = ((cq & 1) ? w3 : w1) + (size_t)e * 2048 * 512 + 4 * g;
            tr_item4_f8(colp4, 512, (unsigned char*)wt_13 + (size_t)e * 1024 * 2048, 2048, kb * 64, nb * 32, SC13, scr, lane); continue; } r -= I_13;
        { const int e = r >> 9, r2 = r & 511, kb = r2 >> 6, nb = r2 & 63;
          tr_item4_f8(w2 + (size_t)e * 512 * 2048 + nb * 32 + (lane & 7) * 4, 2048, (unsigned char*)wt_2 + (size_t)e * 2048 * 512, 512, kb * 64, nb * 32, SC2, scr, lane); }
    }
}

__device__ __forceinline__ void ph1(const Args& a, LAS unsigned char* lds, int G) {
    const int tid = threadIdx.x, lane = tid & 63, wave = __builtin_amdgcn_readfirstlane(tid >> 6);
    unsigned char* ws = a.ws;
    const float* x = a.in[0]; const float* b_ada = a.in[3]; const float* norm1_w = a.in[4]; const float* w_in = a.in[5]; const float* fbias = a.in[6];
    const float* modp = (const float*)(ws + W::MODP); float* mod = (float*)(ws + W::MOD); bf16_t* xn = (bf16_t*)(ws + W::XN); float* logf_ = (float*)(ws + W::LOGF);
    for (int i = blockIdx.x * 512 + tid; i < 2 * 12288; i += G * 512) { const int b = i / 12288, j = i % 12288; float s = b_ada[j];
        for (int k = 0; k < 16; ++k) s += modp[(k * 2 + b) * 12288 + j];
        mod[i] = s; }
    LAS float* A1 = (LAS float*)(lds + RING_OFF); LAS float* S1 = A1 + 2048; LAS float* WFT = S1 + 2048;
    for (int i = tid; i < 2048 * 2; i += 512) { const int cc = i >> 1, hf = (i & 1) * 4; const pg8::f32x4 w = *(const pg8::f32x4*)(w_in + (size_t)cc * 7176 + 3072 + hf);
        WFT[(hf + 0) * 2048 + cc] = w[0]; WFT[(hf + 1) * 2048 + cc] = w[1]; WFT[(hf + 2) * 2048 + cc] = w[2]; WFT[(hf + 3) * 2048 + cc] = w[3]; }
    int bprev = -1;
    for (int rb = blockIdx.x; rb < 256; rb += G) {
        const int b = rb >> 7;
        if (b != bprev) { __syncthreads();
            for (int cc = tid; cc < 2048; cc += 512) { float sh = b_ada[cc], sc = b_ada[2048 + cc];
                for (int k = 0; k < 16; ++k) { sh += modp[(k * 2 + b) * 12288 + cc]; sc += modp[(k * 2 + b) * 12288 + 2048 + cc]; }
                A1[cc] = norm1_w[cc] * (1.f + sc); S1[cc] = sh; }
            __syncthreads(); bprev = b; }
#pragma unroll 1
        for (int q = 0; q < 8; ++q) {
            const int row = rb * 64 + wave * 8 + q;
            pg8::f32x4 v[8]; float ss = 0.f;
#pragma unroll
            for (int j = 0; j < 8; ++j) { v[j] = *(const pg8::f32x4*)(x + (size_t)row * 2048 + j * 256 + lane * 4); ss += (v[j][0] * v[j][0] + v[j][1] * v[j][1]) + (v[j][2] * v[j][2] + v[j][3] * v[j][3]); }
            const float rstd = rsqrtf(wave_sum(ss) * (1.f / 2048.f) + 1e-6f);
            float fa[8] = {0.f, 0.f, 0.f, 0.f, 0.f, 0.f, 0.f, 0.f};
#pragma unroll
            for (int j = 0; j < 8; ++j) { const int c = j * 256 + lane * 4; const pg8::f32x4 a1 = *(const LAS pg8::f32x4*)(A1 + c), s1 = *(const LAS pg8::f32x4*)(S1 + c);
                const pg8::f32x4 h = v[j] * rstd * a1 + s1;
                uint2 pk; pk.x = pk2(h[0], h[1]); pk.y = pk2(h[2], h[3]); *(uint2*)(xn + (size_t)row * 2048 + c) = pk;
#pragma unroll
                for (int hh = 0; hh < 8; ++hh) { const pg8::f32x4 w = *(const LAS pg8::f32x4*)(WFT + hh * 2048 + c); fa[hh] += (h[0] * w[0] + h[1] * w[1]) + (h[2] * w[2] + h[3] * w[3]); }
                asm volatile("" ::: "memory"); }
            float t = 0.f;
#pragma unroll
            for (int hh = 0; hh < 8; ++hh) { const float sm = wave_sum(fa[hh]); if (lane == hh) t = sm; }
            if (lane < 8) logf_[(size_t)((row >> 13) * 8 + lane) * 8192 + (row & 8191)] = log_sigmoid_f(t + fbias[lane]);
        }
    }
    __syncthreads();
}

__device__ __forceinline__ void cumsum_bh(const Args& a, LAS unsigned char* lds, int bh) {
    const int tid = threadIdx.x; unsigned char* ws = a.ws;
    const float* p = (const float*)(ws + W::LOGF) + (size_t)bh * 8192 + tid * 16; float* cum = (float*)(ws + W::CUM) + (size_t)bh * 8192 + tid * 16; float* bias = (float*)(ws + W::BIAS) + (size_t)bh * 8192 + tid * 16;
    LAS double* sc = (LAS double*)(lds + RING_OFF);
    double run = 0.0;
#pragma unroll
    for (int i = 0; i < 16; ++i) run += (double)p[i];
    sc[tid] = run; __syncthreads();
    int cur = 0;
    for (int o = 1; o < 512; o <<= 1) { const double t = sc[cur * 512 + tid] + (tid >= o ? sc[cur * 512 + tid - o] : 0.0); sc[(cur ^ 1) * 512 + tid] = t; cur ^= 1; __syncthreads(); }
    double acc = sc[cur * 512 + tid] - run;
    LAS float* TE = (LAS float*)(lds + RING_OFF + 16384); LAS float* BS = TE + 128; LAS int* JL = (LAS int*)(BS + 32);
#pragma unroll
    for (int i = 0; i < 16; ++i) { acc += (double)p[i]; cum[i] = (float)acc; bias[i] = (float)(-acc * 11.313708498984761);
        if (i == 0 && (tid & 15) == 0) BS[tid >> 4] = (float)acc;
        if (i == 15 && (tid & 3) == 3) TE[tid >> 2] = (float)acc; }
    if (tid < 32) JL[tid] = 4 * tid;
    __syncthreads();
    float mq = 0.f, mk = 0.f;
    for (int i = 0; i < 128; ++i) { mq = fmaxf(mq, fabsf(a.in[7][i])); mk = fmaxf(mk, fabsf(a.in[8][i])); }
    const float thr = 30.f + 2.f * 11.313708498984761f * mq * mk;
    for (int pr = tid; pr < 32 * 128; pr += 512) { const int qb = pr >> 7, j = pr & 127; if (j <= 4 * qb && TE[j] < BS[qb] + thr) atomicMin((int*)(JL + qb), j); }
    __syncthreads();
    if (tid < 32) ((int*)(ws + W::JLO))[bh * 32 + tid] = JL[tid];
    __syncthreads();
}
struct EpiZ {
    static constexpr bool PERM = true, AFTER_DRAIN = false;
    bf16_t* qkv; const float* q_norm_w; const float* k_norm_w; const float* rope; PG8_LAS float* xch;
    __device__ __forceinline__ void operator()(const pg8::f32x4 (&acc)[2][2][4][2], const pg8::Unit& u, int wr, int wc, int fr, int fq) const {
        using pg8::f32x4; using pg8::u32x4;
        const int tt = u.pn >> 2, hp = (u.pn & 3) * 2;
        const int row0 = u.pm * 256 + wr * 64 + fr, b = row0 >> 13, dcol = wc * 32 + 8 * fq;
        bf16_t* base = qkv + (size_t)tt * QKV_ELEMS + ((size_t)(b * 8 + hp) * 8192) * 128 + dcol;
        if (tt < 2) {
#pragma unroll
            for (int ai = 0; ai < 2; ++ai)
#pragma unroll
                for (int m = 0; m < 4; ++m)
#pragma unroll
                    for (int bj = 0; bj < 2; ++bj) { const f32x4 v0 = acc[ai][bj][m][0], v1 = acc[ai][bj][m][1];
                        float s = (v0[0] * v0[0] + v0[1] * v0[1]) + (v0[2] * v0[2] + v0[3] * v0[3]) + (v1[0] * v1[0] + v1[1] * v1[1]) + (v1[2] * v1[2] + v1[3] * v1[3]);
                        s += __shfl_xor(s, 16); s += __shfl_xor(s, 32);
                        if (fq == 0) xch[((ai * 128 + wr * 64 + m * 16 + fr) * 2 + bj) * 4 + wc] = s; }
            asm volatile("s_waitcnt lgkmcnt(0)" ::: "memory"); __builtin_amdgcn_s_barrier(); asm volatile("" ::: "memory");
            const float* nw = tt == 0 ? q_norm_w : k_norm_w; const f32x4 w0 = *(const f32x4*)(nw + dcol), w1 = *(const f32x4*)(nw + dcol + 4);
#pragma unroll
            for (int ai = 0; ai < 2; ++ai)
#pragma unroll
                for (int m = 0; m < 4; ++m) { const int rl = ai * 128 + wr * 64 + m * 16 + fr; const int s_ = (row0 + ai * 128 + m * 16) & 8191;
#pragma unroll
                    for (int bj = 0; bj < 2; ++bj) { const f32x4 p = *(const PG8_LAS f32x4*)(xch + (rl * 2 + bj) * 4);
                        const float rstd = rsqrtf(((p[0] + p[1]) + (p[2] + p[3])) * (1.f / 128.f) + 1e-6f);
                        const f32x4 v0 = acc[ai][bj][m][0] * rstd * w0, v1 = acc[ai][bj][m][1] * rstd * w1;
                        u32x4 w; w.x = pg8::cvt_pk_bf16(v0[0], v0[1]); w.y = pg8::cvt_pk_bf16(v0[2], v0[3]); w.z = pg8::cvt_pk_bf16(v1[0], v1[1]); w.w = pg8::cvt_pk_bf16(v1[2], v1[3]);
                        *(u32x4*)(base + ((size_t)bj * 8192 + s_) * 128) = w; } }
        } else if (tt == 3 || tt == 4) {
            float l2g[2];
#pragma unroll
            for (int bj = 0; bj < 2; ++bj) l2g[bj] = log2f(1.f - exp2f(-5.f - (float)(hp + bj)));
#pragma unroll
            for (int ai = 0; ai < 2; ++ai)
#pragma unroll
                for (int m = 0; m < 4; ++m) { const int s_ = (row0 + ai * 128 + m * 16) & 8191;
                    const f32x4 c0 = *(const f32x4*)(rope + ((size_t)s_ * 64 + (dcol >> 1)) * 2), c1 = *(const f32x4*)(rope + ((size_t)s_ * 64 + (dcol >> 1) + 2) * 2);
#pragma unroll
                    for (int bj = 0; bj < 2; ++bj) { const f32x4 v0 = acc[ai][bj][m][0], v1 = acc[ai][bj][m][1];
                        const float f = tt == 4 ? 0.08838834764831845f * exp2f(-(float)(s_ & 63) * l2g[bj]) : 1.f;
                        const float o0 = (v0[0] * c0[0] - v0[1] * c0[1]) * f, o1 = (v0[0] * c0[1] + v0[1] * c0[0]) * f, o2 = (v0[2] * c0[2] - v0[3] * c0[3]) * f, o3 = (v0[2] * c0[3] + v0[3] * c0[2]) * f;
                        const float o4 = (v1[0] * c1[0] - v1[1] * c1[1]) * f, o5 = (v1[0] * c1[1] + v1[1] * c1[0]) * f, o6 = (v1[2] * c1[2] - v1[3] * c1[3]) * f, o7 = (v1[2] * c1[3] + v1[3] * c1[2]) * f;
                        u32x4 w; w.x = pg8::cvt_pk_bf16(o0, o1); w.y = pg8::cvt_pk_bf16(o2, o3); w.z = pg8::cvt_pk_bf16(o4, o5); w.w = pg8::cvt_pk_bf16(o6, o7);
                        *(u32x4*)(base + ((size_t)bj * 8192 + s_) * 128) = w; } }
        } else {
#pragma unroll
            for (int ai = 0; ai < 2; ++ai)
#pragma unroll
                for (int m = 0; m < 4; ++m) { const int s_ = (row0 + ai * 128 + m * 16) & 8191;
#pragma unroll
                    for (int bj = 0; bj < 2; ++bj) { f32x4 v0 = acc[ai][bj][m][0], v1 = acc[ai][bj][m][1];
                        if (tt == 6) {
#pragma unroll
                            for (int e = 0; e < 4; ++e) { v0[e] = v0[e] / (1.f + __expf(-v0[e])); v1[e] = v1[e] / (1.f + __expf(-v1[e])); } }
                        u32x4 w; w.x = pg8::cvt_pk_bf16(v0[0], v0[1]); w.y = pg8::cvt_pk_bf16(v0[2], v0[3]); w.z = pg8::cvt_pk_bf16(v1[0], v1[1]); w.w = pg8::cvt_pk_bf16(v1[2], v1[3]);
                        *(u32x4*)(base + ((size_t)bj * 8192 + s_) * 128) = w; } }
        }
    }
};


__device__ __forceinline__ void kv_units(const Args& a, char* lds, int G) {
    using namespace at;
    const int tid = threadIdx.x, wid = __builtin_amdgcn_readfirstlane(tid >> 6), lane = tid & 63, r32 = lane & 31, hi = lane >> 5;
    const int sr = tid >> 4, sc = (tid & 15) * 8, st0 = v_st(sr, sc), st1 = v_st(32 + sr, sc);
    const int dblk = wid >> 1, eb0 = (wid & 1) * 2;
    const int kb_ = (int)(uintptr_t)lds + v_rd_base(lane) + dblk * 512, vb_ = (int)(uintptr_t)lds + 32768 + v_rd_base(lane) + eb0 * 512;
    const bf16* q = (const bf16*)(a.ws + W::QKV); float* kvs = (float*)(a.ws + W::KVS);
#define TRRD(dst, base, off) asm volatile("ds_read_b64_tr_b16 %0, %1 offset:%2" : "=&v"(dst) : "v"(base), "i"(off) : "memory")
#define KV_STEP(BUF, KS) do { s16x4 al, ah, b0l, b0h, b1l, b1h; constexpr int o_ = (BUF) * 16384 + (KS) * 4096; \
        TRRD(al, kb_, o_); TRRD(ah, kb_, o_ + 2048); TRRD(b0l, vb_, o_); TRRD(b0h, vb_, o_ + 2048); TRRD(b1l, vb_, o_ + 512); TRRD(b1h, vb_, o_ + 512 + 2048); \
        asm volatile("s_waitcnt lgkmcnt(0)" ::: "memory"); SBAR(); \
        const bf16x8 A_ = {al[0], al[1], al[2], al[3], ah[0], ah[1], ah[2], ah[3]}; \
        acc0 = __builtin_amdgcn_mfma_f32_32x32x16_bf16(A_, (bf16x8){b0l[0], b0l[1], b0l[2], b0l[3], b0h[0], b0h[1], b0h[2], b0h[3]}, acc0, 0, 0, 0); \
        acc1 = __builtin_amdgcn_mfma_f32_32x32x16_bf16(A_, (bf16x8){b1l[0], b1l[1], b1l[2], b1l[3], b1h[0], b1h[1], b1h[2], b1h[3]}, acc1, 0, 0, 0); } while (0)
#define KV_LOAD(T) do { k0 = *(const bf16x8*)(Kp + (unsigned)((64 * (T) + sr) * 128 + sc)); k1 = *(const bf16x8*)(Kp + (unsigned)((64 * (T) + 32 + sr) * 128 + sc)); \
                        v0 = *(const bf16x8*)(Vp + (unsigned)((64 * (T) + sr) * 128 + sc)); v1 = *(const bf16x8*)(Vp + (unsigned)((64 * (T) + 32 + sr) * 128 + sc)); } while (0)
#define KV_WRITE(BUF) do { *(bf16x8*)(lds + (BUF) * 16384 + st0) = k0; *(bf16x8*)(lds + (BUF) * 16384 + st1) = k1; *(bf16x8*)(lds + 32768 + (BUF) * 16384 + st0) = v0; *(bf16x8*)(lds + 32768 + (BUF) * 16384 + st1) = v1; } while (0)
#define KV_TILE(T, BUF) do { if ((T) < 3) KV_LOAD((T) + 1); if ((T) > 0) { acc0 *= g64; acc1 *= g64; } \
        KV_STEP(BUF, 0); KV_STEP(BUF, 1); KV_STEP(BUF, 2); KV_STEP(BUF, 3); if ((T) < 3) { KV_WRITE(1 - (BUF)); } __syncthreads(); } while (0)
    for (int L = blockIdx.x; L < 512; L += G) {
        const int bh = L >> 5, c = L & 31;
        const float l2g = log2f(1.f - exp2f(-5.f - (float)(bh & 7))), g64 = exp2f(64.f * l2g), g63 = exp2f(63.f * l2g);
        const bf16* Kp = q + 4 * QKV_ELEMS + ((size_t)bh * 8192 + c * 256) * 128; const bf16* Vp = q + 5 * QKV_ELEMS + ((size_t)bh * 8192 + c * 256) * 128;
        f32x16 acc0 = {}, acc1 = {}; bf16x8 k0, k1, v0, v1;
        KV_LOAD(0); KV_WRITE(0); __syncthreads();
        KV_TILE(0, 0); KV_TILE(1, 1); KV_TILE(2, 0); KV_TILE(3, 1);
        float* out = kvs + ((size_t)(bh * 32 + c)) * 16384 + (unsigned)((dblk * 32 + 4 * hi) * 128 + eb0 * 32 + r32);
#pragma unroll
        for (int r = 0; r < 16; ++r) { const int ro = (r & 3) + 8 * (r >> 2); out[ro * 128] = g63 * acc0[r]; out[ro * 128 + 32] = g63 * acc1[r]; }
    }
#undef TRRD
#undef KV_STEP
#undef KV_LOAD
#undef KV_WRITE
#undef KV_TILE
}
__device__ __forceinline__ void scan_units(const Args& a, LAS unsigned char* lds, int G) {
    const int tid = threadIdx.x, dl = tid >> 6, e2 = (tid & 63) * 2;
    const float* kvs = (const float*)(a.ws + W::KVS); bf16_t* st = (bf16_t*)(a.ws + W::ST);
    LAS bf16_t* T = (LAS bf16_t*)(lds + RING_OFF);
    for (int L = blockIdx.x; L < 256; L += G) {
        const int bh = L >> 4, d0 = (L & 15) * 8;
        const float g256 = exp2f(256.f * log2f(1.f - exp2f(-5.f - (float)(bh & 7))));
        float2 kv[32];
#pragma unroll
        for (int c = 0; c < 32; ++c) kv[c] = *(const float2*)(kvs + ((size_t)(bh * 32 + c)) * 16384 + (d0 + dl) * 128 + e2);
        float s0 = 0.f, s1 = 0.f;
#pragma unroll
        for (int c = 0; c < 32; ++c) {
            T[e2 * 8 + dl] = (bf16_t)f2bf(s0); T[(e2 + 1) * 8 + dl] = (bf16_t)f2bf(s1);
            __syncthreads();
            if (tid < 128) *(pg8::u32x4*)(st + (((size_t)(bh * 32 + c)) * 128 + tid) * 128 + d0) = *(const LAS pg8::u32x4*)(T + tid * 8);
            s0 = g256 * s0 + kv[c].x; s1 = g256 * s1 + kv[c].y;
            __syncthreads();
        }
    }
}
typedef at::BlockRef<at::bf16, at::bf16> ARef;
template <int MODE> __device__ __forceinline__ ARef attn_ref_bq(const Args& a, int bh, int qb) {
    const int b = bh >> 3, h = bh & 7;
    const at::bf16* q = (const at::bf16*)(a.ws + W::QKV) + (MODE ? 3 * QKV_ELEMS : 0); ARef r;
    r.Q = q + ((size_t)bh * 8192 + qb * 256) * 128; r.K = q + QKV_ELEMS + (size_t)bh * 8192 * 128; r.V = q + 2 * QKV_ELEMS + (size_t)bh * 8192 * 128;
    r.O = (at::bf16*)(a.ws + W::MIX) + ((size_t)(b * 8192 + qb * 256)) * 2048 + (MODE ? 1024 : 0) + h * 128; r.P0 = qb * 256; r.bh = bh; r.jlo = MODE ? 0 : ((const int*)(a.ws + W::JLO))[bh * 32 + qb];
    if (MODE) r.jlo = 4 * qb;
    return r;
}
template <int MODE> __device__ __forceinline__ ARef attn_ref(const Args& a, int L, int pass) { const int bh = L >> 4, x = L & 15; return attn_ref_bq<MODE>(a, bh, pass ? 31 - x : x); }
__device__ __forceinline__ void fox_stream(const Args& a, char* lds) {
    const int tid = threadIdx.x;
    gu32* q = (gu32*)(a.ws + W::CTL) + CW_QFOX; volatile int* tk = (volatile int*)(lds + 100352);
    if (tid == 0) { tk[0] = (int)__hip_atomic_fetch_add(q, 1u, RLX_AGENT); tk[1] = (int)__hip_atomic_fetch_add(q, 1u, RLX_AGENT); }
    __syncthreads();
    int i0 = __builtin_amdgcn_readfirstlane(tk[0]), i1 = __builtin_amdgcn_readfirstlane(tk[1]);
    __syncthreads();
    if (i0 >= 512) return;
    const at::Extra<at::bf16> X{(const float*)(a.ws + W::BIAS), nullptr, nullptr, nullptr};
    ARef cur = attn_ref_bq<0>(a, i0 & 15, 31 - (i0 >> 4));
    at::Seam<at::bf16> S;
    at::causal_swa_prime<at::bf16, at::bf16>(cur, at::WBIG, lds, S);
    for (;;) {
        if (tid == 0) tk[0] = (int)__hip_atomic_fetch_add(q, 1u, RLX_AGENT);
        const bool last = i1 >= 512;
        const ARef nr = last ? cur : attn_ref_bq<0>(a, i1 & 15, 31 - (i1 >> 4));
        const at::NextRef<at::bf16> nxt{nr.Q, nr.K, nr.V, nr.jlo};
        at::causal_swa_block<0, at::bf16, at::bf16>(cur, nxt, X, 8192, at::WBIG, lds, S);
        if (last) break;
        const int i2 = __builtin_amdgcn_readfirstlane(tk[0]);
        __syncthreads();
        cur = attn_ref_bq<0>(a, i1 & 15, 31 - (i1 >> 4)); i0 = i1; i1 = i2;
    }
}
template <int MODE> __device__ __forceinline__ void attn_stream(const Args& a, char* lds, int G) {
    int L = blockIdx.x; if (L >= 256) return;
    int pass = 0; ARef cur = attn_ref<MODE>(a, L, 0);
    const at::Extra<at::bf16> X{(const float*)(a.ws + W::BIAS), (const at::bf16*)(a.ws + W::QKV) + 6 * QKV_ELEMS, a.in[9], (const at::bf16*)(a.ws + W::ST)};
    at::Seam<at::bf16> S;
    at::causal_swa_prime<at::bf16, at::bf16>(cur, at::WBIG, lds, S);
    for (;;) {
        const bool more_pass = pass == 0, more_item = L + G < 256, last = !more_pass && !more_item;
        int Ln = L, passn = 1; if (!more_pass) { passn = 0; Ln = more_item ? L + G : L; }
        const ARef nr = last ? cur : attn_ref<MODE>(a, Ln, passn);
        const at::NextRef<at::bf16> nxt{nr.Q, nr.K, nr.V, nr.jlo};
        at::causal_swa_block<MODE, at::bf16, at::bf16>(cur, nxt, X, 8192, at::WBIG, lds, S);
        if (last) break;
        cur = attn_ref<MODE>(a, Ln, passn); L = Ln; pass = passn;
    }
}


struct EpiX1 {
    static constexpr bool PERM = false, AFTER_DRAIN = false;
    const float* x; const float* mod; float* out;
    __device__ __forceinline__ void operator()(const pg8::f32x4 (&acc)[2][2][4][2], const pg8::Unit& u, int wr, int wc, int fr, int fq) const {
        using pg8::f32x4;
        const int row0 = u.pm * 256 + wr * 64 + fr, b = row0 >> 13, col0 = u.pn * 256 + wc * 32 + 4 * fq;
        f32x4 g[2][2];
#pragma unroll
        for (int bj = 0; bj < 2; ++bj)
#pragma unroll
            for (int n = 0; n < 2; ++n) g[bj][n] = *(const f32x4*)(mod + b * 12288 + 4096 + col0 + bj * 128 + n * 16);
#pragma unroll
        for (int ai = 0; ai < 2; ++ai)
#pragma unroll
            for (int m = 0; m < 4; ++m) { const size_t off = (size_t)(row0 + ai * 128 + m * 16) * 2048 + col0;
#pragma unroll
                for (int bj = 0; bj < 2; ++bj)
#pragma unroll
                    for (int n = 0; n < 2; ++n) { const f32x4 xv = *(const f32x4*)(x + off + bj * 128 + n * 16); *(f32x4*)(out + off + bj * 128 + n * 16) = xv + g[bj][n] * acc[ai][bj][m][n]; }
                if (m & 1) asm volatile("" ::: "memory"); }
    }
};

__device__ __forceinline__ void router_tables(const Args& a, LAS unsigned char* lds, int b) {
    const int tid = threadIdx.x, lane = tid & 63, wave = __builtin_amdgcn_readfirstlane(tid >> 6);
    const float* norm2_w = a.in[11]; const float* w_coarse = a.in[12]; const float* b_coarse = a.in[13]; const float* w_fine = a.in[14]; const float* b_fine = a.in[15];
    const float* mod = (const float*)(a.ws + W::MOD) + b * 12288; float* tab = (float*)(a.ws + W::A2S2);
    LAS float* S2 = (LAS float*)(lds + RING_OFF); LAS float* RD = S2 + 2048;
    for (int cc = tid; cc < 2048; cc += 512) { const float sv = mod[6144 + cc]; tab[b * 2048 + cc] = norm2_w[cc] * (1.f + mod[8192 + cc]); tab[4096 + b * 2048 + cc] = sv; S2[cc] = sv; }
    __syncthreads();
    for (int c0 = 0; c0 < 36; c0 += 4) { float part[4] = {0.f, 0.f, 0.f, 0.f};
#pragma unroll
        for (int q = 0; q < 4; ++q) { const int k = tid * 4 + q; const float sv = S2[k];
            const float4 wv = c0 == 0 ? *(const float4*)(w_coarse + (size_t)k * 4) : *(const float4*)(w_fine + ((size_t)((c0 - 4) >> 3) * 2048 + k) * 8 + ((c0 - 4) & 7));
            part[0] += sv * wv.x; part[1] += sv * wv.y; part[2] += sv * wv.z; part[3] += sv * wv.w; }
#pragma unroll
        for (int i = 0; i < 4; ++i) { const float t = wave_sum(part[i]); if (lane == 0) RD[(c0 + i) * 8 + wave] = t; } }
    __syncthreads();
    if (tid < 36) { float t = tid < 4 ? b_coarse[tid] : b_fine[tid - 4];
        for (int w = 0; w < 8; ++w) t += RD[tid * 8 + w];
        tab[8192 + b * 64 + tid] = t; }
    __syncthreads();
}
typedef short bfx8 __attribute__((ext_vector_type(8)));
__device__ __forceinline__ void split8(const float* v, bfx8& h, bfx8& l) {
    unsigned hw[4], lw[4];
#pragma unroll
    for (int i = 0; i < 4; ++i) { const unsigned h0 = f2bf(v[2 * i]), h1 = f2bf(v[2 * i + 1]); hw[i] = h0 | (h1 << 16);
        const float r0 = v[2 * i] - __uint_as_float(h0 << 16), r1 = v[2 * i + 1] - __uint_as_float(h1 << 16); lw[i] = f2bf(r0) | (f2bf(r1) << 16); }
    typedef unsigned u4 __attribute__((ext_vector_type(4)));
    const u4 hv = {hw[0], hw[1], hw[2], hw[3]}, lv = {lw[0], lw[1], lw[2], lw[3]};
    h = __builtin_bit_cast(bfx8, hv); l = __builtin_bit_cast(bfx8, lv);
}
__device__ __forceinline__ void ph5(const Args& a, LAS unsigned char* lds, int G) {
    using pg8::f32x4;
    const int tid = threadIdx.x, lane = tid & 63, wave = __builtin_amdgcn_readfirstlane(tid >> 6), fr = lane & 15, fq = lane >> 4;
    unsigned char* ws = a.ws; const float* x1 = a.out; bf16_t* h2 = (bf16_t*)(ws + W::H2);
    const float* tab = (const float*)(ws + W::A2S2);
    int* r_eid = (int*)(ws + W::ROUTE); float* r_gate = (float*)(ws + W::ROUTE + 128 * 1024); int* r_idx = (int*)(ws + W::ROUTE + 256 * 1024); int* cnt = (int*)(ws + W::CTL) + CW_CNT;
    constexpr int XP = 2052;
    LAS float* XT = (LAS float*)(lds + RING_OFF); LAS float* PART = XT + 16 * XP; LAS float* RS = PART + 8 * 16 * 36; LAS float* LG = RS + 16; LAS int* CH = (LAS int*)(LG + 16 * 36); LAS int* LC = CH + 128; LAS int* LB = LC + 32;
    const bfx8* wfr = (const bfx8*)(ws + W::WFR) + (size_t)(wave * 8) * 6 * 64;
    int T = blockIdx.x * 4; if (T >= 1024) return;
    f32x4 xn[16];
#define RT_LOAD(TT) do { _Pragma("unroll") for (int q = 0; q < 2; ++q) _Pragma("unroll") for (int j = 0; j < 8; ++j) \
        xn[q * 8 + j] = *(const f32x4*)(x1 + (size_t)((TT) * 16 + 2 * wave + q) * 2048 + j * 256 + lane * 4); } while (0)
    RT_LOAD(T);
    for (;;) {
        const int r0 = T * 16, b = r0 >> 13;
#pragma unroll
        for (int q = 0; q < 2; ++q) { const int rl = 2 * wave + q; float ss = 0.f;
#pragma unroll
            for (int j = 0; j < 8; ++j) { const f32x4 v = xn[q * 8 + j]; ss += (v[0] * v[0] + v[1] * v[1]) + (v[2] * v[2] + v[3] * v[3]); *(LAS f32x4*)(XT + rl * XP + j * 256 + lane * 4) = v; }
            ss = wave_sum(ss); if (lane == 0) RS[rl] = rsqrtf(ss * (1.f / 2048.f) + 1e-6f); }
        __syncthreads();
        const int Tn = (T & 3) < 3 ? T + 1 : T - 3 + 4 * G; const bool has_next = Tn < 1024;
        if (has_next) RT_LOAD(Tn);
        f32x4 acc[3] = {{0.f, 0.f, 0.f, 0.f}, {0.f, 0.f, 0.f, 0.f}, {0.f, 0.f, 0.f, 0.f}};
        unsigned ln = lane; asm volatile("" : "+v"(ln));
#pragma unroll 2
        for (int ks = 0; ks < 8; ++ks) { const int k = 256 * wave + 32 * ks + 8 * fq;
            const f32x4 v0 = *(const LAS f32x4*)(XT + fr * XP + k), v1 = *(const LAS f32x4*)(XT + fr * XP + k + 4);
            const f32x4 a0 = *(const f32x4*)(tab + b * 2048 + k), a1 = *(const f32x4*)(tab + b * 2048 + k + 4);
            const float av[8] = {v0[0] * a0[0], v0[1] * a0[1], v0[2] * a0[2], v0[3] * a0[3], v1[0] * a1[0], v1[1] * a1[1], v1[2] * a1[2], v1[3] * a1[3]};
            bfx8 ah, al; split8(av, ah, al);
#pragma unroll
            for (int ob = 0; ob < 3; ++ob) { const bfx8 bh = (wfr + ((ks * 3 + ob) * 2) * 64)[ln], bl = (wfr + ((ks * 3 + ob) * 2 + 1) * 64)[ln];
                acc[ob] = __builtin_amdgcn_mfma_f32_16x16x32_bf16(ah, bh, acc[ob], 0, 0, 0);
                acc[ob] = __builtin_amdgcn_mfma_f32_16x16x32_bf16(al, bh, acc[ob], 0, 0, 0);
                acc[ob] = __builtin_amdgcn_mfma_f32_16x16x32_bf16(ah, bl, acc[ob], 0, 0, 0); } }
#pragma unroll
        for (int ob = 0; ob < 3; ++ob) { const int o = ob * 16 + fr;
            if (o < 36) {
#pragma unroll
                for (int r = 0; r < 4; ++r) PART[(wave * 16 + 4 * fq + r) * 36 + o] = acc[ob][r]; } }
        __syncthreads();
        for (int it = tid; it < 576; it += 512) { const int rl = it / 36, o = it - rl * 36; float t = 0.f;
#pragma unroll
            for (int w = 0; w < 8; ++w) t += PART[(w * 16 + rl) * 36 + o];
            LG[it] = RS[rl] * t + tab[8192 + b * 64 + o]; }
        __syncthreads();
        if (tid < 16) { const int row = r0 + tid; const LAS float* lg = LG + tid * 36;
            int gs = 0; float cmax = lg[0];
#pragma unroll
            for (int g = 1; g < 4; ++g) if (lg[g] > cmax) { cmax = lg[g]; gs = g; }
            float den = 0.f;
#pragma unroll
            for (int g = 0; g < 4; ++g) den += expf(lg[g] - cmax);
            const float pg = 1.f / den;
            float f0 = -3.0e38f, f1 = -3.0e38f; int e0 = 0, e1 = 0;
#pragma unroll
            for (int e = 0; e < 8; ++e) { const float fl = lg[4 + gs * 8 + e];
                if (fl > f0) { f1 = f0; e1 = e0; f0 = fl; e0 = e; } else if (fl > f1) { f1 = fl; e1 = e; } }
            const float t1 = expf(f1 - f0); const float g0 = pg / (1.f + t1), g1 = pg * t1 / (1.f + t1);
            const int E0 = gs * 8 + e0, E1 = gs * 8 + e1;
            r_eid[2 * row] = E0; r_eid[2 * row + 1] = E1; r_gate[2 * row] = g0; r_gate[2 * row + 1] = g1;
            CH[((T & 3) * 16 + tid) * 2] = E0; CH[((T & 3) * 16 + tid) * 2 + 1] = E1; }
#pragma unroll
        for (int q = 0; q < 2; ++q) { const int rl = 2 * wave + q; const float rstd = RS[rl]; unsigned char* hrow = (unsigned char*)h2 + (size_t)(r0 + rl) * 2048;
#pragma unroll
            for (int j = 0; j < 8; ++j) { const int c = j * 256 + lane * 4; const f32x4 xv = *(const LAS f32x4*)(XT + rl * XP + c);
                const f32x4 aa = *(const f32x4*)(tab + b * 2048 + c), sv = *(const f32x4*)(tab + 4096 + b * 2048 + c);
                *(unsigned*)(hrow + c) = pk4_fp8(xv[0] * rstd * aa[0] + sv[0], xv[1] * rstd * aa[1] + sv[1], xv[2] * rstd * aa[2] + sv[2], xv[3] * rstd * aa[3] + sv[3]); } }
        __syncthreads();
        if ((T & 3) == 3) {
            if (tid < 32) LC[tid] = 0;
            __syncthreads();
            int rk = 0, ee = 0;
            if (tid < 128) { ee = CH[tid]; rk = atomicAdd((int*)(LC + ee), 1); }
            __syncthreads();
            if (tid < 32) { const int n = LC[tid]; LB[tid] = n ? atomicAdd(cnt + tid * CNT_STRIDE, n) : 0; }
            __syncthreads();
            if (tid < 128) r_idx[(size_t)(T >> 2) * 128 + tid] = LB[ee] + rk;
            __syncthreads();
        }
        if (!has_next) break;
        T = Tn;
    }
#undef RT_LOAD
}
__device__ __forceinline__ void ph6(const Args& a, LAS unsigned char* lds, int G) {
    const int tid = threadIdx.x, lane = tid & 63, wave = __builtin_amdgcn_readfirstlane(tid >> 6);
    unsigned char* ws = a.ws;
    const int* cnt = (const int*)(ws + W::CTL) + CW_CNT; int* pstart_g = (int*)(ws + W::TILE); int* tile_e = pstart_g + 64; int* ntile = pstart_g + 512;
    const int* r_eid = (const int*)(ws + W::ROUTE); const int* r_idx = (const int*)(ws + W::ROUTE + 256 * 1024); int* r_slot = (int*)(ws + W::ROUTE + 384 * 1024);
    LAS int* ps = (LAS int*)(lds + RING_OFF);
    if (tid == 0) { int p = 0, t = 0;
        for (int e = 0; e < 32; ++e) { ps[e] = p; const int n = (cnt[e * CNT_STRIDE] + 255) >> 8; if (blockIdx.x == 0) { pstart_g[e] = p; for (int i = 0; i < n; ++i) tile_e[t + i] = e; } t += n; p += n * 256; }
        ps[32] = p; if (blockIdx.x == 0) { pstart_g[32] = p; *ntile = t; } }
    __syncthreads();
    const bf16_t* h2 = (const bf16_t*)(ws + W::H2); bf16_t* xs = (bf16_t*)(ws + W::XS);
    for (int mk = blockIdx.x * NWAVES + wave; mk < 2 * M_TOK; mk += G * NWAVES) {
        const int slot = ps[r_eid[mk]] + r_idx[mk]; if (lane == 0) r_slot[mk] = slot;
        const uint4* src = (const uint4*)((const unsigned char*)h2 + (size_t)(mk >> 1) * 2048) + lane; uint4* dst = (uint4*)((unsigned char*)xs + (size_t)slot * 2048) + lane;
        uint4 v[2];
#pragma unroll
        for (int j = 0; j < 2; ++j) v[j] = src[64 * j];
#pragma unroll
        for (int j = 0; j < 2; ++j) dst[64 * j] = v[j];
    }
    __syncthreads();
}
template <int LOG2_NN> struct GroupedOrder {
    const int* tile_e; int nunits, G, c;
    __device__ void init(const int* tile_e_, const int* ntile, int G_, int c_) { tile_e = tile_e_; nunits = *ntile << LOG2_NN; G = G_; c = c_; }
    __device__ bool next(int i, pg8::Unit& u) const { const int L = i * G + c; if (L >= nunits) return false; u.pm = L >> LOG2_NN; u.pn = L & ((1 << LOG2_NN) - 1); u.e = tile_e[u.pm]; return true; }
    __device__ __forceinline__ void a_ready(const pg8::Unit&) const {}
    __device__ __forceinline__ void done(const pg8::Unit&) const {}
};
struct EpiUp {
    static constexpr bool PERM = true, AFTER_DRAIN = false;
    bf16_t* act;
    __device__ __forceinline__ void operator()(const pg8::f32x4 (&acc)[2][2][4][2], const pg8::Unit& u, int wr, int wc, int fr, int fq) const {
        using pg8::f32x4;
        const int row0 = u.pm * 256 + wr * 64 + fr, col0 = u.pn * 128 + wc * 16 + 4 * fq;
#pragma unroll
        for (int ai = 0; ai < 2; ++ai)
#pragma unroll
            for (int m = 0; m < 4; ++m) { unsigned char* rowp = (unsigned char*)act + (size_t)(row0 + ai * 128 + m * 16) * 512 + col0;
#pragma unroll
                for (int bj = 0; bj < 2; ++bj) { const f32x4 av = acc[ai][bj][m][0] * (1.f / SC13), bv = acc[ai][bj][m][1] * (1.f / SC13); float o[4];
#pragma unroll
                    for (int e = 0; e < 4; ++e) o[e] = av[e] * __builtin_amdgcn_rcpf(1.f + __expf(-av[e])) * bv[e];
                    *(unsigned*)(rowp + bj * 64) = pk4_fp8(o[0], o[1], o[2], o[3]); } }
    }
};
__device__ __forceinline__ void ph9(const Args& a, int G) {
    const int tid = threadIdx.x, lane = tid & 63, wave = __builtin_amdgcn_readfirstlane(tid >> 6);
    unsigned char* ws = a.ws; float* out = a.out;
    const float* mod = (const float*)(ws + W::MOD); const bf16_t* y = (const bf16_t*)(ws + W::Y);
    const float* r_gate = (const float*)(ws + W::ROUTE + 128 * 1024); const int* r_slot = (const int*)(ws + W::ROUTE + 384 * 1024);
    int m = blockIdx.x * NWAVES + wave; if (m >= M_TOK) return;
    int s0 = r_slot[2 * m], s1 = r_slot[2 * m + 1]; float g0 = r_gate[2 * m], g1 = r_gate[2 * m + 1];
    for (;;) {
        const int mn = m + G * NWAVES; const bool more = mn < M_TOK; const int mq = more ? mn : m;
        const int s0n = r_slot[2 * mq], s1n = r_slot[2 * mq + 1]; const float g0n = r_gate[2 * mq], g1n = r_gate[2 * mq + 1];
        const float* g2 = mod + (m >> 13) * 12288 + 10240;
#pragma unroll
        for (int j = 0; j < 4; ++j) { const int c = j * 512 + lane * 8;
            const pg8::u32x4 ya = *(const pg8::u32x4*)(y + (size_t)s0 * 2048 + c), yb = *(const pg8::u32x4*)(y + (size_t)s1 * 2048 + c);
            const pg8::f32x4 x0 = *(const pg8::f32x4*)(out + (size_t)m * 2048 + c), x1v = *(const pg8::f32x4*)(out + (size_t)m * 2048 + c + 4);
            const pg8::f32x4 ga = *(const pg8::f32x4*)(g2 + c), gb = *(const pg8::f32x4*)(g2 + c + 4);
            pg8::f32x4 o0, o1;
#pragma unroll
            for (int e = 0; e < 2; ++e) { o0[2 * e] = x0[2 * e] + ga[2 * e] * (g0 * __uint_as_float(ya[e] << 16) + g1 * __uint_as_float(yb[e] << 16));
                o0[2 * e + 1] = x0[2 * e + 1] + ga[2 * e + 1] * (g0 * __uint_as_float(ya[e] & 0xffff0000u) + g1 * __uint_as_float(yb[e] & 0xffff0000u));
                o1[2 * e] = x1v[2 * e] + gb[2 * e] * (g0 * __uint_as_float(ya[2 + e] << 16) + g1 * __uint_as_float(yb[2 + e] << 16));
                o1[2 * e + 1] = x1v[2 * e + 1] + gb[2 * e + 1] * (g0 * __uint_as_float(ya[2 + e] & 0xffff0000u) + g1 * __uint_as_float(yb[2 + e] & 0xffff0000u)); }
            *(pg8::f32x4*)(out + (size_t)m * 2048 + c) = o0; *(pg8::f32x4*)(out + (size_t)m * 2048 + c + 4) = o1; }
        if (!more) break;
        m = mn; s0 = s0n; s1 = s1n; g0 = g0n; g1 = g1n;
    }
}

__global__ void __launch_bounds__(NWAVES * 64, 2) mk_fwd(Args args) {
    extern __shared__ __attribute__((aligned(16))) unsigned char lds_raw[];
    LAS unsigned char* lds = (LAS unsigned char*)lds_raw;
    volatile LAS unsigned* MISC = (volatile LAS unsigned*)(lds + MISC_OFF);
    const int tid = threadIdx.x, G = gridDim.x;
    unsigned char* ws = args.ws; gu32* ctl = (gu32*)(ws + W::CTL);
    for (int u = tid; u < (LDS_BYTES - MISC_OFF) / 4; u += NWAVES * 64) ((LAS unsigned*)(lds + MISC_OFF))[u] = 0u;
    __syncthreads();
    const int lo = args.ph_lo, hi = args.ph_hi;
    XcdBarrier bar; bar.bar = (unsigned*)(ctl + CW_BAR) + args.li * XCD_BAR_WORDS; bar.x = 0; bar.st = nullptr;
    if (hi - lo > 1) bar = xcd_barrier_post((unsigned*)(ctl + CW_BAR) + args.li * XCD_BAR_WORDS, MISC + 8);
#define IN(k) (lo <= (k) && (k) < hi)
#define BOTH(k) (IN(k) && IN((k) + 1))
    if (IN(0)) { ph0(args, lds, G); if (BOTH(0)) xcd_barrier(bar); }
    if (IN(1)) { ph1(args, lds, G); if (BOTH(1)) xcd_barrier(bar); }
    if (IN(2)) {
        for (int bh = blockIdx.x; bh < 16; bh += G) cumsum_bh(args, lds, bh);
        for (int b = (int)blockIdx.x - 16; b < 2; b += G) if (b >= 0) router_tables(args, lds, b);
        pg8::Gemm g{(const bf16_t*)(ws + W::XN), (const bf16_t*)(ws + W::WT_IN), M_TOK, 7168, 2048, 0};
        pg8::StaticOrder S; S.init(M_TOK, 7168, G, (int)blockIdx.x);
        EpiZ E{(bf16_t*)(ws + W::QKV), args.in[7], args.in[8], (const float*)(ws + W::ROPE), (PG8_LAS float*)(lds + XCH_OFF)};
        pg8::gemm_phase<EpiZ, pg8::StaticOrder, true, true>(lds + RING_OFF, g, S, E);
        if (BOTH(2)) xcd_barrier(bar);
    }
    if (IN(3)) { kv_units(args, (char*)lds_raw + RING_OFF, G); fox_stream(args, (char*)lds_raw + RING_OFF); if (BOTH(3)) xcd_barrier(bar); }
    if (IN(4)) { scan_units(args, lds, G); if (BOTH(4)) xcd_barrier(bar); }
    if (IN(5)) { attn_stream<1>(args, (char*)lds_raw + RING_OFF, G); if (BOTH(5)) xcd_barrier(bar); }
    if (IN(6)) {
        pg8::Gemm g{(const bf16_t*)(ws + W::MIX), (const bf16_t*)(ws + W::WT_OUT), M_TOK, 2048, 2048, 0};
        pg8::StaticOrder S; S.init(M_TOK, 2048, G, (int)blockIdx.x);
        EpiX1 E{args.in[0], (const float*)(ws + W::MOD), args.out};
        pg8::gemm_phase<EpiX1, pg8::StaticOrder, true, true>(lds + RING_OFF, g, S, E);
        if (BOTH(6)) xcd_barrier(bar);
    }
    if (IN(7)) { ph5(args, lds, G); if (BOTH(7)) xcd_barrier(bar); }
    if (IN(8)) { ph6(args, lds, G); if (BOTH(8)) xcd_barrier(bar); }
    if (IN(9)) {
        pg8::Gemm g{(const bf16_t*)(ws + W::XS), (const bf16_t*)(ws + W::WT_13), 0, 1024, 2048, (size_t)1024 * 2048};
        GroupedOrder<2> S; S.init((const int*)(ws + W::TILE) + 64, (const int*)(ws + W::TILE) + 512, G, (int)blockIdx.x);
        EpiUp E{(bf16_t*)(ws + W::ACT)};
        pg8::gemm_phase<EpiUp, GroupedOrder<2>, true, true, 1>(lds + RING_OFF, g, S, E);
        if (BOTH(9)) xcd_barrier(bar);
    }
    if (IN(10)) {
        pg8::Gemm g{(const bf16_t*)(ws + W::ACT), (const bf16_t*)(ws + W::WT_2), 0, 2048, 512, (size_t)2048 * 512};
        GroupedOrder<3> S; S.init((const int*)(ws + W::TILE) + 64, (const int*)(ws + W::TILE) + 512, G, (int)blockIdx.x);
        pg8::EpiBf16<0> E{(bf16_t*)(ws + W::Y), 2048, nullptr, 1 << 30, 0, 1.f / SC2};
        pg8::gemm_phase<pg8::EpiBf16<0>, GroupedOrder<3>, true, true, 1>(lds + RING_OFF, g, S, E);
        if (BOTH(10)) xcd_barrier(bar);
    }
    if (IN(11)) ph9(args, G);
#undef IN
#undef BOTH
}
extern "C" void kernel_launch(void* const* d_in, const int* in_sizes, int n_in, void* d_out, int out_size, void* d_ws, size_t ws_size, hipStream_t stream) {
    static int grid = 0;
    if (grid == 0) {
        if (n_in != 19 || out_size != M_TOK * DM || ws_size < W::END) { fprintf(stderr, "kernel_launch: built for 19 inputs, %d outputs, >= %zu bytes of workspace; got %d, %d, %zu\n", M_TOK * DM, (size_t)W::END, n_in, out_size, ws_size); grid = -1; return; }
        int dev = 0, cus = 0, per_cu = 0;
        if (hipGetDevice(&dev) != hipSuccess || hipDeviceGetAttribute(&cus, hipDeviceAttributeMultiprocessorCount, dev) != hipSuccess) { fprintf(stderr, "kernel_launch: device query failed\n"); grid = -1; return; }
        if (hipFuncSetAttribute((const void*)mk_fwd, hipFuncAttributeMaxDynamicSharedMemorySize, LDS_BYTES) != hipSuccess) { fprintf(stderr, "kernel_launch: hipFuncSetAttribute failed\n"); grid = -1; return; }
        if (hipOccupancyMaxActiveBlocksPerMultiprocessor(&per_cu, (const void*)mk_fwd, NWAVES * 64, LDS_BYTES) != hipSuccess || per_cu < 1) { fprintf(stderr, "kernel_launch: occupancy query says %d workgroups per CU\n", per_cu); (void)hipGetLastError(); grid = -1; return; }
        grid = cus;
    }
    if (grid < 0) return;
    (void)hipMemsetAsync((char*)d_ws + W::CTL, 0, W::CTL_ZERO_BYTES, stream);
    Args a{};
    for (int i = 0; i < 19; ++i) a.in[i] = (const float*)d_in[i];
    a.out = (float*)d_out; a.ws = (unsigned char*)d_ws; a.ph_lo = 0; a.ph_hi = 12; a.li = 0;
    hipLaunchKernelGGL(mk_fwd, dim3(grid), dim3(NWAVES * 64), LDS_BYTES, stream, a);
}
```

```cpp
#include <hip/hip_runtime.h>
#include <cstdio>
#include <cstdint>
typedef unsigned short bf16_t;
__device__ __forceinline__ float bf2f(bf16_t v) { return __uint_as_float(((unsigned)v) << 16); }
__device__ __forceinline__ unsigned f2bf(float f) { const unsigned u = __float_as_uint(f); return (u + 0x7fffu + ((u >> 16) & 1u)) >> 16; }

constexpr size_t MiB = 1u << 20;
constexpr int M_TOK = 16384, SEQ = 8192, DM = 2048;
constexpr size_t QKV_ELEMS = (size_t)16 * 8192 * 128;
namespace pg8 {
#define PG8_LAS __attribute__((address_space(3)))
typedef short bf16x8 __attribute__((ext_vector_type(8)));
typedef float f32x4 __attribute__((ext_vector_type(4)));
typedef unsigned u32x4 __attribute__((ext_vector_type(4)));
constexpr int BM = 256, BK = 64, HALF = 128, HTB = HALF * BK * 2  , STAGE_BYTES = 8 * HTB, NXCD = 8, WGM = 8;

__host__ __device__ __forceinline__ int lds_byte(int r, int c) { const int st = (r >> 4) * 2 + (c >> 5), rr = r & 15, cc = c & 31, ob = rr * 64 + cc * 2; return st * 1024 + (ob ^ (((ob >> 9) & 1) << 5)); }
__host__ __device__ __forceinline__ void stage_rc(int b, int& R, int& C) { const int st = b / 1024, sb = b % 1024, swz = sb ^ (((sb >> 9) & 1) << 5); R = (st >> 1) * 16 + swz / 64; C = (st & 1) * 32 + (swz % 64) / 2; }
__host__ __device__ __forceinline__ int perm32(int rho) { const int n = rho >> 4, i = rho & 15; return 8 * (i >> 2) + 4 * n + (i & 3); }

struct Unit { int pm, pn, e; };
struct Gemm { const bf16_t* A; const bf16_t* Bt; int M, N, K; size_t estride; };

struct StaticOrder {
    int nM, nN, nwg, G, c;
    __host__ __device__ void init(int M, int N, int G_, int c_) { nM = M / BM; nN = N / BM; nwg = nM * nN; G = G_; c = c_; }
    __host__ __device__ bool next(int i, Unit& u) const {
        const long L = (long)i * G + c; if (L >= nwg) return false;
        int wgid = (int)L; { const int q = nwg / NXCD, r = nwg % NXCD, xcd = wgid % NXCD, off = wgid / NXCD; wgid = (xcd < r ? xcd * (q + 1) : r * (q + 1) + (xcd - r) * q) + off; }
        const int nig = WGM * nN, gid = wgid / nig, fm = gid * WGM, gsz = (nM - fm) < WGM ? (nM - fm) : WGM;
        u.pm = fm + ((wgid % nig) % gsz); u.pn = (wgid % nig) / gsz; u.e = 0; return true;
    }
    __device__ __forceinline__ void a_ready(const Unit&) const {}
    __device__ __forceinline__ void done(const Unit&) const {}
};

__device__ __forceinline__ unsigned cvt_pk_bf16(float lo, float hi) { unsigned r; asm volatile("v_cvt_pk_bf16_f32 %0, %1, %2" : "=v"(r) : "v"(lo), "v"(hi)); return r; }
typedef float f32x2 __attribute__((ext_vector_type(2)));
__device__ __forceinline__ f32x2 gelu_pk(f32x2 v) {
    const f32x2 av = __builtin_elementwise_abs(v), d = av * 0.2316418882f + 1.0f;
    f32x2 t; t.x = __builtin_amdgcn_rcpf(d.x); t.y = __builtin_amdgcn_rcpf(d.y);
    f32x2 q = t * 0.5307027145f + (-0.7265760135f); q = q * t + 0.7107068705f; q = q * t + (-0.142248368f); q = q * t + 0.127414796f; q = q * t;
    const f32x2 s = (v * v) * (-0.72134752044f);
    f32x2 e; e.x = __builtin_amdgcn_exp2f(s.x); e.y = __builtin_amdgcn_exp2f(s.y);
    const f32x2 m = v * (q * e), r = v - m;
    f32x2 o; o.x = v.x < 0.f ? m.x : r.x; o.y = v.y < 0.f ? m.y : r.y; return o;
}

template <int ACT  > struct EpiBf16 {
    static constexpr bool PERM = true, AFTER_DRAIN = false; static_assert(ACT == 0 || ACT == 1, "EpiBf16: ACT is 0 (none) or 1 (gelu_pk)");
    bf16_t* O; int ldc; const float* bias; int split_cols; size_t split_stride; float scale0;
    __device__ __forceinline__ void operator()(const f32x4 (&acc)[2][2][4][2], const Unit& u, int wr, int wc, int fr, int fq) const {
        const int row0 = u.pm * BM + wr * 64 + fr; int colt = u.pn * BM; bf16_t* base = O;
        float sc = 1.f; if (split_cols) { const int t = colt / split_cols; base += (size_t)t * split_stride; colt -= t * split_cols; if (t == 0) sc = scale0; }
        const int col0 = colt + wc * 32 + 8 * fq, bcol0 = u.pn * BM + wc * 32 + 8 * fq;
        f32x4 bv[2][2];
#pragma unroll
        for (int bj = 0; bj < 2; ++bj)
#pragma unroll
            for (int n = 0; n < 2; ++n) bv[bj][n] = bias ? *(const f32x4*)(bias + bcol0 + bj * HALF + 4 * n) : (f32x4){0.f, 0.f, 0.f, 0.f};
#pragma unroll
        for (int ai = 0; ai < 2; ++ai)
#pragma unroll
            for (int m = 0; m < 4; ++m) { bf16_t* rowp = base + (size_t)(row0 + ai * HALF + m * 16) * ldc + col0;
#pragma unroll
                for (int bj = 0; bj < 2; ++bj) { f32x4 v0 = acc[ai][bj][m][0] + bv[bj][0], v1 = acc[ai][bj][m][1] + bv[bj][1];
                    if (ACT == 1) { f32x2 a = gelu_pk((f32x2){v0[0], v0[1]}), b = gelu_pk((f32x2){v0[2], v0[3]}), c = gelu_pk((f32x2){v1[0], v1[1]}), d = gelu_pk((f32x2){v1[2], v1[3]});
                        v0 = (f32x4){a.x, a.y, b.x, b.y}; v1 = (f32x4){c.x, c.y, d.x, d.y}; }
                    v0 = v0 * sc; v1 = v1 * sc; u32x4 w; w.x = cvt_pk_bf16(v0[0], v0[1]); w.y = cvt_pk_bf16(v0[2], v0[3]); w.z = cvt_pk_bf16(v1[0], v1[1]); w.w = cvt_pk_bf16(v1[2], v1[3]);
                    *(u32x4*)(rowp + bj * HALF) = w; } }
    }
};
template <class Epi, class Sched, bool ALIGN_EPI = false, bool SP2 = false, int ESZ = 2>
__device__ __forceinline__ void gemm_phase(PG8_LAS unsigned char* lds, const Gemm g, const Sched& S, const Epi& E) {
    const int tid = threadIdx.x, wid = __builtin_amdgcn_readfirstlane(tid >> 6), lane = tid & 63, wr = wid >> 2, wc = wid & 3, fr = lane & 15, fq = lane >> 4;
    int Kraw = g.K; asm volatile("" : "+s"(Kraw));
    const int K = ESZ == 1 ? Kraw / 2 : Kraw, nt = K / BK;
    unsigned voffA[2], voffB[2];
#pragma unroll
    for (int i = 0; i < 2; ++i) { int R, C; stage_rc(tid * 16 + i * 8192, R, C); const int Rb = Epi::PERM ? ((R & ~31) + perm32(R & 31)) : R;
        voffA[i] = (unsigned)(R * K + C) * 2u; voffB[i] = (unsigned)(Rb * K + C) * 2u; }
    const size_t kstep = (size_t)(BK * 2);
    const size_t hstep = (size_t)HALF * K * 2;
    const size_t tstep = 2 * hstep;
    const unsigned ldsw = (unsigned)wid * 1024u;
    const int aoff = lds_byte(wr * 64 + fr, fq * 8), boff = lds_byte(wc * 32 + fr, fq * 8);
#define PG8_SA(b, h) (((b) * 2 + (h)) * HTB)
#define PG8_SB(b, h) ((4 + (b) * 2 + (h)) * HTB)
#define PG8_STAGE(bufoff, gbase, voff) do { _Pragma("unroll") for (int _i = 0; _i < 2; ++_i) \
        __builtin_amdgcn_global_load_lds((const unsigned*)((const char*)(gbase) + (voff)[_i]), (PG8_LAS unsigned*)(lds + (bufoff) + ldsw + _i * 8192), 16, 0, 0); } while (0)
#define PG8_LDA(dst, b, h) do { _Pragma("unroll") for (int m = 0; m < 4; ++m) { if constexpr (ESZ == 1) dst##8[m] = __builtin_shufflevector(*(const PG8_LAS i32x4_*)(lds + PG8_SA(b, h) + aoff + m * 2048), *(const PG8_LAS i32x4_*)(lds + PG8_SA(b, h) + aoff + m * 2048 + 1024), 0, 1, 2, 3, 4, 5, 6, 7); \
        else { _Pragma("unroll") for (int k = 0; k < 2; ++k) dst[m][k] = *(const PG8_LAS bf16x8*)(lds + PG8_SA(b, h) + aoff + m * 2048 + k * 1024); } } } while (0)
#define PG8_LDB(dst, b, h) do { _Pragma("unroll") for (int n = 0; n < 2; ++n) { if constexpr (ESZ == 1) dst##8[n] = __builtin_shufflevector(*(const PG8_LAS i32x4_*)(lds + PG8_SB(b, h) + boff + n * 2048), *(const PG8_LAS i32x4_*)(lds + PG8_SB(b, h) + boff + n * 2048 + 1024), 0, 1, 2, 3, 4, 5, 6, 7); \
        else { _Pragma("unroll") for (int k = 0; k < 2; ++k) dst[n][k] = *(const PG8_LAS bf16x8*)(lds + PG8_SB(b, h) + boff + n * 2048 + k * 1024); } } } while (0)
#define PG8_MMA(ai, bj, At, Bt) do { __builtin_amdgcn_s_setprio(1); _Pragma("unroll") for (int m = 0; m < 4; ++m) _Pragma("unroll") for (int n = 0; n < 2; ++n) { \
        if constexpr (ESZ == 1) asm volatile("v_mfma_scale_f32_16x16x128_f8f6f4 %0, %1, %2, %0, %3, %3 op_sel_hi:[0,0,0]" : "+v"(acc[ai][bj][m][n]) : "v"(Bt##8[n]), "v"(At##8[m]), "v"(0x7F7F7F7F)); \
        else { _Pragma("unroll") for (int k = 0; k < 2; ++k) acc[ai][bj][m][n] = __builtin_amdgcn_mfma_f32_16x16x32_bf16(Bt[n][k], At[m][k], acc[ai][bj][m][n], 0, 0, 0); } } __builtin_amdgcn_s_setprio(0); } while (0)
#define PG8_WAIT_V(n) asm volatile("s_waitcnt vmcnt(" #n ")" ::: "memory")
#define PG8_WAIT_L(n) asm volatile("s_waitcnt lgkmcnt(" #n ")" ::: "memory")
#define PG8_BAR __builtin_amdgcn_s_barrier()
#define PG8_SCHED __builtin_amdgcn_sched_barrier(0)
    Unit cur, nxt; int ui = 0;
    if (!S.next(0, cur)) return;
    f32x4 acc[2][2][4][2];
#pragma unroll
    for (int a = 0; a < 2; ++a)
#pragma unroll
        for (int b = 0; b < 2; ++b)
#pragma unroll
            for (int m = 0; m < 4; ++m)
#pragma unroll
                for (int n = 0; n < 2; ++n) acc[a][b][m][n] = (f32x4){0.f, 0.f, 0.f, 0.f};
    typedef int i32x4_ __attribute__((ext_vector_type(4))); typedef int i32x8_ __attribute__((ext_vector_type(8)));
    bf16x8 At[4][2], B0[2][2], B1[2][2]; i32x8_ At8[4], B08[2], B18[2];
    const char* cA = (const char*)g.A + (size_t)cur.pm * tstep; const char* cB = (const char*)g.Bt + (size_t)cur.pn * tstep + (size_t)cur.e * g.estride;
    S.a_ready(cur);
    if constexpr (SP2) {
        PG8_STAGE(PG8_SB(0, 0), cB, voffB); PG8_STAGE(PG8_SB(0, 1), cB + hstep, voffB); PG8_STAGE(PG8_SA(0, 0), cA, voffA); PG8_STAGE(PG8_SA(0, 1), cA + hstep, voffA);
        if (wr == 1) PG8_BAR;
        PG8_WAIT_V(2); PG8_BAR;
        PG8_STAGE(PG8_SB(1, 0), cB + kstep, voffB); PG8_STAGE(PG8_SA(1, 0), cA + kstep, voffA); PG8_STAGE(PG8_SB(1, 1), cB + hstep + kstep, voffB);
        PG8_WAIT_V(6); PG8_BAR;
    } else {
        PG8_STAGE(PG8_SB(0, 0), cB, voffB); PG8_STAGE(PG8_SA(0, 0), cA, voffA); PG8_STAGE(PG8_SB(0, 1), cB + hstep, voffB); PG8_STAGE(PG8_SA(0, 1), cA + hstep, voffA);
        if (wr == 1) PG8_BAR;
        PG8_WAIT_V(4); PG8_BAR;
        PG8_STAGE(PG8_SB(1, 0), cB + kstep, voffB); PG8_STAGE(PG8_SA(1, 0), cA + kstep, voffA); PG8_STAGE(PG8_SB(1, 1), cB + hstep + kstep, voffB);
        PG8_WAIT_V(6); PG8_BAR;
    }
    for (;;) {
        const bool has_next = S.next(ui + 1, nxt);
        const char* nA = has_next ? (const char*)g.A + (size_t)nxt.pm * tstep : cA; const char* nB = has_next ? (const char*)g.Bt + (size_t)nxt.pn * tstep + (size_t)nxt.e * g.estride : cB;
        for (int t = 0; t < nt; t += 2) {
            const bool last = (t == nt - 2);
            const char* a1 = cA + (size_t)(t + 1) * kstep;
            const char* a2 = last ? nA : cA + (size_t)(t + 2) * kstep; const char* b2 = last ? nB : cB + (size_t)(t + 2) * kstep;
            const char* a3 = a2 + kstep; const char* b3 = b2 + kstep;
            if (last && has_next) S.a_ready(nxt);
            if constexpr (SP2) {
            PG8_LDB(B0, 0, 0); PG8_LDB(B1, 0, 1); PG8_SCHED; PG8_LDA(At, 0, 0); PG8_STAGE(PG8_SA(1, 1), a1 + hstep, voffA);
            PG8_WAIT_V(8); PG8_WAIT_L(0); PG8_BAR; PG8_MMA(0, 0, At, B0); PG8_MMA(0, 1, At, B1); PG8_BAR; PG8_SCHED;
            PG8_LDA(At, 0, 1); PG8_STAGE(PG8_SB(0, 0), b2, voffB); PG8_STAGE(PG8_SB(0, 1), b2 + hstep, voffB); PG8_STAGE(PG8_SA(0, 0), a2, voffA);
            PG8_WAIT_V(8); PG8_WAIT_L(0); PG8_BAR; PG8_MMA(1, 0, At, B0); PG8_MMA(1, 1, At, B1); PG8_BAR; PG8_SCHED;
            PG8_LDB(B0, 1, 0); PG8_LDB(B1, 1, 1); PG8_SCHED; PG8_LDA(At, 1, 0); PG8_STAGE(PG8_SA(0, 1), a2 + hstep, voffA);
            PG8_WAIT_V(8); PG8_WAIT_L(0); PG8_BAR; PG8_MMA(0, 0, At, B0); PG8_MMA(0, 1, At, B1); PG8_BAR; PG8_SCHED;
            PG8_LDA(At, 1, 1); PG8_STAGE(PG8_SB(1, 0), b3, voffB); PG8_STAGE(PG8_SB(1, 1), b3 + hstep, voffB); PG8_STAGE(PG8_SA(1, 0), a3, voffA);
            PG8_WAIT_V(8); PG8_WAIT_L(0); PG8_BAR; PG8_MMA(1, 0, At, B0); PG8_MMA(1, 1, At, B1); PG8_BAR; PG8_SCHED;
            } else {
            PG8_LDB(B0, 0, 0); PG8_SCHED; PG8_LDA(At, 0, 0); PG8_STAGE(PG8_SA(1, 1), a1 + hstep, voffA);
            PG8_WAIT_L(8); PG8_BAR; PG8_WAIT_L(0); PG8_MMA(0, 0, At, B0); PG8_BAR; PG8_SCHED;
            PG8_LDB(B1, 0, 1); PG8_STAGE(PG8_SB(0, 0), b2, voffB);
            PG8_BAR; PG8_WAIT_L(0); PG8_MMA(0, 1, At, B1); PG8_BAR;
            PG8_LDA(At, 0, 1); PG8_STAGE(PG8_SA(0, 0), a2, voffA);
            PG8_BAR; PG8_WAIT_L(0); PG8_MMA(1, 0, At, B0); PG8_BAR; PG8_SCHED;
            PG8_STAGE(PG8_SB(0, 1), b2 + hstep, voffB);
            PG8_WAIT_V(6); PG8_BAR; PG8_MMA(1, 1, At, B1); PG8_BAR;
            PG8_LDB(B0, 1, 0); PG8_SCHED; PG8_LDA(At, 1, 0); PG8_STAGE(PG8_SA(0, 1), a2 + hstep, voffA);
            PG8_WAIT_L(8); PG8_BAR; PG8_WAIT_L(0); PG8_MMA(0, 0, At, B0); PG8_BAR; PG8_SCHED;
            PG8_LDB(B1, 1, 1); PG8_STAGE(PG8_SB(1, 0), b3, voffB);
            PG8_BAR; PG8_WAIT_L(0); PG8_MMA(0, 1, At, B1); PG8_BAR;
            PG8_LDA(At, 1, 1); PG8_STAGE(PG8_SA(1, 0), a3, voffA);
            PG8_BAR; PG8_WAIT_L(0); PG8_MMA(1, 0, At, B0); PG8_BAR; PG8_SCHED;
            PG8_STAGE(PG8_SB(1, 1), b3 + hstep, voffB);
            PG8_WAIT_V(6); PG8_BAR; PG8_MMA(1, 1, At, B1); PG8_BAR;
            }
        }
        if constexpr (ALIGN_EPI) { if (wr == 0) PG8_BAR; }
        if constexpr (ESZ == 1) asm volatile("s_nop 15\n\ts_nop 15" ::: "memory");
        if constexpr (!Epi::AFTER_DRAIN) { int t2_ = threadIdx.x; asm volatile("" : "+v"(t2_)); E(acc, cur, wr, wc, t2_ & 15, (t2_ >> 4) & 3); S.done(cur); }
        if (!has_next) break;
#pragma unroll
        for (int a = 0; a < 2; ++a)
#pragma unroll
            for (int b = 0; b < 2; ++b)
#pragma unroll
                for (int m = 0; m < 4; ++m)
#pragma unroll
                    for (int n = 0; n < 2; ++n) acc[a][b][m][n] = (f32x4){0.f, 0.f, 0.f, 0.f};
        cur = nxt; cA = nA; cB = nB; ++ui;
        if constexpr (ALIGN_EPI) { if (wr == 1) PG8_BAR; }
    }
    PG8_WAIT_V(0);
    if constexpr (!ALIGN_EPI) { if (wr == 0) PG8_BAR; }
    PG8_BAR;
    if constexpr (Epi::AFTER_DRAIN) { E.fused(acc, cur, wr, wc, fr, fq, lds, wid, lane); S.done(cur); }
#undef PG8_SA
#undef PG8_SB
#undef PG8_STAGE
#undef PG8_LDA
#undef PG8_LDB
#undef PG8_MMA
#undef PG8_WAIT_V
#undef PG8_WAIT_L
#undef PG8_BAR
#undef PG8_SCHED
}
}
#define GAS __attribute__((address_space(1)))
#define LAS __attribute__((address_space(3)))
typedef GAS unsigned gu32;
typedef GAS unsigned long long gu64;
#define RLX_AGENT __ATOMIC_RELAXED, __HIP_MEMORY_SCOPE_AGENT
#define LDS_WAIT() asm volatile("s_waitcnt lgkmcnt(0)" ::: "memory")
#define VM_WAIT() asm volatile("s_waitcnt vmcnt(0)" ::: "memory")
#define XB_TMO      128
#define XB_XCNT(j)  (256  + 64 * (j))
#define XB_XSUB(j)  (1280 + 64 * (j))
#define XB_XGEN(j)  (2304 + 64 * (j))
#define XB_TOP      3328
#define XB_TOPGEN   3392
#define XCD_BAR_WORDS 3456
#define XB_SPIN_CAP (1u << 18)

__device__ __forceinline__ unsigned xb_ld(unsigned* p)              { return __hip_atomic_load(p, __ATOMIC_RELAXED, __HIP_MEMORY_SCOPE_AGENT); }
__device__ __forceinline__ unsigned xb_add(unsigned* p, unsigned v) { return __hip_atomic_fetch_add(p, v, __ATOMIC_RELAXED, __HIP_MEMORY_SCOPE_AGENT); }
__device__ __forceinline__ unsigned xb_xcc_id() { return (unsigned)__builtin_amdgcn_s_getreg((3 << 11) | 20) & 0xFu; }
#define XB_SPIN(cond, bar) do { unsigned _sp = 0; while (cond) { __builtin_amdgcn_s_sleep(1); \
    if ((++_sp & 255u) == 0u) { if (xb_ld(&(bar)[XB_TMO])) break; if (_sp > XB_SPIN_CAP) { atomicAdd(&(bar)[XB_TMO], 1u); break; } } } } while (0)

struct XcdBarrier {
    unsigned* bar; unsigned x;
    volatile LAS unsigned* st;
};

__device__ __forceinline__ XcdBarrier xcd_barrier_post(unsigned* bar, volatile LAS unsigned* st) {
    XcdBarrier b; b.bar = bar; b.x = xb_xcc_id(); b.st = st;
    if (threadIdx.x == 0) (void)xb_add(&bar[XB_XCNT(b.x)], 1u);
    return b;
}
__device__ __forceinline__ void xcd_barrier_complete(unsigned* bar, unsigned x, unsigned& nloc, unsigned& nx) {
    const unsigned G = gridDim.x * gridDim.y * gridDim.z;
    unsigned sum, cnt, mine, sp = 0u;
    for (;;) {
        sum = 0u; cnt = 0u; mine = 0u;
#pragma unroll
        for (unsigned j = 0; j < 16; ++j) { const unsigned c = xb_ld(&bar[XB_XCNT(j)]); sum += c; cnt += (c > 0u) ? 1u : 0u; mine = (j == x) ? c : mine; }
        if (sum == G) break;
        __builtin_amdgcn_s_sleep(1);
        if ((++sp & 255u) == 0u) { if (xb_ld(&bar[XB_TMO])) break; if (sp > XB_SPIN_CAP) { atomicAdd(&bar[XB_TMO], 1u); break; } }
    }
    nloc = mine > 0u ? mine : 1u; nx = cnt > 0u ? cnt : 1u;
}

__device__ __forceinline__ void xcd_barrier(const XcdBarrier& b) {
    asm volatile("s_waitcnt vmcnt(0)" ::: "memory");
    __syncthreads();
    if (threadIdx.x == 0) {
        unsigned* bar = b.bar;
        __builtin_amdgcn_s_waitcnt(0);
        unsigned nloc = b.st[0], nx = b.st[1];
        if (nloc == 0u) { xcd_barrier_complete(bar, b.x, nloc, nx); b.st[0] = nloc; b.st[1] = nx; }
        const unsigned old = xb_add(&bar[XB_XSUB(b.x)], 1u);
        const unsigned gen = old / nloc;
        if (old + 1u == (gen + 1u) * nloc) {
            __builtin_amdgcn_fence(__ATOMIC_RELEASE, "agent");
            asm volatile("s_waitcnt vmcnt(0)" ::: "memory");
            const unsigned og = xb_add(&bar[XB_TOP], 1u);
            const unsigned tg = og / nx;
            if (og + 1u == (tg + 1u) * nx) xb_add(&bar[XB_TOPGEN], 1u);
            else XB_SPIN(xb_ld(&bar[XB_TOPGEN]) == tg, bar);
            __builtin_amdgcn_fence(__ATOMIC_ACQUIRE, "agent");
            xb_add(&bar[XB_XGEN(b.x)], 1u);
            asm volatile("s_waitcnt vmcnt(0)" ::: "memory");
        } else {
            XB_SPIN(xb_ld(&bar[XB_XGEN(b.x)]) == gen, bar);
            __builtin_amdgcn_fence(__ATOMIC_ACQUIRE, "agent");
            asm volatile("s_waitcnt vmcnt(0)" ::: "memory");
        }
    }
    __syncthreads();
}
namespace at {
constexpr int D = 128; constexpr float THR = 8.f; constexpr bool WSKIP = false; constexpr int WBIG = 1 << 30;
constexpr float SCALE = 0.08838834764831845f;
constexpr int NW = 8, QBLK = 32, KVBLK = 64, QB = NW * QBLK;
constexpr int SHM_V = KVBLK * D * 2, SHM_K = KVBLK * D * 2;
constexpr int LDS_BODY = 2 * SHM_V + 2 * SHM_K + NW * 64 * 4;
constexpr int LDS_BIAS = LDS_BODY, LDS_BYTES = LDS_BODY + 8192 * 4;
using bf16 = unsigned short;
typedef short bf16x8 __attribute__((ext_vector_type(8)));
typedef short s16x4 __attribute__((ext_vector_type(4)));
typedef float f32x16 __attribute__((ext_vector_type(16)));
typedef float f32x4 __attribute__((ext_vector_type(4)));
typedef unsigned u32x4 __attribute__((ext_vector_type(4)));
template <class A, class Bt> struct same_t { static constexpr bool v = false; };
template <class A> struct same_t<A, A> { static constexpr bool v = true; };

#define KSWZ(row, colB) ((row) * 256 + ((colB) ^ (((row) & 7) << 4)))
#define SBAR() __builtin_amdgcn_sched_barrier(0)
__device__ __forceinline__ int v_st(int k, int c) { const int kk = (k & ~0xC) | ((k & 4) << 1) | ((k & 8) >> 1); return ((kk >> 3) * 4 + (c >> 5)) * 512 + ((kk & 7) * 32 + (c & 31)) * 2; }
__device__ __forceinline__ int v_rd_base(int lane) { return ((lane & 3) << 3) | (((lane >> 2) & 3) << 6) | (((lane >> 4) & 1) << 5) | (((lane >> 5) & 1) << 8); }
constexpr int v_rd_off(int d0, int ks, int half) { return d0 * 512 + ks * 4096 + half * 2048; }
__device__ __forceinline__ int crow(int r, int hi) { return (r & 3) + 8 * (r >> 2) + 4 * hi; }
__device__ __forceinline__ unsigned cvtpk(float lo, float hi) {
    unsigned r; asm volatile("v_cvt_pk_bf16_f32 %0, %1, %2" : "=v"(r) : "v"(lo), "v"(hi)); return r;
}
__device__ __forceinline__ bf16x8 pack8(f32x4 a, f32x4 b) {
    u32x4 w = {cvtpk(a[0], a[1]), cvtpk(a[2], a[3]), cvtpk(b[0], b[1]), cvtpk(b[2], b[3])};
    return *reinterpret_cast<bf16x8*>(&w);
}
template <class T> __device__ __forceinline__ bf16x8 load8(const T* p) {
    if constexpr (same_t<T, float>::v) { return pack8(*(const f32x4*)p, *(const f32x4*)(p + 4)); }
    else { return *reinterpret_cast<const bf16x8*>(p); }
}
template <int MODE> __device__ __forceinline__ void mask_tile(f32x16& p0, f32x16& p1, int dq, unsigned W) {
    const float NEG = MODE ? 0.f : -__builtin_inff();
#pragma unroll
    for (int r = 0; r < 16; ++r) {
        const int c = (r & 3) + 8 * (r >> 2);
        if ((unsigned)(dq - c) >= W) p0[r] = NEG;
        if ((unsigned)(dq - c - 32) >= W) p1[r] = NEG;
    }
}
__device__ __forceinline__ void partialRet(f32x16& p0, float rowfac) { for (int r = 0; r < 16; ++r) p0[r] *= rowfac; }
__device__ __forceinline__ void partialSM(f32x16& p0, f32x16& p1, float& m_reg, float& mn, float& alpha) {
    float pmax = p0[0]; for (int r = 1; r < 16; ++r) pmax = fmaxf(pmax, p0[r]); for (int r = 0; r < 16; ++r) pmax = fmaxf(pmax, p1[r]);
    { auto rr = __builtin_amdgcn_permlane32_swap(__float_as_uint(pmax), __float_as_uint(pmax), false, false);
      pmax = fmaxf(__uint_as_float(rr[0]), __uint_as_float(rr[1])); }
    constexpr float C2 = 1.4426950408889634f * SCALE;
    if (__builtin_expect(__all((pmax - m_reg) * SCALE <= THR), 1)) { mn = m_reg; alpha = 1.f; }
    else { mn = fmaxf(m_reg, pmax); alpha = __builtin_amdgcn_exp2f((m_reg - mn) * C2); m_reg = mn; }
    const float mnL = -mn * C2;
    for (int r = 0; r < 16; ++r) p0[r] = fmaf(p0[r], C2, mnL); for (int r = 0; r < 16; ++r) p1[r] = fmaf(p1[r], C2, mnL);
    for (int r = 0; r < 16; ++r) p0[r] = __builtin_amdgcn_exp2f(p0[r]);
}
template <int MODE> __device__ __forceinline__ void finishSM(f32x16& p0, f32x16& p1, float alpha, float& l_reg, bf16x8& pa0, bf16x8& pa1, bf16x8& pa2, bf16x8& pa3) {
    if constexpr (MODE == 0) {
    for (int r = 0; r < 16; ++r) p1[r] = __builtin_amdgcn_exp2f(p1[r]);
    float ps = 0; for (int r = 0; r < 16; ++r) ps += p0[r]; for (int r = 0; r < 16; ++r) ps += p1[r];
    { auto rr = __builtin_amdgcn_permlane32_swap(__float_as_uint(ps), __float_as_uint(ps), false, false);
      ps = __uint_as_float(rr[0]) + __uint_as_float(rr[1]); }
    l_reg = l_reg * alpha + ps;
    } else { for (int r = 0; r < 16; ++r) p1[r] *= alpha; }
#define PK4(P, B_, OUT) do { unsigned a0 = cvtpk(P[B_+0], P[B_+1]), a1 = cvtpk(P[B_+2], P[B_+3]);                          \
        unsigned b0 = cvtpk(P[B_+4], P[B_+5]), b1 = cvtpk(P[B_+6], P[B_+7]);                                             \
        auto r0 = __builtin_amdgcn_permlane32_swap(a0, b0, false, false); auto r1 = __builtin_amdgcn_permlane32_swap(a1, b1, false, false); \
        u32x4 w = {r0[0], r1[0], r0[1], r1[1]}; OUT = *reinterpret_cast<bf16x8*>(&w); } while (0)
    PK4(p0, 0, pa0); PK4(p0, 8, pa1); PK4(p1, 0, pa2); PK4(p1, 8, pa3);
#undef PK4
}
template <int KB, bool SK, int MODE>
__device__ __forceinline__ void qkt(f32x16& p0, f32x16& p1, const char* K_lds, int r32, int hi, const bf16x8* qr, bool act, const float* bt) {
    if (SK && !act) { const float NEG = -__builtin_inff();
#pragma unroll
        for (int r = 0; r < 16; ++r) { p0[r] = NEG; p1[r] = NEG; } return; }
    if constexpr (MODE == 0) {
        const f32x4 b0 = *(const f32x4*)(bt), b1 = *(const f32x4*)(bt + 8), b2 = *(const f32x4*)(bt + 16), b3 = *(const f32x4*)(bt + 24);
        const f32x4 c0 = *(const f32x4*)(bt + 32), c1 = *(const f32x4*)(bt + 40), c2 = *(const f32x4*)(bt + 48), c3 = *(const f32x4*)(bt + 56);
        p0 = f32x16{b0[0], b0[1], b0[2], b0[3], b1[0], b1[1], b1[2], b1[3], b2[0], b2[1], b2[2], b2[3], b3[0], b3[1], b3[2], b3[3]};
        p1 = f32x16{c0[0], c0[1], c0[2], c0[3], c1[0], c1[1], c1[2], c1[3], c2[0], c2[1], c2[2], c2[3], c3[0], c3[1], c3[2], c3[3]};
    } else { p0 = f32x16{}; p1 = f32x16{}; }
    const char* kb[4];
#pragma unroll
    for (int dd = 0; dd < 4; ++dd) kb[dd] = K_lds + KB * SHM_K + KSWZ(r32, (dd * 16 + hi * 8) * 2);
#pragma unroll
    for (int d0 = 0; d0 < 8; ++d0) { const char* a = kb[d0 & 3] + (d0 >> 2) * 128;
        bf16x8 b0 = *reinterpret_cast<const bf16x8*>(a);
        bf16x8 b1 = *reinterpret_cast<const bf16x8*>(a + 32 * 256);
        p0 = __builtin_amdgcn_mfma_f32_32x32x16_bf16(b0, qr[d0], p0, 0, 0, 0);
        p1 = __builtin_amdgcn_mfma_f32_32x32x16_bf16(b1, qr[d0], p1, 0, 0, 0); }
}
template <int VB, bool SK>
__device__ __forceinline__ void pv_tile(f32x16* o, int vb0, bf16x8 pa0, bf16x8 pa1, bf16x8 pa2, bf16x8 pa3, bool act) {
    if (SK && !act) return;
#define TRRD(dst, off) asm volatile("ds_read_b64_tr_b16 %0, %1 offset:%2" : "=&v"(dst) : "v"(vb0), "i"(off) : "memory")
#define PV_D0(d0) do { s16x4 l0, l1, l2, l3, h0, h1, h2, h3; constexpr int b_ = VB * SHM_V + v_rd_off(d0, 0, 0);     \
        TRRD(l0, b_); TRRD(h0, b_ + 2048); TRRD(l1, b_ + 4096); TRRD(h1, b_ + 6144); TRRD(l2, b_ + 8192); TRRD(h2, b_ + 10240); TRRD(l3, b_ + 12288); TRRD(h3, b_ + 14336); \
        asm volatile("s_waitcnt lgkmcnt(0)" ::: "memory"); SBAR();                 \
        o[d0] = __builtin_amdgcn_mfma_f32_32x32x16_bf16(pa0, (bf16x8){l0[0], l0[1], l0[2], l0[3], h0[0], h0[1], h0[2], h0[3]}, o[d0], 0, 0, 0);   \
        o[d0] = __builtin_amdgcn_mfma_f32_32x32x16_bf16(pa1, (bf16x8){l1[0], l1[1], l1[2], l1[3], h1[0], h1[1], h1[2], h1[3]}, o[d0], 0, 0, 0);   \
        o[d0] = __builtin_amdgcn_mfma_f32_32x32x16_bf16(pa2, (bf16x8){l2[0], l2[1], l2[2], l2[3], h2[0], h2[1], h2[2], h2[3]}, o[d0], 0, 0, 0);   \
        o[d0] = __builtin_amdgcn_mfma_f32_32x32x16_bf16(pa3, (bf16x8){l3[0], l3[1], l3[2], l3[3], h3[0], h3[1], h3[2], h3[3]}, o[d0], 0, 0, 0); } while (0)
    PV_D0(0); PV_D0(1); PV_D0(2); PV_D0(3);
#undef PV_D0
#undef TRRD
}

template <class TIn, class TOut> struct BlockRef { const TIn* Q; const TIn* K; const TIn* V; TOut* O; int P0; int jlo; int bh; };
template <class TIn> struct NextRef { const TIn* Q; const TIn* K; const TIn* V; int jlo; };
template <class TIn> struct Extra { const float* bias; const TIn* G; const float* nw; const TIn* S; };
constexpr int LDO = 2048;
template <class TIn> struct Seam {
    bf16x8 qr[8];
    bf16x8 st_v0, st_v1, st_k0, st_k1; f32x4 sf0, sf1, sf2, sf3;
    f32x4 tq[16];
};
#define ROW(p, k0, rr) ((p) + (unsigned)(((k0) + (rr)) * D + sc))
#define VMW() asm volatile("s_waitcnt vmcnt(0)" ::: "memory")
#define VMWN(n) asm volatile("s_waitcnt vmcnt(%0)" :: "i"(n) : "memory")
#define SLOAD_H(Kp, Vp, k0) do { S.st_v0 = load8<TIn>(ROW(Vp, k0, sr)); S.st_v1 = load8<TIn>(ROW(Vp, k0, 32 + sr));              \
                         S.st_k0 = load8<TIn>(ROW(Kp, k0, sr)); S.st_k1 = load8<TIn>(ROW(Kp, k0, 32 + sr)); } while (0)
#define SWRITE_HK(bf) do { *(bf16x8*)(K_lds + (bf) * SHM_K + kws) = S.st_k0; *(bf16x8*)(K_lds + (bf) * SHM_K + kws + 32 * 256) = S.st_k1; } while (0)
#define SWRITE_HV(bf) do { *(bf16x8*)(V_lds + (bf) * SHM_V + vst0) = S.st_v0; *(bf16x8*)(V_lds + (bf) * SHM_V + vst1) = S.st_v1; } while (0)
#define SWRITE_H(bf) do { SWRITE_HV(bf); SWRITE_HK(bf); } while (0)
#define SLOAD_F(p, k0) do { S.sf0 = *(const f32x4*)ROW(p, k0, sr); S.sf1 = *(const f32x4*)(ROW(p, k0, sr) + 4);                \
                            S.sf2 = *(const f32x4*)ROW(p, k0, 32 + sr); S.sf3 = *(const f32x4*)(ROW(p, k0, 32 + sr) + 4); } while (0)
#define SWRITE_KF(bf) do { *(bf16x8*)(K_lds + (bf) * SHM_K + kws) = pack8(S.sf0, S.sf1); *(bf16x8*)(K_lds + (bf) * SHM_K + kws + 32 * 256) = pack8(S.sf2, S.sf3); } while (0)
#define SWRITE_VF(bf) do { *(bf16x8*)(V_lds + (bf) * SHM_V + vst0) = pack8(S.sf0, S.sf1); *(bf16x8*)(V_lds + (bf) * SHM_V + vst1) = pack8(S.sf2, S.sf3); } while (0)
template <class TIn, class TOut>
__device__ __forceinline__ void causal_swa_prime(const BlockRef<TIn, TOut>& cur, int W, char* lds, Seam<TIn>& S) {
    constexpr bool F32 = same_t<TIn, float>::v;
    const int tid = threadIdx.x, wid = __builtin_amdgcn_readfirstlane(tid >> 6), lane = tid & 63, r32 = lane & 31, hi = lane >> 5;
    const int sr = tid >> 4, sc = (tid & 15) * 8, kws = KSWZ(sr, sc * 2); char* K_lds = lds + 2 * SHM_V;
    const int kb0 = cur.jlo * KVBLK;
    for (int d0 = 0; d0 < 8; ++d0) S.qr[d0] = load8<TIn>(cur.Q + (unsigned)((wid * QBLK + r32) * D + d0 * 16 + hi * 8));
    if constexpr (F32) { SLOAD_F((const float*)cur.K, kb0); VMW(); SWRITE_KF(0); SBAR(); SLOAD_F((const float*)cur.V, kb0); }
    else { SLOAD_H(cur.K, cur.V, kb0); VMW(); SWRITE_HK(0); }
    __syncthreads();
}
template <int MODE, class TIn, class TOut>
__device__ __forceinline__ void causal_swa_block(const BlockRef<TIn, TOut>& cur, const NextRef<TIn>& nxt, const Extra<TIn>& X, int skv, int W, char* lds, Seam<TIn>& S) {
    constexpr bool F32 = same_t<TIn, float>::v;
    int tid_ = threadIdx.x; asm volatile("" : "+v"(tid_));
    const int tid = tid_, wid = __builtin_amdgcn_readfirstlane(tid >> 6), lane = tid & 63, r32 = lane & 31, hi = lane >> 5;
    const int j_lo = cur.jlo;
    int j_hi = (cur.P0 + QB - 1) / KVBLK + 1; if (j_hi > skv / KVBLK) j_hi = skv / KVBLK;
    const int NT = j_hi - j_lo;
    const int kbn = nxt.jlo * KVBLK;
    const int qlo = cur.P0 + wid * QBLK, qm = qlo + r32 - 4 * hi;
    char* V_lds = lds; char* K_lds = lds + 2 * SHM_V;
    float* ws = (float*)(lds + 2 * SHM_V + 2 * SHM_K) + wid * 64; float* li_l = ws, * al_l = ws + 32;
    float m_reg = -1e30f, l_reg = 0; f32x16 o[4] = {};
    const int sr = tid >> 4, sc = (tid & 15) * 8, vst0 = v_st(sr, sc), vst1 = v_st(32 + sr, sc), kws = KSWZ(sr, sc * 2);
    const int vb0 = (int)(uintptr_t)V_lds + v_rd_base(lane);
    const TIn* Kh = cur.K; const TIn* Vh = cur.V;
    const float* bl = (const float*)(lds + LDS_BIAS) + 4 * hi;
    if constexpr (MODE == 0) { for (int i = tid; i < NT * 16; i += 64 * NW) *(f32x4*)(lds + LDS_BIAS + i * 16) = *(const f32x4*)(X.bias + (size_t)cur.bh * 8192 + j_lo * KVBLK + i * 4); __syncthreads(); }
    const float l2g = MODE ? log2f(1.f - exp2f(-5.f - (float)(cur.bh & 7))) : 0.f;
    if constexpr (MODE == 1) {
        const TIn* Sg = X.S + ((size_t)(cur.bh * 32 + (cur.P0 >> 8))) * 16384 + (unsigned)(r32 * D + hi * 8);
        const float fq = __builtin_amdgcn_exp2f(l2g * (float)(wid * QBLK + r32 + 1));
#pragma unroll
        for (int d0 = 0; d0 < 8; ++d0) { const u32x4 qw = *reinterpret_cast<const u32x4*>(&S.qr[d0]); u32x4 sw;
#pragma unroll
            for (int i = 0; i < 4; ++i) sw[i] = cvtpk(__uint_as_float(qw[i] << 16) * fq, __uint_as_float(qw[i] & 0xffff0000u) * fq);
            const bf16x8 qs = *reinterpret_cast<const bf16x8*>(&sw);
#pragma unroll
            for (int eb = 0; eb < 4; ++eb) { const bf16x8 sb = *reinterpret_cast<const bf16x8*>(Sg + eb * 32 * D + d0 * 16); o[eb] = __builtin_amdgcn_mfma_f32_32x32x16_bf16(qs, sb, o[eb], 0, 0, 0); }
            if (d0 & 1) asm volatile("" ::: "memory"); }
    }
#define BT(t) (bl + (t) * KVBLK)
#define PSM(P0_, P1_, mnX, alX, t) do { if constexpr (MODE == 0) partialSM(P0_, P1_, m_reg, mnX, alX); else { alX = __builtin_amdgcn_exp2f(l2g * (float)(qlo + r32 - KBASE(t))); partialRet(P0_, alX); } } while (0)
#define RESC(a) do { if (MODE == 0 && __any((a) < 1.f)) { if (hi == 0) al_l[r32] = (a); asm volatile("s_waitcnt lgkmcnt(0)" ::: "memory");              \
                     for (int d_ = 0; d_ < 4; ++d_) for (int r = 0; r < 16; ++r) o[d_][r] *= al_l[crow(r, hi)]; } } while (0)
#define KBASE(t) ((j_lo + (t)) * KVBLK)
#define ACT(t) (KBASE(t) <= qlo + QBLK - 1 && KBASE(t) + KVBLK - 1 >= qlo - W + 1)
#define MASKT(P0_, P1_, t) do { const int kb_ = KBASE(t); if ((!SK || ACT(t)) && (kb_ + KVBLK - 1 > qlo || kb_ <= qlo + QBLK - 1 - W)) mask_tile<MODE>(P0_, P1_, qm - kb_, (unsigned)W); } while (0)
    constexpr int NQL = F32 ? 16 : 8;
    constexpr bool SK = WSKIP && !F32;
#define SEAM_K0() do { VMWN(NQL); if constexpr (F32) { SWRITE_KF(0); SBAR(); SLOAD_F((const float*)nxt.V, kbn); } else { SWRITE_HK(0); } SBAR(); } while (0)
    f32x16 pA0, pA1, pB0, pB1; float mnA, mnB, alA, alB; bf16x8 pa0, pa1, pa2, pa3;
    if constexpr (F32) { VMW(); SWRITE_VF(0); SBAR(); } else { SWRITE_HV(0); SBAR(); }
    if (NT > 1) { if constexpr (F32) SLOAD_F((const float*)Kh, KBASE(1)); else SLOAD_H(Kh, Vh, KBASE(1)); }
    SBAR(); qkt<0, SK, MODE>(pA0, pA1, K_lds, r32, hi, S.qr, ACT(0), BT(0));
    if constexpr (F32) { if (NT > 1) { VMW(); SWRITE_KF(1); SBAR(); SLOAD_F((const float*)Vh, KBASE(1)); } }
    MASKT(pA0, pA1, 0); PSM(pA0, pA1, mnA, alA, 0);
    if (NT > 1) { VMW(); if constexpr (F32) { SWRITE_VF(1); SBAR(); if (NT > 2) SLOAD_F((const float*)Kh, KBASE(2)); } else SWRITE_H(1); }
    __syncthreads();
#define HALF_STEP(PX0, PX1, mnX, alX, PY0, PY1, alY, t, KB, VB, SB) do {                                                      \
        SBAR(); qkt<KB, SK, MODE>(PX0, PX1, K_lds, r32, hi, S.qr, ACT(t), BT(t));                                \
        finishSM<MODE>(PY0, PY1, alY, l_reg, pa0, pa1, pa2, pa3); SBAR();                                                           \
        if ((t) + 1 < NT) { if constexpr (F32) { VMW(); SWRITE_KF(SB); SBAR(); SLOAD_F((const float*)Vh, KBASE((t) + 1)); }  \
                            else { SLOAD_H(Kh, Vh, KBASE((t) + 1)); } SBAR(); }                                               \
        pv_tile<VB, SK>(o, vb0, pa0, pa1, pa2, pa3, ACT((t) - 1)); MASKT(PX0, PX1, (t)); PSM(PX0, PX1, mnX, alX, (t));                                        \
        __syncthreads();                                                                                                      \
        if ((t) + 1 < NT) { VMW(); if constexpr (F32) { SWRITE_VF(SB); SBAR(); if ((t) + 2 < NT) SLOAD_F((const float*)Kh, KBASE((t) + 2)); } \
                            else { SWRITE_H(SB); } }                                                                          \
        RESC(alX); __syncthreads(); } while (0)
    for (int t = 1; t + 1 < NT; t += 2) {
        HALF_STEP(pB0, pB1, mnB, alB, pA0, pA1, alA, t, 1, 0, 0);
        HALF_STEP(pA0, pA1, mnA, alA, pB0, pB1, alB, t + 1, 0, 1, 1);
    }
    const bool even = (NT & 1) == 0;
    if (even) { SBAR(); qkt<1, SK, MODE>(pB0, pB1, K_lds, r32, hi, S.qr, ACT(NT - 1), BT(NT - 1)); SBAR(); }
#define QROW(e) (nxt.Q + (size_t)(wid * QBLK + r32) * D + ((e) >> 1) * 16 + hi * 8 + ((e) & 1) * 4)
    if constexpr (F32) { SLOAD_F((const float*)nxt.K, kbn); SBAR();
#pragma unroll
        for (int e = 0; e < 8; ++e) S.tq[e] = *(const f32x4*)QROW(e); }
    else { SLOAD_H(nxt.K, nxt.V, kbn); SBAR();
#pragma unroll
        for (int d0 = 0; d0 < 8; ++d0) S.qr[d0] = load8<TIn>(nxt.Q + (unsigned)((wid * QBLK + r32) * D + d0 * 16 + hi * 8)); }
    SBAR();
    finishSM<MODE>(pA0, pA1, alA, l_reg, pa0, pa1, pa2, pa3); SBAR();
    if constexpr (F32) {
#pragma unroll
        for (int e = 8; e < 16; ++e) S.tq[e] = *(const f32x4*)QROW(e); SBAR(); }
#undef QROW
    pv_tile<0, SK>(o, vb0, pa0, pa1, pa2, pa3, ACT(even ? NT - 2 : NT - 1));
    if (even) { MASKT(pB0, pB1, NT - 1); PSM(pB0, pB1, mnB, alB, NT - 1); __syncthreads(); RESC(alB);
        finishSM<MODE>(pB0, pB1, alB, l_reg, pa0, pa1, pa2, pa3); SBAR(); pv_tile<1, SK>(o, vb0, pa0, pa1, pa2, pa3, ACT(NT - 1)); }
    SBAR(); SEAM_K0();
    float rli[16];
    if constexpr (MODE == 0) {
        if (hi == 0) li_l[r32] = l_reg; asm volatile("s_waitcnt lgkmcnt(0)" ::: "memory");
#pragma unroll
        for (int r = 0; r < 16; ++r) rli[r] = __builtin_amdgcn_rcpf(li_l[crow(r, hi)]);
    } else {
#pragma unroll
        for (int r = 0; r < 16; ++r) { float sq = (o[0][r] * o[0][r] + o[1][r] * o[1][r]) + (o[2][r] * o[2][r] + o[3][r] * o[3][r]);
            sq += __shfl_xor(sq, 1); sq += __shfl_xor(sq, 2); sq += __shfl_xor(sq, 4); sq += __shfl_xor(sq, 8); sq += __shfl_xor(sq, 16);
            rli[r] = rsqrtf(sq * (1.f / 128.f) + 1e-6f); }
    }
    { int t2 = threadIdx.x; asm volatile("" : "+v"(t2));
      const int w2 = __builtin_amdgcn_readfirstlane(t2 >> 6), c2 = t2 & 31, h2 = (t2 >> 5) & 1;
      TOut* Ow = cur.O + (unsigned)((w2 * QBLK + 4 * h2) * LDO + c2);
      float nwv[4] = {1.f, 1.f, 1.f, 1.f}; const TIn* Gp = nullptr;
      if constexpr (MODE == 1) { Gp = X.G + ((size_t)cur.bh * 8192 + cur.P0) * D + (unsigned)((w2 * QBLK + 4 * h2) * D + c2);
#pragma unroll
          for (int d0 = 0; d0 < 4; ++d0) nwv[d0] = X.nw[(cur.bh & 7) * D + d0 * 32 + c2]; }
#pragma unroll
      for (int r = 0; r < 16; ++r) { const int ro = (r & 3) + 8 * (r >> 2);
          float v[4];
#pragma unroll
          for (int d0 = 0; d0 < 4; ++d0) { v[d0] = o[d0][r] * rli[r];
              if constexpr (MODE == 1) { const unsigned gq = Gp[ro * D + d0 * 32]; v[d0] *= nwv[d0] * __uint_as_float(gq << 16); } }
#pragma unroll
          for (int d0 = 0; d0 < 4; ++d0) { const float vn = __shfl_xor(v[d0], 1);
              if ((c2 & 1) == 0) *(unsigned*)(Ow + ro * LDO + d0 * 32) = cvtpk(v[d0], vn); }
          if ((r & 3) == 3) asm volatile("" ::: "memory"); } }
    if constexpr (F32) {
#pragma unroll
        for (int d0 = 0; d0 < 8; ++d0) S.qr[d0] = pack8(S.tq[2 * d0], S.tq[2 * d0 + 1]); }
    __syncthreads();
#undef RESC
#undef BT
#undef PSM
#undef KBASE
#undef ACT
#undef MASKT
#undef SEAM_K0
#undef HALF_STEP
}
#undef ROW
#undef VMW
#undef VMWN
#undef SLOAD_H
#undef SWRITE_HK
#undef SWRITE_HV
#undef SWRITE_H
#undef SLOAD_F
#undef SWRITE_KF
#undef SWRITE_VF

}
constexpr int NWAVES = 8;
namespace W {
constexpr size_t CTL = 0, CTL_ZERO_BYTES = 1 * MiB;
constexpr size_t MOD = 1 * MiB, MODP = 2 * MiB, ROPE = 4 * MiB, LOGF = 8 * MiB, CUM = 9 * MiB, BIAS = 9 * MiB + 512 * 1024, ROUTE = 10 * MiB, TILE = 11 * MiB, JLO = 12 * MiB, WFR = 13 * MiB, A2S2 = 14 * MiB;
constexpr size_t XN = 16 * MiB, MIX = 80 * MiB, WT_IN = 144 * MiB, WT_OUT = 172 * MiB, WT_13 = 180 * MiB, WT_2 = 308 * MiB, QKV = 372 * MiB, END = 596 * MiB;
constexpr size_t KVS = XN, ST = XN + 32 * MiB;
constexpr size_t H2 = XN, XS = QKV, ACT = QKV + 160 * MiB, Y = 16 * MiB;
constexpr size_t NV_RO = 596 * MiB, NV_UP = 596 * MiB, NV_Z = 144 * MiB, NV_END = 676 * MiB;
}
constexpr int CW_CNT = 0, CNT_STRIDE = 64;
constexpr int CW_QFOX = 2560;
constexpr int CW_BAR = 4096;
constexpr int RING_OFF = 0, RING_BYTES = 131072, XCH_OFF = 131072, XCH_BYTES = 8192, LDS_BYTES = 163840, MISC_OFF = LDS_BYTES - 512;

struct Args { const float* in[19]; float* out; unsigned char* ws; int ph_lo, ph_hi, li, pad; };

__device__ __forceinline__ float wave_sum(float v) {
#define WS_DPP(ctrl, rmask, bc) v += __int_as_float(__builtin_amdgcn_update_dpp(0, __float_as_int(v), ctrl, rmask, 0xF, bc))
    WS_DPP(0x111, 0xF, true); WS_DPP(0x112, 0xF, true); WS_DPP(0x114, 0xF, true); WS_DPP(0x118, 0xF, true);
    WS_DPP(0x142, 0xA, false); WS_DPP(0x143, 0xC, false);
#undef WS_DPP
    return __int_as_float(__builtin_amdgcn_readlane(__float_as_int(v), 63));
}
__device__ __forceinline__ unsigned pk2(float lo, float hi) { return f2bf(lo) | (f2bf(hi) << 16); }
__device__ __forceinline__ float log_sigmoid_f(float x) { return x >= 0.f ? -log1pf(expf(-x)) : x - log1pf(expf(x)); }

__device__ __forceinline__ void tr_item(const float* colp, size_t ldw, bf16_t* WT, int K, int k0, int n0, LAS float* scr, int lane) {
#pragma unroll 8
    for (int i = 0; i < 32; ++i) { const int kk = 2 * i + (lane >> 5); scr[kk * 33 + (lane & 31)] = colp[(size_t)(k0 + kk) * ldw]; }
    LDS_WAIT(); asm volatile("" ::: "memory");
    const int c = lane & 7;
#pragma unroll
    for (int j = 0; j < 4; ++j) { const int n = (lane >> 3) + 8 * j; const LAS float* s = scr + (8 * c) * 33 + n;
        uint4 o; o.x = pk2(s[0 * 33], s[1 * 33]); o.y = pk2(s[2 * 33], s[3 * 33]); o.z = pk2(s[4 * 33], s[5 * 33]); o.w = pk2(s[6 * 33], s[7 * 33]);
        *(uint4*)(WT + (size_t)(n0 + n) * K + k0 + 8 * c) = o; }
    LDS_WAIT(); asm volatile("" ::: "memory");
}
__device__ __forceinline__ void tr_item4(const float* colp4, size_t ldw, bf16_t* WT, int K, int k0, int n0, LAS float* scr, int lane) {
    const int kr = lane >> 3, cq = (lane & 7) * 4;
    pg8::f32x4 v[8];
#pragma unroll
    for (int i = 0; i < 8; ++i) v[i] = *(const pg8::f32x4*)(colp4 + (size_t)(k0 + i * 8 + kr) * ldw);
#pragma unroll
    for (int i = 0; i < 8; ++i) { const int kk = i * 8 + kr;
        scr[kk * 33 + cq] = v[i][0]; scr[kk * 33 + cq + 1] = v[i][1]; scr[kk * 33 + cq + 2] = v[i][2]; scr[kk * 33 + cq + 3] = v[i][3]; }
    LDS_WAIT(); asm volatile("" ::: "memory");
    const int c = lane & 7;
#pragma unroll
    for (int j = 0; j < 4; ++j) { const int n = (lane >> 3) + 8 * j; const LAS float* s = scr + (8 * c) * 33 + n;
        uint4 o; o.x = pk2(s[0 * 33], s[1 * 33]); o.y = pk2(s[2 * 33], s[3 * 33]); o.z = pk2(s[4 * 33], s[5 * 33]); o.w = pk2(s[6 * 33], s[7 * 33]);
        *(uint4*)(WT + (size_t)(n0 + n) * K + k0 + 8 * c) = o; }
    LDS_WAIT(); asm volatile("" ::: "memory");
}
__device__ __forceinline__ unsigned pk4_fp8(float a, float b, float c, float d) { int p = __builtin_amdgcn_cvt_pk_fp8_f32(a, b, 0, false); p = __builtin_amdgcn_cvt_pk_fp8_f32(c, d, p, true); return (unsigned)p; }
__device__ __forceinline__ void tr4_load(pg8::f32x4 (&v)[8], const float* colp4, size_t ldw, int k0, int lane) {
    const int kr = lane >> 3;
#pragma unroll
    for (int i = 0; i < 8; ++i) v[i] = *(const pg8::f32x4*)(colp4 + (size_t)(k0 + i * 8 + kr) * ldw);
}
__device__ __forceinline__ void tr4_finish_f8(const pg8::f32x4 (&v)[8], unsigned char* WT, int K, int k0, int n0, float scale, LAS float* scr, int lane) {
    const int kr = lane >> 3, cq = (lane & 7) * 4;
#pragma unroll
    for (int i = 0; i < 8; ++i) { const int kk = i * 8 + kr;
        scr[kk * 33 + cq] = v[i][0] * scale; scr[kk * 33 + cq + 1] = v[i][1] * scale; scr[kk * 33 + cq + 2] = v[i][2] * scale; scr[kk * 33 + cq + 3] = v[i][3] * scale; }
    LDS_WAIT(); asm volatile("" ::: "memory");
    const int c = lane & 7;
#pragma unroll
    for (int j = 0; j < 4; ++j) { const int n = (lane >> 3) + 8 * j; const LAS float* sp = scr + (8 * c) * 33 + n;
        uint2 o; o.x = pk4_fp8(sp[0 * 33], sp[1 * 33], sp[2 * 33], sp[3 * 33]); o.y = pk4_fp8(sp[4 * 33], sp[5 * 33], sp[6 * 33], sp[7 * 33]);
        *(uint2*)(WT + (size_t)(n0 + n) * K + k0 + 8 * c) = o; }
    LDS_WAIT(); asm volatile("" ::: "memory");
}
constexpr float SC13 = 64.f, SC2 = 32.f;
__device__ __forceinline__ int win_src(int n) {
    const int tt = n >> 10;
    if (tt < 3) return n;
    if (tt < 5) { const int d = n & 127; return 8 + (n & ~127) + (d & 1) * 64 + (d >> 1); }
    return n + 8;
}
__device__ __forceinline__ void ph0(const Args& a, LAS unsigned char* lds, int G) {
    const int tid = threadIdx.x, lane = tid & 63, wave = __builtin_amdgcn_readfirstlane(tid >> 6);
    unsigned char* ws = a.ws;
    LAS float* cact = (LAS float*)(lds + RING_OFF + 98304);
    const float* c = a.in[1]; const float* w_ada = a.in[2];
    for (int i = tid; i < 4096; i += 512) { const float cv = c[i]; cact[i] = cv / (1.f + expf(-cv)); }
    __syncthreads();
    float* modp = (float*)(ws + W::MODP);
    LAS float* red = (LAS float*)(lds + RING_OFF);
    for (int it = blockIdx.x; it < 192; it += G) { const int cb = it % 12, ks = it / 12; const int col = cb * 1024 + lane * 4, k0 = ks * 128 + wave * 16;
        pg8::f32x4 w[16];
#pragma unroll
        for (int i = 0; i < 16; ++i) w[i] = *(const pg8::f32x4*)(w_ada + (size_t)(k0 + i) * 12288 + col);
        pg8::f32x4 a0 = {0.f, 0.f, 0.f, 0.f}, a1 = {0.f, 0.f, 0.f, 0.f}, b0 = a0, b1 = a0, c0 = a0, c1 = a0, d0 = a0, d1 = a0;
        (void)b0; (void)b1; (void)c0; (void)c1; (void)d0; (void)d1;
#pragma unroll
        for (int i = 0; i < 16; ++i) { a0 += w[i] * cact[k0 + i]; a1 += w[i] * cact[2048 + k0 + i]; }
        pg8::f32x4 e0[3], e1[3];
#pragma unroll
        for (int q = 1; q < 4; ++q) { pg8::f32x4 t0 = {0.f, 0.f, 0.f, 0.f}, t1 = t0;
#pragma unroll
            for (int i = 0; i < 16; ++i) w[i] = *(const pg8::f32x4*)(w_ada + (size_t)(k0 + i) * 12288 + col + q * 256);
#pragma unroll
            for (int i = 0; i < 16; ++i) { t0 += w[i] * cact[k0 + i]; t1 += w[i] * cact[2048 + k0 + i]; }
            e0[q - 1] = t0; e1[q - 1] = t1; }
        __syncthreads();
        *(LAS pg8::f32x4*)(red + (wave * 2 + 0) * 1024 + lane * 4) = a0; *(LAS pg8::f32x4*)(red + (wave * 2 + 1) * 1024 + lane * 4) = a1;
#pragma unroll
        for (int q = 1; q < 4; ++q) { *(LAS pg8::f32x4*)(red + (wave * 2 + 0) * 1024 + q * 256 + lane * 4) = e0[q - 1]; *(LAS pg8::f32x4*)(red + (wave * 2 + 1) * 1024 + q * 256 + lane * 4) = e1[q - 1]; }
        __syncthreads();
        for (int i = tid; i < 2048; i += 512) { const int bb = i >> 10, cc = i & 1023; float t = 0.f;
#pragma unroll
            for (int wv = 0; wv < 8; ++wv) t += red[(wv * 2 + bb) * 1024 + cc];
            modp[(ks * 2 + bb) * 12288 + cb * 1024 + cc] = t; }
    }
    __syncthreads();
    float2* rope = (float2*)(ws + W::ROPE);
    for (int i = blockIdx.x * 512 + tid; i < 8192 * 64; i += G * 512) { const int s = i >> 6, j = i & 63;
        const float theta = powf(10000.f, -(float)j / 64.f); const float ang = (float)s * theta;
        const double ad = (double)ang, TWO_PI = 6.283185307179586; const double kq = rint(ad / TWO_PI); const float r = (float)(ad - kq * TWO_PI);
        rope[i] = make_float2(cosf(r), sinf(r)); }
    { bf16_t* wfr = (bf16_t*)(ws + W::WFR); const float* w_coarse = a.in[12]; const float* w_fine = a.in[14];
      for (int i = blockIdx.x * 512 + tid; i < 64 * 3 * 64 * 8; i += G * 512) { const int e8 = i & 7, ln = (i >> 3) & 63, ob = (i >> 9) % 3, ks = (i >> 9) / 3, o = ob * 16 + (ln & 15), k = 32 * ks + 8 * (ln >> 4) + e8;
          const float wv = o < 4 ? w_coarse[(size_t)k * 4 + o] : (o < 36 ? w_fine[((size_t)((o - 4) >> 3) * 2048 + k) * 8 + ((o - 4) & 7)] : 0.f);
          const unsigned h = f2bf(wv), l = f2bf(wv - __uint_as_float(h << 16));
          wfr[(((size_t)(ks * 3 + ob) * 2 + 0) * 64 + ln) * 8 + e8] = (bf16_t)h; wfr[(((size_t)(ks * 3 + ob) * 2 + 1) * 64 + ln) * 8 + e8] = (bf16_t)l; } }
    LAS float* scr = (LAS float*)(lds + RING_OFF + wave * 12288);
    const float* w_in = a.in[5]; const float* w_out = a.in[10]; const float* w1 = a.in[16]; const float* w3 = a.in[17]; const float* w2 = a.in[18];
    bf16_t* wt_in = (bf16_t*)(ws + W::WT_IN); bf16_t* wt_out = (bf16_t*)(ws + W::WT_OUT); bf16_t* wt_13 = (bf16_t*)(ws + W::WT_13); bf16_t* wt_2 = (bf16_t*)(ws + W::WT_2);
    constexpr int I_IN = 32 * 224, I_OUT = 32 * 64, NITEMS = I_IN + I_OUT;
    const int gw = blockIdx.x * NWAVES + wave, NGW = G * NWAVES;
    for (int it = gw; it < NITEMS; it += NGW) {
        int r = it;
        if (r < I_IN) { const int kb = r / 224, nb = r % 224; tr_item(w_in + win_src(nb * 32 + (lane & 31)), 7176, wt_in, 2048, kb * 64, nb * 32, scr, lane); continue; } r -= I_IN;
        { const int kb = r / 64, nb = r % 64; tr_item4(w_out + nb * 32 + (lane & 7) * 4, 2048, wt_out, 2048, kb * 64, nb * 32, scr, lane); }
    }
}
__device__ __forceinline__ void moe_convert(const Args& a, LAS unsigned char* lds, int G) {
    const int tid = threadIdx.x, lane = tid & 63, wave = __builtin_amdgcn_readfirstlane(tid >> 6);
    unsigned char* ws = a.ws; LAS unsigned char* T = lds + RING_OFF;
    const float* w1 = a.in[16]; const float* w3 = a.in[17]; const float* w2 = a.in[18];
    unsigned char* wt_13 = ws + W::WT_13; unsigned char* wt_2 = ws + W::WT_2;
    constexpr int S13 = 32 * 64, S2 = 32 * 32, NS = S13 + S2;
    const int kg = lane & 7, ng = wave * 8 + (lane >> 3);
    __syncthreads();
    for (int st = blockIdx.x; st < NS; st += G) {
        const float* src; size_t ld; unsigned char* dst; int K; float sc;
        if (st < S13) { const int e = st >> 6, r = st & 63, kb = r >> 2, nb = r & 3;
            src = ((lane & 1) ? w3 : w1) + (size_t)e * 2048 * 512 + (size_t)(kb * 128) * 512 + nb * 128 + 4 * (lane >> 1); ld = 512;
            dst = wt_13 + (size_t)e * 1024 * 2048 + (size_t)(nb * 256) * 2048 + kb * 128; K = 2048; sc = SC13; }
        else { const int r0 = st - S13, e = r0 >> 5, r = r0 & 31, kb = r >> 3, nb = r & 7;
            src = w2 + (size_t)e * 512 * 2048 + (size_t)(kb * 128) * 2048 + nb * 256 + 4 * lane; ld = 2048;
            dst = wt_2 + (size_t)e * 2048 * 512 + (size_t)(nb * 256) * 512 + kb * 128; K = 512; sc = SC2; }
        pg8::f32x4 v[16];
#pragma unroll
        for (int i = 0; i < 16; ++i) v[i] = *(const pg8::f32x4*)(src + (size_t)(i * 8 + wave) * ld);
#pragma unroll
        for (int i = 0; i < 16; ++i) *(LAS unsigned*)(T + (i * 8 + wave) * 260 + lane * 4) = pk4_fp8(v[i][0] * sc, v[i][1] * sc, v[i][2] * sc, v[i][3] * sc);
        __syncthreads();
        unsigned R[16];
#pragma unroll
        for (int j = 0; j < 16; ++j) R[j] = *(const LAS unsigned*)(T + (16 * kg + j) * 260 + ng * 4);
        __syncthreads();
        pg8::u32x4 o[4];
#pragma unroll
        for (int q = 0; q < 4; ++q) {
            const unsigned lo01 = __builtin_amdgcn_perm(R[4 * q + 1], R[4 * q], 0x05010400u), hi01 = __builtin_amdgcn_perm(R[4 * q + 1], R[4 * q], 0x07030602u);
            const unsigned lo23 = __builtin_amdgcn_perm(R[4 * q + 3], R[4 * q + 2], 0x05010400u), hi23 = __builtin_amdgcn_perm(R[4 * q + 3], R[4 * q + 2], 0x07030602u);
            o[0][q] = __builtin_amdgcn_perm(lo23, lo01, 0x05040100u); o[1][q] = __builtin_amdgcn_perm(lo23, lo01, 0x07060302u);
            o[2][q] = __builtin_amdgcn_perm(hi23, hi01, 0x05040100u); o[3][q] = __builtin_amdgcn_perm(hi23, hi01, 0x07060302u); }
#pragma unroll
        for (int nbq = 0; nbq < 4; ++nbq) *(pg8::u32x4*)(dst + (size_t)(4 * ng + nbq) * K + 16 * kg) = o[nbq];
    }
    __syncthreads();
}

__device__ __forceinline__ void ph1(const Args& a, LAS unsigned char* lds, int G) {
    const int tid = threadIdx.x, lane = tid & 63, wave = __builtin_amdgcn_readfirstlane(tid >> 6);
    unsigned char* ws = a.ws;
    const float* x = a.in[0]; const float* b_ada = a.in[3]; const float* norm1_w = a.in[4]; const float* w_in = a.in[5]; const float* fbias = a.in[6];
    const float* modp = (const float*)(ws + W::MODP); float* mod = (float*)(ws + W::MOD); bf16_t* xn = (bf16_t*)(ws + W::XN); float* logf_ = (float*)(ws + W::LOGF);
    for (int i = blockIdx.x * 512 + tid; i < 2 * 12288; i += G * 512) { const int b = i / 12288, j = i % 12288; float s = b_ada[j];
        for (int k = 0; k < 16; ++k) s += modp[(k * 2 + b) * 12288 + j];
        mod[i] = s; }
    LAS float* A1 = (LAS float*)(lds + RING_OFF); LAS float* S1 = A1 + 2048; LAS float* WFT = S1 + 2048;
    for (int i = tid; i < 2048 * 2; i += 512) { const int cc = i >> 1, hf = (i & 1) * 4; const pg8::f32x4 w = *(const pg8::f32x4*)(w_in + (size_t)cc * 7176 + 3072 + hf);
        WFT[(hf + 0) * 2048 + cc] = w[0]; WFT[(hf + 1) * 2048 + cc] = w[1]; WFT[(hf + 2) * 2048 + cc] = w[2]; WFT[(hf + 3) * 2048 + cc] = w[3]; }
    int bprev = -1;
    for (int rb = blockIdx.x; rb < 256; rb += G) {
        const int b = rb >> 7;
        if (b != bprev) { __syncthreads();
            for (int cc = tid; cc < 2048; cc += 512) { float sh = b_ada[cc], sc = b_ada[2048 + cc];
                for (int k = 0; k < 16; ++k) { sh += modp[(k * 2 + b) * 12288 + cc]; sc += modp[(k * 2 + b) * 12288 + 2048 + cc]; }
                A1[cc] = norm1_w[cc] * (1.f + sc); S1[cc] = sh; }
            __syncthreads(); bprev = b; }
#pragma unroll 1
        for (int q = 0; q < 8; ++q) {
            const int row = rb * 64 + wave * 8 + q;
            pg8::f32x4 v[8]; float ss = 0.f;
#pragma unroll
            for (int j = 0; j < 8; ++j) { v[j] = *(const pg8::f32x4*)(x + (size_t)row * 2048 + j * 256 + lane * 4); ss += (v[j][0] * v[j][0] + v[j][1] * v[j][1]) + (v[j][2] * v[j][2] + v[j][3] * v[j][3]); }
            const float rstd = rsqrtf(wave_sum(ss) * (1.f / 2048.f) + 1e-6f);
            float fa[8] = {0.f, 0.f, 0.f, 0.f, 0.f, 0.f, 0.f, 0.f};
#pragma unroll
            for (int j = 0; j < 8; ++j) { const int c = j * 256 + lane * 4; const pg8::f32x4 a1 = *(const LAS pg8::f32x4*)(A1 + c), s1 = *(const LAS pg8::f32x4*)(S1 + c);
                const pg8::f32x4 h = v[j] * rstd * a1 + s1;
                uint2 pk; pk.x = pk2(h[0], h[1]); pk.y = pk2(h[2], h[3]); *(uint2*)(xn + (size_t)row * 2048 + c) = pk;
#pragma unroll
                for (int hh = 0; hh < 8; ++hh) { const pg8::f32x4 w = *(const LAS pg8::f32x4*)(WFT + hh * 2048 + c); fa[hh] += (h[0] * w[0] + h[1] * w[1]) + (h[2] * w[2] + h[3] * w[3]); }
                asm volatile("" ::: "memory"); }
            float t = 0.f;
#pragma unroll
            for (int hh = 0; hh < 8; ++hh) { const float sm = wave_sum(fa[hh]); if (lane == hh) t = sm; }
            if (lane < 8) logf_[(size_t)((row >> 13) * 8 + lane) * 8192 + (row & 8191)] = log_sigmoid_f(t + fbias[lane]);
        }
    }
    __syncthreads();
}

__device__ __forceinline__ void cumsum_bh(const Args& a, LAS unsigned char* lds, int bh) {
    const int tid = threadIdx.x; unsigned char* ws = a.ws;
    const float* p = (const float*)(ws + W::LOGF) + (size_t)bh * 8192 + tid * 16; float* cum = (float*)(ws + W::CUM) + (size_t)bh * 8192 + tid * 16; float* bias = (float*)(ws + W::BIAS) + (size_t)bh * 8192 + tid * 16;
    LAS double* sc = (LAS double*)(lds + RING_OFF);
    double run = 0.0;
#pragma unroll
    for (int i = 0; i < 16; ++i) run += (double)p[i];
    sc[tid] = run; __syncthreads();
    int cur = 0;
    for (int o = 1; o < 512; o <<= 1) { const double t = sc[cur * 512 + tid] + (tid >= o ? sc[cur * 512 + tid - o] : 0.0); sc[(cur ^ 1) * 512 + tid] = t; cur ^= 1; __syncthreads(); }
    double acc = sc[cur * 512 + tid] - run;
    LAS float* TE = (LAS float*)(lds + RING_OFF + 16384); LAS float* BS = TE + 128; LAS int* JL = (LAS int*)(BS + 32);
#pragma unroll
    for (int i = 0; i < 16; ++i) { acc += (double)p[i]; cum[i] = (float)acc; bias[i] = (float)(-acc * 11.313708498984761);
        if (i == 0 && (tid & 15) == 0) BS[tid >> 4] = (float)acc;
        if (i == 15 && (tid & 3) == 3) TE[tid >> 2] = (float)acc; }
    if (tid < 32) JL[tid] = 4 * tid;
    __syncthreads();
    float mq = 0.f, mk = 0.f;
    for (int i = 0; i < 128; ++i) { mq = fmaxf(mq, fabsf(a.in[7][i])); mk = fmaxf(mk, fabsf(a.in[8][i])); }
    const float thr = 30.f + 2.f * 11.313708498984761f * mq * mk;
    for (int pr = tid; pr < 32 * 128; pr += 512) { const int qb = pr >> 7, j = pr & 127; if (j <= 4 * qb && TE[j] < BS[qb] + thr) atomicMin((int*)(JL + qb), j); }
    __syncthreads();
    if (tid < 32) ((int*)(ws + W::JLO))[bh * 32 + tid] = JL[tid];
    __syncthreads();
}
struct EpiZ {
    static constexpr bool PERM = true, AFTER_DRAIN = false;
    bf16_t* qkv; const float* q_norm_w; const float* k_norm_w; const float* rope; PG8_LAS float* xch;
    __device__ __forceinline__ void operator()(const pg8::f32x4 (&acc)[2][2][4][2], const pg8::Unit& u, int wr, int wc, int fr, int fq) const {
        using pg8::f32x4; using pg8::u32x4;
        const int tt = u.pn >> 2, hp = (u.pn & 3) * 2;
        const int row0 = u.pm * 256 + wr * 64 + fr, b = row0 >> 13, dcol = wc * 32 + 8 * fq;
        bf16_t* base = qkv + (size_t)tt * QKV_ELEMS + ((size_t)(b * 8 + hp) * 8192) * 128 + dcol;
        if (tt < 2) {
#pragma unroll
            for (int ai = 0; ai < 2; ++ai)
#pragma unroll
                for (int m = 0; m < 4; ++m)
#pragma unroll
                    for (int bj = 0; bj < 2; ++bj) { const f32x4 v0 = acc[ai][bj][m][0], v1 = acc[ai][bj][m][1];
                        float s = (v0[0] * v0[0] + v0[1] * v0[1]) + (v0[2] * v0[2] + v0[3] * v0[3]) + (v1[0] * v1[0] + v1[1] * v1[1]) + (v1[2] * v1[2] + v1[3] * v1[3]);
                        s += __shfl_xor(s, 16); s += __shfl_xor(s, 32);
                        if (fq == 0) xch[((ai * 128 + wr * 64 + m * 16 + fr) * 2 + bj) * 4 + wc] = s; }
            asm volatile("s_waitcnt lgkmcnt(0)" ::: "memory"); __builtin_amdgcn_s_barrier(); asm volatile("" ::: "memory");
            const float* nw = tt == 0 ? q_norm_w : k_norm_w; const f32x4 w0 = *(const f32x4*)(nw + dcol), w1 = *(const f32x4*)(nw + dcol + 4);
#pragma unroll
            for (int ai = 0; ai < 2; ++ai)
#pragma unroll
                for (int m = 0; m < 4; ++m) { const int rl = ai * 128 + wr * 64 + m * 16 + fr; const int s_ = (row0 + ai * 128 + m * 16) & 8191;
#pragma unroll
                    for (int bj = 0; bj < 2; ++bj) { const f32x4 p = *(const PG8_LAS f32x4*)(xch + (rl * 2 + bj) * 4);
                        const float rstd = rsqrtf(((p[0] + p[1]) + (p[2] + p[3])) * (1.f / 128.f) + 1e-6f);
                        const f32x4 v0 = acc[ai][bj][m][0] * rstd * w0, v1 = acc[ai][bj][m][1] * rstd * w1;
                        u32x4 w; w.x = pg8::cvt_pk_bf16(v0[0], v0[1]); w.y = pg8::cvt_pk_bf16(v0[2], v0[3]); w.z = pg8::cvt_pk_bf16(v1[0], v1[1]); w.w = pg8::cvt_pk_bf16(v1[2], v1[3]);
                        *(u32x4*)(base + ((size_t)bj * 8192 + s_) * 128) = w; } }
        } else if (tt == 3 || tt == 4) {
            float l2g[2];
#pragma unroll
            for (int bj = 0; bj < 2; ++bj) l2g[bj] = log2f(1.f - exp2f(-5.f - (float)(hp + bj)));
#pragma unroll
            for (int ai = 0; ai < 2; ++ai)
#pragma unroll
                for (int m = 0; m < 4; ++m) { const int s_ = (row0 + ai * 128 + m * 16) & 8191;
                    const f32x4 c0 = *(const f32x4*)(rope + ((size_t)s_ * 64 + (dcol >> 1)) * 2), c1 = *(const f32x4*)(rope + ((size_t)s_ * 64 + (dcol >> 1) + 2) * 2);
#pragma unroll
                    for (int bj = 0; bj < 2; ++bj) { const f32x4 v0 = acc[ai][bj][m][0], v1 = acc[ai][bj][m][1];
                        const float f = tt == 4 ? 0.08838834764831845f * exp2f(-(float)(s_ & 63) * l2g[bj]) : 1.f;
                        const float o0 = (v0[0] * c0[0] - v0[1] * c0[1]) * f, o1 = (v0[0] * c0[1] + v0[1] * c0[0]) * f, o2 = (v0[2] * c0[2] - v0[3] * c0[3]) * f, o3 = (v0[2] * c0[3] + v0[3] * c0[2]) * f;
                        const float o4 = (v1[0] * c1[0] - v1[1] * c1[1]) * f, o5 = (v1[0] * c1[1] + v1[1] * c1[0]) * f, o6 = (v1[2] * c1[2] - v1[3] * c1[3]) * f, o7 = (v1[2] * c1[3] + v1[3] * c1[2]) * f;
                        u32x4 w; w.x = pg8::cvt_pk_bf16(o0, o1); w.y = pg8::cvt_pk_bf16(o2, o3); w.z = pg8::cvt_pk_bf16(o4, o5); w.w = pg8::cvt_pk_bf16(o6, o7);
                        *(u32x4*)(base + ((size_t)bj * 8192 + s_) * 128) = w; } }
        } else {
#pragma unroll
            for (int ai = 0; ai < 2; ++ai)
#pragma unroll
                for (int m = 0; m < 4; ++m) { const int s_ = (row0 + ai * 128 + m * 16) & 8191;
#pragma unroll
                    for (int bj = 0; bj < 2; ++bj) { f32x4 v0 = acc[ai][bj][m][0], v1 = acc[ai][bj][m][1];
                        if (tt == 6) {
#pragma unroll
                            for (int e = 0; e < 4; ++e) { v0[e] = v0[e] / (1.f + __expf(-v0[e])); v1[e] = v1[e] / (1.f + __expf(-v1[e])); } }
                        u32x4 w; w.x = pg8::cvt_pk_bf16(v0[0], v0[1]); w.y = pg8::cvt_pk_bf16(v0[2], v0[3]); w.z = pg8::cvt_pk_bf16(v1[0], v1[1]); w.w = pg8::cvt_pk_bf16(v1[2], v1[3]);
                        *(u32x4*)(base + ((size_t)bj * 8192 + s_) * 128) = w; } }
        }
    }
};


__device__ __forceinline__ void kv_units(const Args& a, char* lds, int G) {
    using namespace at;
    const int tid = threadIdx.x, wid = __builtin_amdgcn_readfirstlane(tid >> 6), lane = tid & 63, r32 = lane & 31, hi = lane >> 5;
    const int sr = tid >> 4, sc = (tid & 15) * 8, st0 = v_st(sr, sc), st1 = v_st(32 + sr, sc);
    const int dblk = wid >> 1, eb0 = (wid & 1) * 2;
    const int kb_ = (int)(uintptr_t)lds + v_rd_base(lane) + dblk * 512, vb_ = (int)(uintptr_t)lds + 32768 + v_rd_base(lane) + eb0 * 512;
    const bf16* q = (const bf16*)(a.ws + W::QKV); float* kvs = (float*)(a.ws + W::KVS);
#define TRRD(dst, base, off) asm volatile("ds_read_b64_tr_b16 %0, %1 offset:%2" : "=&v"(dst) : "v"(base), "i"(off) : "memory")
#define KV_STEP(BUF, KS) do { s16x4 al, ah, b0l, b0h, b1l, b1h; constexpr int o_ = (BUF) * 16384 + (KS) * 4096; \
        TRRD(al, kb_, o_); TRRD(ah, kb_, o_ + 2048); TRRD(b0l, vb_, o_); TRRD(b0h, vb_, o_ + 2048); TRRD(b1l, vb_, o_ + 512); TRRD(b1h, vb_, o_ + 512 + 2048); \
        asm volatile("s_waitcnt lgkmcnt(0)" ::: "memory"); SBAR(); \
        const bf16x8 A_ = {al[0], al[1], al[2], al[3], ah[0], ah[1], ah[2], ah[3]}; \
        acc0 = __builtin_amdgcn_mfma_f32_32x32x16_bf16(A_, (bf16x8){b0l[0], b0l[1], b0l[2], b0l[3], b0h[0], b0h[1], b0h[2], b0h[3]}, acc0, 0, 0, 0); \
        acc1 = __builtin_amdgcn_mfma_f32_32x32x16_bf16(A_, (bf16x8){b1l[0], b1l[1], b1l[2], b1l[3], b1h[0], b1h[1], b1h[2], b1h[3]}, acc1, 0, 0, 0); } while (0)
#define KV_LOAD(T) do { k0 = *(const bf16x8*)(Kp + (unsigned)((64 * (T) + sr) * 128 + sc)); k1 = *(const bf16x8*)(Kp + (unsigned)((64 * (T) + 32 + sr) * 128 + sc)); \
                        v0 = *(const bf16x8*)(Vp + (unsigned)((64 * (T) + sr) * 128 + sc)); v1 = *(const bf16x8*)(Vp + (unsigned)((64 * (T) + 32 + sr) * 128 + sc)); } while (0)
#define KV_WRITE(BUF) do { *(bf16x8*)(lds + (BUF) * 16384 + st0) = k0; *(bf16x8*)(lds + (BUF) * 16384 + st1) = k1; *(bf16x8*)(lds + 32768 + (BUF) * 16384 + st0) = v0; *(bf16x8*)(lds + 32768 + (BUF) * 16384 + st1) = v1; } while (0)
#define KV_TILE(T, BUF) do { if ((T) < 3) KV_LOAD((T) + 1); if ((T) > 0) { acc0 *= g64; acc1 *= g64; } \
        KV_STEP(BUF, 0); KV_STEP(BUF, 1); KV_STEP(BUF, 2); KV_STEP(BUF, 3); if ((T) < 3) { KV_WRITE(1 - (BUF)); } __syncthreads(); } while (0)
    for (int L = blockIdx.x; L < 512; L += G) {
        const int bh = L >> 5, c = L & 31;
        const float l2g = log2f(1.f - exp2f(-5.f - (float)(bh & 7))), g64 = exp2f(64.f * l2g), g63 = exp2f(63.f * l2g);
        const bf16* Kp = q + 4 * QKV_ELEMS + ((size_t)bh * 8192 + c * 256) * 128; const bf16* Vp = q + 5 * QKV_ELEMS + ((size_t)bh * 8192 + c * 256) * 128;
        f32x16 acc0 = {}, acc1 = {}; bf16x8 k0, k1, v0, v1;
        KV_LOAD(0); KV_WRITE(0); __syncthreads();
        KV_TILE(0, 0); KV_TILE(1, 1); KV_TILE(2, 0); KV_TILE(3, 1);
        float* out = kvs + ((size_t)(bh * 32 + c)) * 16384 + (unsigned)((dblk * 32 + 4 * hi) * 128 + eb0 * 32 + r32);
#pragma unroll
        for (int r = 0; r < 16; ++r) { const int ro = (r & 3) + 8 * (r >> 2); out[ro * 128] = g63 * acc0[r]; out[ro * 128 + 32] = g63 * acc1[r]; }
    }
#undef TRRD
#undef KV_STEP
#undef KV_LOAD
#undef KV_WRITE
#undef KV_TILE
}
__device__ __forceinline__ void scan_units(const Args& a, LAS unsigned char* lds, int G) {
    const int tid = threadIdx.x, dl = tid >> 6, e2 = (tid & 63) * 2;
    const float* kvs = (const float*)(a.ws + W::KVS); bf16_t* st = (bf16_t*)(a.ws + W::ST);
    LAS bf16_t* T = (LAS bf16_t*)(lds + RING_OFF);
    for (int L = blockIdx.x; L < 256; L += G) {
        const int bh = L >> 4, d0 = (L & 15) * 8;
        const float g256 = exp2f(256.f * log2f(1.f - exp2f(-5.f - (float)(bh & 7))));
        float2 kv[32];
#pragma unroll
        for (int c = 0; c < 32; ++c) kv[c] = *(const float2*)(kvs + ((size_t)(bh * 32 + c)) * 16384 + (d0 + dl) * 128 + e2);
        float s0 = 0.f, s1 = 0.f;
#pragma unroll
        for (int c = 0; c < 32; ++c) {
            T[e2 * 8 + dl] = (bf16_t)f2bf(s0); T[(e2 + 1) * 8 + dl] = (bf16_t)f2bf(s1);
            __syncthreads();
            if (tid < 128) *(pg8::u32x4*)(st + (((size_t)(bh * 32 + c)) * 128 + tid) * 128 + d0) = *(const LAS pg8::u32x4*)(T + tid * 8);
            s0 = g256 * s0 + kv[c].x; s1 = g256 * s1 + kv[c].y;
            __syncthreads();
        }
    }
}
typedef at::BlockRef<at::bf16, at::bf16> ARef;
template <int MODE> __device__ __forceinline__ ARef attn_ref_bq(const Args& a, int bh, int qb) {
    const int b = bh >> 3, h = bh & 7;
    const at::bf16* q = (const at::bf16*)(a.ws + W::QKV) + (MODE ? 3 * QKV_ELEMS : 0); ARef r;
    r.Q = q + ((size_t)bh * 8192 + qb * 256) * 128; r.K = q + QKV_ELEMS + (size_t)bh * 8192 * 128; r.V = q + 2 * QKV_ELEMS + (size_t)bh * 8192 * 128;
    r.O = (at::bf16*)(a.ws + W::MIX) + ((size_t)(b * 8192 + qb * 256)) * 2048 + (MODE ? 1024 : 0) + h * 128; r.P0 = qb * 256; r.bh = bh; r.jlo = MODE ? 0 : ((const int*)(a.ws + W::JLO))[bh * 32 + qb];
    if (MODE) r.jlo = 4 * qb;
    return r;
}
template <int MODE> __device__ __forceinline__ ARef attn_ref(const Args& a, int L, int pass) { const int bh = L >> 4, x = L & 15; return attn_ref_bq<MODE>(a, bh, pass ? 31 - x : x); }
__device__ __forceinline__ void fox_stream(const Args& a, char* lds) {
    const int tid = threadIdx.x;
    gu32* q = (gu32*)(a.ws + W::CTL) + CW_QFOX; volatile int* tk = (volatile int*)(lds + 100352);
    if (tid == 0) { tk[0] = (int)__hip_atomic_fetch_add(q, 1u, RLX_AGENT); tk[1] = (int)__hip_atomic_fetch_add(q, 1u, RLX_AGENT); }
    __syncthreads();
    int i0 = __builtin_amdgcn_readfirstlane(tk[0]), i1 = __builtin_amdgcn_readfirstlane(tk[1]);
    __syncthreads();
    if (i0 >= 512) return;
    const at::Extra<at::bf16> X{(const float*)(a.ws + W::BIAS), nullptr, nullptr, nullptr};
    ARef cur = attn_ref_bq<0>(a, i0 & 15, 31 - (i0 >> 4));
    at::Seam<at::bf16> S;
    at::causal_swa_prime<at::bf16, at::bf16>(cur, at::WBIG, lds, S);
    for (;;) {
        if (tid == 0) tk[0] = (int)__hip_atomic_fetch_add(q, 1u, RLX_AGENT);
        const bool last = i1 >= 512;
        const ARef nr = last ? cur : attn_ref_bq<0>(a, i1 & 15, 31 - (i1 >> 4));
        const at::NextRef<at::bf16> nxt{nr.Q, nr.K, nr.V, nr.jlo};
        at::causal_swa_block<0, at::bf16, at::bf16>(cur, nxt, X, 8192, at::WBIG, lds, S);
        if (last) break;
        const int i2 = __builtin_amdgcn_readfirstlane(tk[0]);
        __syncthreads();
        cur = attn_ref_bq<0>(a, i1 & 15, 31 - (i1 >> 4)); i0 = i1; i1 = i2;
    }
}
template <int MODE> __device__ __forceinline__ void attn_stream(const Args& a, char* lds, int G) {
    int L = blockIdx.x; if (L >= 256) return;
    int pass = 0; ARef cur = attn_ref<MODE>(a, L, 0);
    const at::Extra<at::bf16> X{(const float*)(a.ws + W::BIAS), (const at::bf16*)(a.ws + W::QKV) + 6 * QKV_ELEMS, a.in[9], (const at::bf16*)(a.ws + W::ST)};
    at::Seam<at::bf16> S;
    at::causal_swa_prime<at::bf16, at::bf16>(cur, at::WBIG, lds, S);
    for (;;) {
        const bool more_pass = pass == 0, more_item = L + G < 256, last = !more_pass && !more_item;
        int Ln = L, passn = 1; if (!more_pass) { passn = 0; Ln = more_item ? L + G : L; }
        const ARef nr = last ? cur : attn_ref<MODE>(a, Ln, passn);
        const at::NextRef<at::bf16> nxt{nr.Q, nr.K, nr.V, nr.jlo};
        at::causal_swa_block<MODE, at::bf16, at::bf16>(cur, nxt, X, 8192, at::WBIG, lds, S);
        if (last) break;
        cur = attn_ref<MODE>(a, Ln, passn); L = Ln; pass = passn;
    }
}


struct RangeOrder : pg8::StaticOrder {
    int i0, i1;
    __device__ bool next(int i, pg8::Unit& u) const { return (i + i0 < i1) && pg8::StaticOrder::next(i + i0, u); }
};
struct EpiX1 {
    static constexpr bool PERM = false, AFTER_DRAIN = false;
    const float* x; const float* mod; float* out;
    __device__ __forceinline__ void operator()(const pg8::f32x4 (&acc)[2][2][4][2], const pg8::Unit& u, int wr, int wc, int fr, int fq) const {
        using pg8::f32x4;
        const int row0 = u.pm * 256 + wr * 64 + fr, b = row0 >> 13, col0 = u.pn * 256 + wc * 32 + 4 * fq;
        f32x4 g[2][2];
#pragma unroll
        for (int bj = 0; bj < 2; ++bj)
#pragma unroll
            for (int n = 0; n < 2; ++n) g[bj][n] = *(const f32x4*)(mod + b * 12288 + 4096 + col0 + bj * 128 + n * 16);
#pragma unroll
        for (int ai = 0; ai < 2; ++ai)
#pragma unroll
            for (int m = 0; m < 4; ++m) { const size_t off = (size_t)(row0 + ai * 128 + m * 16) * 2048 + col0;
#pragma unroll
                for (int bj = 0; bj < 2; ++bj)
#pragma unroll
                    for (int n = 0; n < 2; ++n) { const f32x4 xv = *(const f32x4*)(x + off + bj * 128 + n * 16); *(f32x4*)(out + off + bj * 128 + n * 16) = xv + g[bj][n] * acc[ai][bj][m][n]; }
                if (m & 1) asm volatile("" ::: "memory"); }
    }
};

__device__ __forceinline__ void router_tables(const Args& a, LAS unsigned char* lds, int b) {
    const int tid = threadIdx.x, lane = tid & 63, wave = __builtin_amdgcn_readfirstlane(tid >> 6);
    const float* norm2_w = a.in[11]; const float* w_coarse = a.in[12]; const float* b_coarse = a.in[13]; const float* w_fine = a.in[14]; const float* b_fine = a.in[15];
    const float* mod = (const float*)(a.ws + W::MOD) + b * 12288; float* tab = (float*)(a.ws + W::A2S2);
    LAS float* S2 = (LAS float*)(lds + RING_OFF); LAS float* RD = S2 + 2048;
    for (int cc = tid; cc < 2048; cc += 512) { const float sv = mod[6144 + cc]; tab[b * 2048 + cc] = norm2_w[cc] * (1.f + mod[8192 + cc]); tab[4096 + b * 2048 + cc] = sv; S2[cc] = sv; }
    __syncthreads();
    for (int c0 = 0; c0 < 36; c0 += 4) { float part[4] = {0.f, 0.f, 0.f, 0.f};
#pragma unroll
        for (int q = 0; q < 4; ++q) { const int k = tid * 4 + q; const float sv = S2[k];
            const float4 wv = c0 == 0 ? *(const float4*)(w_coarse + (size_t)k * 4) : *(const float4*)(w_fine + ((size_t)((c0 - 4) >> 3) * 2048 + k) * 8 + ((c0 - 4) & 7));
            part[0] += sv * wv.x; part[1] += sv * wv.y; part[2] += sv * wv.z; part[3] += sv * wv.w; }
#pragma unroll
        for (int i = 0; i < 4; ++i) { const float t = wave_sum(part[i]); if (lane == 0) RD[(c0 + i) * 8 + wave] = t; } }
    __syncthreads();
    if (tid < 36) { float t = tid < 4 ? b_coarse[tid] : b_fine[tid - 4];
        for (int w = 0; w < 8; ++w) t += RD[tid * 8 + w];
        tab[8192 + b * 64 + tid] = t; }
    __syncthreads();
}
typedef short bfx8 __attribute__((ext_vector_type(8)));
__device__ __forceinline__ void split8(const float* v, bfx8& h, bfx8& l) {
    unsigned hw[4], lw[4];
#pragma unroll
    for (int i = 0; i < 4; ++i) { const unsigned h0 = f2bf(v[2 * i]), h1 = f2bf(v[2 * i + 1]); hw[i] = h0 | (h1 << 16);
        const float r0 = v[2 * i] - __uint_as_float(h0 << 16), r1 = v[2 * i + 1] - __uint_as_float(h1 << 16); lw[i] = f2bf(r0) | (f2bf(r1) << 16); }
    typedef unsigned u4 __attribute__((ext_vector_type(4)));
    const u4 hv = {hw[0], hw[1], hw[2], hw[3]}, lv = {lw[0], lw[1], lw[2], lw[3]};
    h = __builtin_bit_cast(bfx8, hv); l = __builtin_bit_cast(bfx8, lv);
}
__device__ __forceinline__ void ph5(const Args& a, LAS unsigned char* lds, int G) {
    using pg8::f32x4;
    const int tid = threadIdx.x, lane = tid & 63, wave = __builtin_amdgcn_readfirstlane(tid >> 6), fr = lane & 15, fq = lane >> 4;
    unsigned char* ws = a.ws; const float* x1 = a.out; bf16_t* h2 = (bf16_t*)(ws + W::H2);
    const float* tab = (const float*)(ws + W::A2S2);
    int* r_eid = (int*)(ws + W::ROUTE); float* r_gate = (float*)(ws + W::ROUTE + 128 * 1024); int* r_idx = (int*)(ws + W::ROUTE + 256 * 1024); int* cnt = (int*)(ws + W::CTL) + CW_CNT;
    constexpr int XP = 2052;
    LAS float* XT = (LAS float*)(lds + RING_OFF); LAS float* PART = XT + 16 * XP; LAS float* RS = PART + 8 * 16 * 36; LAS float* LG = RS + 16; LAS int* CH = (LAS int*)(LG + 16 * 36); LAS int* LC = CH + 128; LAS int* LB = LC + 32;
    const bfx8* wfr = (const bfx8*)(ws + W::WFR) + (size_t)(wave * 8) * 6 * 64;
    int T = blockIdx.x * 4; if (T >= 1024) return;
    f32x4 xn[16];
#define RT_LOAD(TT) do { _Pragma("unroll") for (int q = 0; q < 2; ++q) _Pragma("unroll") for (int j = 0; j < 8; ++j) \
        xn[q * 8 + j] = *(const f32x4*)(x1 + (size_t)((TT) * 16 + 2 * wave + q) * 2048 + j * 256 + lane * 4); } while (0)
    RT_LOAD(T);
    for (;;) {
        const int r0 = T * 16, b = r0 >> 13;
#pragma unroll
        for (int q = 0; q < 2; ++q) { const int rl = 2 * wave + q; float ss = 0.f;
#pragma unroll
            for (int j = 0; j < 8; ++j) { const f32x4 v = xn[q * 8 + j]; ss += (v[0] * v[0] + v[1] * v[1]) + (v[2] * v[2] + v[3] * v[3]); *(LAS f32x4*)(XT + rl * XP + j * 256 + lane * 4) = v; }
            ss = wave_sum(ss); if (lane == 0) RS[rl] = rsqrtf(ss * (1.f / 2048.f) + 1e-6f); }
        __syncthreads();
        const int Tn = (T & 3) < 3 ? T + 1 : T - 3 + 4 * G; const bool has_next = Tn < 1024;
        if (has_next) RT_LOAD(Tn);
        f32x4 acc[3] = {{0.f, 0.f, 0.f, 0.f}, {0.f, 0.f, 0.f, 0.f}, {0.f, 0.f, 0.f, 0.f}};
        unsigned ln = lane; asm volatile("" : "+v"(ln));
#pragma unroll 2
        for (int ks = 0; ks < 8; ++ks) { const int k = 256 * wave + 32 * ks + 8 * fq;
            const f32x4 v0 = *(const LAS f32x4*)(XT + fr * XP + k), v1 = *(const LAS f32x4*)(XT + fr * XP + k + 4);
            const f32x4 a0 = *(const f32x4*)(tab + b * 2048 + k), a1 = *(const f32x4*)(tab + b * 2048 + k + 4);
            const float av[8] = {v0[0] * a0[0], v0[1] * a0[1], v0[2] * a0[2], v0[3] * a0[3], v1[0] * a1[0], v1[1] * a1[1], v1[2] * a1[2], v1[3] * a1[3]};
            bfx8 ah, al; split8(av, ah, al);
#pragma unroll
            for (int ob = 0; ob < 3; ++ob) { const bfx8 bh = (wfr + ((ks * 3 + ob) * 2) * 64)[ln], bl = (wfr + ((ks * 3 + ob) * 2 + 1) * 64)[ln];
                acc[ob] = __builtin_amdgcn_mfma_f32_16x16x32_bf16(ah, bh, acc[ob], 0, 0, 0);
                acc[ob] = __builtin_amdgcn_mfma_f32_16x16x32_bf16(al, bh, acc[ob], 0, 0, 0);
                acc[ob] = __builtin_amdgcn_mfma_f32_16x16x32_bf16(ah, bl, acc[ob], 0, 0, 0); } }
#pragma unroll
        for (int ob = 0; ob < 3; ++ob) { const int o = ob * 16 + fr;
            if (o < 36) {
#pragma unroll
                for (int r = 0; r < 4; ++r) PART[(wave * 16 + 4 * fq + r) * 36 + o] = acc[ob][r]; } }
        __syncthreads();
        for (int it = tid; it < 576; it += 512) { const int rl = it / 36, o = it - rl * 36; float t = 0.f;
#pragma unroll
            for (int w = 0; w < 8; ++w) t += PART[(w * 16 + rl) * 36 + o];
            LG[it] = RS[rl] * t + tab[8192 + b * 64 + o]; }
        __syncthreads();
        if (tid < 16) { const int row = r0 + tid; const LAS float* lg = LG + tid * 36;
            int gs = 0; float cmax = lg[0];
#pragma unroll
            for (int g = 1; g < 4; ++g) if (lg[g] > cmax) { cmax = lg[g]; gs = g; }
            float den = 0.f;
#pragma unroll
            for (int g = 0; g < 4; ++g) den += expf(lg[g] - cmax);
            const float pg = 1.f / den;
            float f0 = -3.0e38f, f1 = -3.0e38f; int e0 = 0, e1 = 0;
#pragma unroll
            for (int e = 0; e < 8; ++e) { const float fl = lg[4 + gs * 8 + e];
                if (fl > f0) { f1 = f0; e1 = e0; f0 = fl; e0 = e; } else if (fl > f1) { f1 = fl; e1 = e; } }
            const float t1 = expf(f1 - f0); const float g0 = pg / (1.f + t1), g1 = pg * t1 / (1.f + t1);
            const int E0 = gs * 8 + e0, E1 = gs * 8 + e1;
            r_eid[2 * row] = E0; r_eid[2 * row + 1] = E1; r_gate[2 * row] = g0; r_gate[2 * row + 1] = g1;
            CH[((T & 3) * 16 + tid) * 2] = E0; CH[((T & 3) * 16 + tid) * 2 + 1] = E1; }
#pragma unroll
        for (int q = 0; q < 2; ++q) { const int rl = 2 * wave + q; const float rstd = RS[rl]; unsigned char* hrow = (unsigned char*)h2 + (size_t)(r0 + rl) * 2048;
#pragma unroll
            for (int j = 0; j < 8; ++j) { const int c = j * 256 + lane * 4; const f32x4 xv = *(const LAS f32x4*)(XT + rl * XP + c);
                const f32x4 aa = *(const f32x4*)(tab + b * 2048 + c), sv = *(const f32x4*)(tab + 4096 + b * 2048 + c);
                *(unsigned*)(hrow + c) = pk4_fp8(xv[0] * rstd * aa[0] + sv[0], xv[1] * rstd * aa[1] + sv[1], xv[2] * rstd * aa[2] + sv[2], xv[3] * rstd * aa[3] + sv[3]); } }
        __syncthreads();
        if ((T & 3) == 3) {
            if (tid < 32) LC[tid] = 0;
            __syncthreads();
            int rk = 0, ee = 0;
            if (tid < 128) { ee = CH[tid]; rk = atomicAdd((int*)(LC + ee), 1); }
            __syncthreads();
            if (tid < 32) { const int n = LC[tid]; LB[tid] = n ? atomicAdd(cnt + tid * CNT_STRIDE, n) : 0; }
            __syncthreads();
            if (tid < 128) r_idx[(size_t)(T >> 2) * 128 + tid] = LB[ee] + rk;
            __syncthreads();
        }
        if (!has_next) break;
        T = Tn;
    }
#undef RT_LOAD
}
__device__ __forceinline__ void ph6(const Args& a, LAS unsigned char* lds, int G) {
    const int tid = threadIdx.x, lane = tid & 63, wave = __builtin_amdgcn_readfirstlane(tid >> 6);
    unsigned char* ws = a.ws;
    const int* cnt = (const int*)(ws + W::CTL) + CW_CNT; int* pstart_g = (int*)(ws + W::TILE); int* tile_e = pstart_g + 64; int* ntile = pstart_g + 512;
    const int* r_eid = (const int*)(ws + W::ROUTE); const int* r_idx = (const int*)(ws + W::ROUTE + 256 * 1024); int* r_slot = (int*)(ws + W::ROUTE + 384 * 1024);
    LAS int* ps = (LAS int*)(lds + RING_OFF);
    if (tid == 0) { int p = 0, t = 0;
        for (int e = 0; e < 32; ++e) { ps[e] = p; const int n = (cnt[e * CNT_STRIDE] + 255) >> 8; if (blockIdx.x == 0) { pstart_g[e] = p; for (int i = 0; i < n; ++i) tile_e[t + i] = e; } t += n; p += n * 256; }
        ps[32] = p; if (blockIdx.x == 0) { pstart_g[32] = p; *ntile = t; } }
    __syncthreads();
    const bf16_t* h2 = (const bf16_t*)(ws + W::H2); bf16_t* xs = (bf16_t*)(ws + W::XS);
    for (int mk = blockIdx.x * NWAVES + wave; mk < 2 * M_TOK; mk += G * NWAVES) {
        const int slot = ps[r_eid[mk]] + r_idx[mk]; if (lane == 0) r_slot[mk] = slot;
        const uint4* src = (const uint4*)((const unsigned char*)h2 + (size_t)(mk >> 1) * 2048) + lane; uint4* dst = (uint4*)((unsigned char*)xs + (size_t)slot * 2048) + lane;
        uint4 v[2];
#pragma unroll
        for (int j = 0; j < 2; ++j) v[j] = src[64 * j];
#pragma unroll
        for (int j = 0; j < 2; ++j) dst[64 * j] = v[j];
    }
    __syncthreads();
}
template <int LOG2_NN> struct GroupedOrder {
    const int* tile_e; int nunits, G, c;
    __device__ void init(const int* tile_e_, const int* ntile, int G_, int c_) { tile_e = tile_e_; nunits = *ntile << LOG2_NN; G = G_; c = c_; }
    __device__ bool next(int i, pg8::Unit& u) const { const int L = i * G + c; if (L >= nunits) return false; u.pm = L >> LOG2_NN; u.pn = L & ((1 << LOG2_NN) - 1); u.e = tile_e[u.pm]; return true; }
    __device__ __forceinline__ void a_ready(const pg8::Unit&) const {}
    __device__ __forceinline__ void done(const pg8::Unit&) const {}
};
struct EpiUp {
    static constexpr bool PERM = true, AFTER_DRAIN = false;
    bf16_t* act;
    __device__ __forceinline__ void operator()(const pg8::f32x4 (&acc)[2][2][4][2], const pg8::Unit& u, int wr, int wc, int fr, int fq) const {
        using pg8::f32x4;
        const int row0 = u.pm * 256 + wr * 64 + fr, col0 = u.pn * 128 + wc * 16 + 4 * fq;
#pragma unroll
        for (int ai = 0; ai < 2; ++ai)
#pragma unroll
            for (int m = 0; m < 4; ++m) { unsigned char* rowp = (unsigned char*)act + (size_t)(row0 + ai * 128 + m * 16) * 512 + col0;
#pragma unroll
                for (int bj = 0; bj < 2; ++bj) { const f32x4 av = acc[ai][bj][m][0] * (1.f / SC13), bv = acc[ai][bj][m][1] * (1.f / SC13); float o[4];
#pragma unroll
                    for (int e = 0; e < 4; ++e) o[e] = av[e] * __builtin_amdgcn_rcpf(1.f + __expf(-av[e])) * bv[e];
                    *(unsigned*)(rowp + bj * 64) = pk4_fp8(o[0], o[1], o[2], o[3]); } }
    }
};
__device__ __forceinline__ void ph9(const Args& a, int G) {
    const int tid = threadIdx.x, lane = tid & 63, wave = __builtin_amdgcn_readfirstlane(tid >> 6);
    unsigned char* ws = a.ws; float* out = a.out;
    const float* mod = (const float*)(ws + W::MOD); const bf16_t* y = (const bf16_t*)(ws + W::Y);
    const float* r_gate = (const float*)(ws + W::ROUTE + 128 * 1024); const int* r_slot = (const int*)(ws + W::ROUTE + 384 * 1024);
    int m = blockIdx.x * NWAVES + wave; if (m >= M_TOK) return;
    int s0 = r_slot[2 * m], s1 = r_slot[2 * m + 1]; float g0 = r_gate[2 * m], g1 = r_gate[2 * m + 1];
    for (;;) {
        const int mn = m + G * NWAVES; const bool more = mn < M_TOK; const int mq = more ? mn : m;
        const int s0n = r_slot[2 * mq], s1n = r_slot[2 * mq + 1]; const float g0n = r_gate[2 * mq], g1n = r_gate[2 * mq + 1];
        const float* g2 = mod + (m >> 13) * 12288 + 10240;
#pragma unroll
        for (int j = 0; j < 4; ++j) { const int c = j * 512 + lane * 8;
            const pg8::u32x4 ya = *(const pg8::u32x4*)(y + (size_t)s0 * 2048 + c), yb = *(const pg8::u32x4*)(y + (size_t)s1 * 2048 + c);
            const pg8::f32x4 x0 = *(const pg8::f32x4*)(out + (size_t)m * 2048 + c), x1v = *(const pg8::f32x4*)(out + (size_t)m * 2048 + c + 4);
            const pg8::f32x4 ga = *(const pg8::f32x4*)(g2 + c), gb = *(const pg8::f32x4*)(g2 + c + 4);
            pg8::f32x4 o0, o1;
#pragma unroll
            for (int e = 0; e < 2; ++e) { o0[2 * e] = x0[2 * e] + ga[2 * e] * (g0 * __uint_as_float(ya[e] << 16) + g1 * __uint_as_float(yb[e] << 16));
                o0[2 * e + 1] = x0[2 * e + 1] + ga[2 * e + 1] * (g0 * __uint_as_float(ya[e] & 0xffff0000u) + g1 * __uint_as_float(yb[e] & 0xffff0000u));
                o1[2 * e] = x1v[2 * e] + gb[2 * e] * (g0 * __uint_as_float(ya[2 + e] << 16) + g1 * __uint_as_float(yb[2 + e] << 16));
                o1[2 * e + 1] = x1v[2 * e + 1] + gb[2 * e + 1] * (g0 * __uint_as_float(ya[2 + e] & 0xffff0000u) + g1 * __uint_as_float(yb[2 + e] & 0xffff0000u)); }
            *(pg8::f32x4*)(out + (size_t)m * 2048 + c) = o0; *(pg8::f32x4*)(out + (size_t)m * 2048 + c + 4) = o1; }
        if (!more) break;
        m = mn; s0 = s0n; s1 = s1n; g0 = g0n; g1 = g1n;
    }
}

__global__ void __launch_bounds__(NWAVES * 64, 2) mk_fwd(Args args) {
    extern __shared__ __attribute__((aligned(16))) unsigned char lds_raw[];
    LAS unsigned char* lds = (LAS unsigned char*)lds_raw;
    volatile LAS unsigned* MISC = (volatile LAS unsigned*)(lds + MISC_OFF);
    const int tid = threadIdx.x, G = gridDim.x;
    unsigned char* ws = args.ws; gu32* ctl = (gu32*)(ws + W::CTL);
    for (int u = tid; u < (LDS_BYTES - MISC_OFF) / 4; u += NWAVES * 64) ((LAS unsigned*)(lds + MISC_OFF))[u] = 0u;
    __syncthreads();
    const int lo = args.ph_lo, hi = args.ph_hi;
    XcdBarrier bar; bar.bar = (unsigned*)(ctl + CW_BAR) + args.li * XCD_BAR_WORDS; bar.x = 0; bar.st = nullptr;
    if (hi - lo > 1) bar = xcd_barrier_post((unsigned*)(ctl + CW_BAR) + args.li * XCD_BAR_WORDS, MISC + 8);
#define IN(k) (lo <= (k) && (k) < hi)
#define BOTH(k) (IN(k) && IN((k) + 1))
    if (IN(0)) { ph0(args, lds, G); if (BOTH(0)) xcd_barrier(bar); }
    if (IN(1)) { ph1(args, lds, G); if (BOTH(1)) xcd_barrier(bar); }
    if (IN(2)) {
        for (int bh = blockIdx.x; bh < 16; bh += G) cumsum_bh(args, lds, bh);
        for (int b = (int)blockIdx.x - 16; b < 2; b += G) if (b >= 0) router_tables(args, lds, b);
        pg8::Gemm g{(const bf16_t*)(ws + W::XN), (const bf16_t*)(ws + W::WT_IN), M_TOK, 7168, 2048, 0};
        RangeOrder S; S.init(M_TOK, 7168, G, (int)blockIdx.x);
        EpiZ E{(bf16_t*)(ws + W::QKV), args.in[7], args.in[8], (const float*)(ws + W::ROPE), (PG8_LAS float*)(lds + XCH_OFF)};
        const int ksplit = ((int)blockIdx.x >> 3) & 7;
        S.i0 = 0; S.i1 = ksplit;
        pg8::gemm_phase<EpiZ, RangeOrder, true, true>(lds + RING_OFF, g, S, E);
        moe_convert(args, lds, G);
        S.i0 = ksplit; S.i1 = 1 << 20;
        pg8::gemm_phase<EpiZ, RangeOrder, true, true>(lds + RING_OFF, g, S, E);
        if (BOTH(2)) xcd_barrier(bar);
    }
    if (IN(3)) { kv_units(args, (char*)lds_raw + RING_OFF, G); fox_stream(args, (char*)lds_raw + RING_OFF); if (BOTH(3)) xcd_barrier(bar); }
    if (IN(4)) { scan_units(args, lds, G); if (BOTH(4)) xcd_barrier(bar); }
    if (IN(5)) { attn_stream<1>(args, (char*)lds_raw + RING_OFF, G); if (BOTH(5)) xcd_barrier(bar); }
    if (IN(6)) {
        pg8::Gemm g{(const bf16_t*)(ws + W::MIX), (const bf16_t*)(ws + W::WT_OUT), M_TOK, 2048, 2048, 0};
        pg8::StaticOrder S; S.init(M_TOK, 2048, G, (int)blockIdx.x);
        EpiX1 E{args.in[0], (const float*)(ws + W::MOD), args.out};
        pg8::gemm_phase<EpiX1, pg8::StaticOrder, true, true>(lds + RING_OFF, g, S, E);
        if (BOTH(6)) xcd_barrier(bar);
    }
    if (IN(7)) { ph5(args, lds, G); if (BOTH(7)) xcd_barrier(bar); }
    if (IN(8)) { ph6(args, lds, G); if (BOTH(8)) xcd_barrier(bar); }
    if (IN(9)) {
        pg8::Gemm g{(const bf16_t*)(ws + W::XS), (const bf16_t*)(ws + W::WT_13), 0, 1024, 2048, (size_t)1024 * 2048};
        GroupedOrder<2> S; S.init((const int*)(ws + W::TILE) + 64, (const int*)(ws + W::TILE) + 512, G, (int)blockIdx.x);
        EpiUp E{(bf16_t*)(ws + W::ACT)};
        pg8::gemm_phase<EpiUp, GroupedOrder<2>, true, true, 1>(lds + RING_OFF, g, S, E);
        if (BOTH(9)) xcd_barrier(bar);
    }
    if (IN(10)) {
        pg8::Gemm g{(const bf16_t*)(ws + W::ACT), (const bf16_t*)(ws + W::WT_2), 0, 2048, 512, (size_t)2048 * 512};
        GroupedOrder<3> S; S.init((const int*)(ws + W::TILE) + 64, (const int*)(ws + W::TILE) + 512, G, (int)blockIdx.x);
        pg8::EpiBf16<0> E{(bf16_t*)(ws + W::Y), 2048, nullptr, 1 << 30, 0, 1.f / SC2};
        pg8::gemm_phase<pg8::EpiBf16<0>, GroupedOrder<3>, true, true, 1>(lds + RING_OFF, g, S, E);
        if (BOTH(10)) xcd_barrier(bar);
    }
    if (IN(11)) ph9(args, G);
#undef IN
#undef BOTH
}
extern "C" void kernel_launch(void* const* d_in, const int* in_sizes, int n_in, void* d_out, int out_size, void* d_ws, size_t ws_size, hipStream_t stream) {
    static int grid = 0;
    if (grid == 0) {
        if (n_in != 19 || out_size != M_TOK * DM || ws_size < W::END) { fprintf(stderr, "kernel_launch: built for 19 inputs, %d outputs, >= %zu bytes of workspace; got %d, %d, %zu\n", M_TOK * DM, (size_t)W::END, n_in, out_size, ws_size); grid = -1; return; }
        int dev = 0, cus = 0, per_cu = 0;
        if (hipGetDevice(&dev) != hipSuccess || hipDeviceGetAttribute(&cus, hipDeviceAttributeMultiprocessorCount, dev) != hipSuccess) { fprintf(stderr, "kernel_launch: device query failed\n"); grid = -1; return; }
        if (hipFuncSetAttribute((const void*)mk_fwd, hipFuncAttributeMaxDynamicSharedMemorySize, LDS_BYTES) != hipSuccess) { fprintf(stderr, "kernel_launch: hipFuncSetAttribute failed\n"); grid = -1; return; }
        if (hipOccupancyMaxActiveBlocksPerMultiprocessor(&per_cu, (const void*)mk_fwd, NWAVES * 64, LDS_BYTES) != hipSuccess || per_cu < 1) { fprintf(stderr, "kernel_launch: occupancy query says %d workgroups per CU\n", per_cu); (void)hipGetLastError(); grid = -1; return; }
        grid = cus;
    }
    if (grid < 0) return;
    (void)hipMemsetAsync((char*)d_ws + W::CTL, 0, W::CTL_ZERO_BYTES, stream);
    Args a{};
    for (int i = 0; i < 19; ++i) a.in[i] = (const float*)d_in[i];
    a.out = (float*)d_out; a.ws = (unsigned char*)d_ws; a.ph_lo = 0; a.ph_hi = 12; a.li = 0;
    hipLaunchKernelGGL(mk_fwd, dim3(grid), dim3(NWAVES * 64), LDS_BYTES, stream, a);
}
```
